# Optimizing an MI355X kernel written in HIP

```python
import math
import jax
import jax.numpy as jnp
from jax import lax
import numpy as np

D_MODEL = 1024
BATCH = 4
SEQ = 4096
DEPTH = 1

D_MIX = D_MODEL
CONV_WIDTH = D_MIX // 2
CONV_GROUPS = 8
CONV_K = 3
GLA_WIDTH = D_MIX - CONV_WIDTH
GLA_HEADS = 4
GLA_DV = GLA_WIDTH // GLA_HEADS
GLA_DK = GLA_DV // 2
GLA_RANK = 16
GLA_NORMALIZER = 16.0
GLA_CHUNK = 64
N_EXPERTS = 32
TOP_K = 4
D_FF = D_MODEL
SWIGLU_LIMIT = 7.0
SWIGLU_ALPHA = 1.702
MOE_BLOCK = 256
RMS_EPS = 1e-5
D_IN = 3 * CONV_WIDTH + 2 * GLA_HEADS * GLA_DK + 2 * GLA_WIDTH + GLA_RANK

kernel_name = "hybrid_conv_gla_moe_block"


def rmsnorm(x, g):
    xf = x.astype(jnp.float32)
    y = xf * lax.rsqrt(jnp.mean(xf * xf, axis=-1, keepdims=True) + RMS_EPS)
    return (y * g.astype(jnp.float32)).astype(x.dtype)


def gla_chunked(q, k, v, log_a):
    bsz, nh, s, dk = q.shape
    dv = v.shape[-1]
    n = s // GLA_CHUNK
    q = q.reshape(bsz, nh, n, GLA_CHUNK, dk)
    k = k.reshape(bsz, nh, n, GLA_CHUNK, dk)
    v = v.reshape(bsz, nh, n, GLA_CHUNK, dv)
    b = jnp.cumsum(log_a.reshape(bsz, nh, n, GLA_CHUNK, dk), axis=3)
    b_last = b[..., -1:, :]
    q_dec = q * jnp.exp(b)
    k_dec = k * jnp.exp(-b)
    mask = jnp.tril(jnp.ones((GLA_CHUNK, GLA_CHUNK), dtype=bool))
    scores = jnp.where(mask, jnp.einsum('bhncd,bhnjd->bhncj', q_dec, k_dec), 0.0)
    o_intra = jnp.einsum('bhncj,bhnjv->bhncv', scores, v)
    kv = jnp.einsum('bhncd,bhncv->bhndv', k * jnp.exp(b_last - b), v)
    decay = jnp.exp(b_last[..., 0, :])

    def step(state, inp):
        dec, kv_n = inp
        return dec[..., None] * state + kv_n, state

    init = jnp.zeros((bsz, nh, dk, dv), q.dtype)
    _, s_before = lax.scan(step, init, (jnp.moveaxis(decay, 2, 0), jnp.moveaxis(kv, 2, 0)))
    s_before = jnp.moveaxis(s_before, 0, 2)
    o_inter = jnp.einsum('bhncd,bhndv->bhncv', q_dec, s_before)
    return (o_intra + o_inter).reshape(bsz, nh, s, dv)


def hybrid_mixer(h, w_in, conv_w, w_gk_up, b_gk_up, gla_norm_g, w_out):
    bsz, s, _ = h.shape
    sizes = [CONV_WIDTH, CONV_WIDTH, CONV_WIDTH, GLA_HEADS * GLA_DK, GLA_HEADS * GLA_DK,
             GLA_WIDTH, GLA_WIDTH, GLA_RANK]
    splits = [int(v) for v in np.cumsum(sizes)[:-1]]
    proj = h @ w_in
    u_h, gate_b, gate_c, q, k, v, g_out, gk_low = jnp.split(proj, splits, axis=-1)

    u = gate_c * u_h
    u_pad = jnp.pad(u, ((0, 0), (CONV_K - 1, 0), (0, 0)))
    conv = conv_w[0] * u_pad[:, 0:s]
    for i in range(1, CONV_K):
        conv = conv + conv_w[i] * u_pad[:, i:i + s]
    y_conv = gate_b * conv

    gk = gk_low @ w_gk_up + b_gk_up
    log_a = jax.nn.log_sigmoid(gk.astype(jnp.float32)) / GLA_NORMALIZER

    def heads(t, d):
        return t.astype(jnp.float32).reshape(bsz, s, GLA_HEADS, d).transpose(0, 2, 1, 3)

    o = gla_chunked(heads(q, GLA_DK) * (GLA_DK ** -0.5), heads(k, GLA_DK),
                    heads(v, GLA_DV), heads(log_a, GLA_DK))
    o = rmsnorm(o, gla_norm_g)
    o = o.transpose(0, 2, 1, 3).reshape(bsz, s, GLA_WIDTH).astype(h.dtype)
    y_gla = o * jax.nn.silu(g_out)

    return jnp.concatenate([y_conv, y_gla], axis=-1) @ w_out


def moe(h, w_router, b_router, w_gate_up, b_gate_up, w_down, b_down):
    bsz, s, d = h.shape
    t = bsz * s
    xf = h.reshape(t, d)
    logits = (xf @ w_router + b_router).astype(jnp.float32)
    top_v, top_i = lax.top_k(logits, TOP_K)
    gates = jax.nn.softmax(top_v, axis=-1).astype(h.dtype)

    tk = t * TOP_K
    e_flat = top_i.reshape(tk).astype(jnp.int32)
    tok_flat = jnp.repeat(jnp.arange(t, dtype=jnp.int32), TOP_K)
    gate_flat = gates.reshape(tk)

    counts = jnp.zeros((N_EXPERTS,), jnp.int32).at[e_flat].add(1)
    padded = ((counts + MOE_BLOCK - 1) // MOE_BLOCK) * MOE_BLOCK
    pad_end = jnp.cumsum(padded)
    pad_start = pad_end - padded
    grp_start = jnp.cumsum(counts) - counts
    order = jnp.argsort(e_flat, stable=True)
    e_sorted = e_flat[order]
    dest = pad_start[e_sorted] + (jnp.arange(tk, dtype=jnp.int32) - grp_start[e_sorted])

    n_rows = (-(-tk // MOE_BLOCK)) * MOE_BLOCK + N_EXPERTS * MOE_BLOCK
    n_blocks = n_rows // MOE_BLOCK
    row_tok = jnp.full((n_rows,), t, jnp.int32).at[dest].set(tok_flat[order])
    row_gate = jnp.zeros((n_rows,), h.dtype).at[dest].set(gate_flat[order])
    block_expert = jnp.minimum(
        jnp.searchsorted(pad_end, jnp.arange(n_blocks, dtype=jnp.int32) * MOE_BLOCK, side='right'),
        N_EXPERTS - 1).astype(jnp.int32)

    x_pad = jnp.concatenate([xf, jnp.zeros((1, d), xf.dtype)], axis=0)
    x_blocks = x_pad[row_tok].reshape(n_blocks, MOE_BLOCK, d)

    def expert_block(args):
        xb, eid = args
        gu = xb @ w_gate_up[eid] + b_gate_up[eid]
        gate = jnp.minimum(gu[:, :D_FF], SWIGLU_LIMIT)
        up = jnp.clip(gu[:, D_FF:], -SWIGLU_LIMIT, SWIGLU_LIMIT)
        glu = gate * jax.nn.sigmoid(gate * SWIGLU_ALPHA)
        return ((up + 1.0) * glu) @ w_down[eid] + b_down[eid]

    out = lax.map(expert_block, (x_blocks, block_expert)).reshape(n_rows, d)
    y = jnp.zeros((t + 1, d), h.dtype).at[row_tok].add(out * row_gate[:, None])[:t]
    return y.reshape(bsz, s, d)


def setup_inputs(seed: int = 0) -> dict:
    key = jax.random.key(seed)
    ks = jax.random.split(key, 17)
    f32 = jnp.float32

    def nrm(k, shape, scale):
        return jax.random.normal(k, shape, f32) * scale

    return {
        "x": nrm(ks[0], (BATCH, SEQ, D_MODEL), 1.0),
        "norm_mix_g": 1.0 + nrm(ks[1], (DEPTH, D_MODEL), 0.02),
        "w_in": nrm(ks[2], (DEPTH, D_MODEL, D_IN), D_MODEL ** -0.5),
        "conv_w": nrm(ks[3], (DEPTH, CONV_K, CONV_WIDTH), CONV_K ** -0.5),
        "w_gk_up": nrm(ks[4], (DEPTH, GLA_RANK, GLA_HEADS * GLA_DK), GLA_RANK ** -0.5),
        "b_gk_up": nrm(ks[5], (DEPTH, GLA_HEADS * GLA_DK), 0.1),
        "gla_norm_g": 1.0 + nrm(ks[6], (DEPTH, GLA_DV), 0.02),
        "w_out": nrm(ks[7], (DEPTH, D_MIX, D_MODEL), D_MIX ** -0.5),
        "norm_ffn_g": 1.0 + nrm(ks[8], (DEPTH, D_MODEL), 0.02),
        "w_router": nrm(ks[9], (DEPTH, D_MODEL, N_EXPERTS), D_MODEL ** -0.5),
        "b_router": nrm(ks[10], (DEPTH, N_EXPERTS), 0.01),
        "w_gate_up": nrm(ks[11], (DEPTH, N_EXPERTS, D_MODEL, 2 * D_FF), D_MODEL ** -0.5),
        "b_gate_up": nrm(ks[12], (DEPTH, N_EXPERTS, 2 * D_FF), 0.02),
        "w_down": nrm(ks[13], (DEPTH, N_EXPERTS, D_FF, D_MODEL), D_FF ** -0.5),
        "b_down": nrm(ks[14], (DEPTH, N_EXPERTS, D_MODEL), 0.02),
        "norm_final_g": 1.0 + nrm(ks[15], (D_MODEL,), 0.02),
    }


def reference(x, norm_mix_g, w_in, conv_w, w_gk_up, b_gk_up, gla_norm_g, w_out,
              norm_ffn_g, w_router, b_router, w_gate_up, b_gate_up, w_down, b_down,
              norm_final_g):
    for l in range(DEPTH):
        h = rmsnorm(x, norm_mix_g[l])
        x = x + hybrid_mixer(h, w_in[l], conv_w[l], w_gk_up[l], b_gk_up[l],
                             gla_norm_g[l], w_out[l])
        h = rmsnorm(x, norm_ffn_g[l])
        x = x + moe(h, w_router[l], b_router[l], w_gate_up[l], b_gate_up[l],
                    w_down[l], b_down[l])
    return rmsnorm(x, norm_final_g)
```

```cpp
#include <hip/hip_runtime.h>
#include <cstdio>
#include <cstdint>

#ifndef MK_N_LAUNCHES
#define MK_N_LAUNCHES 11
#endif

#define LAS __attribute__((address_space(3)))
#define GAS __attribute__((address_space(1)))
typedef unsigned short bf16_t;
typedef short bf16x8 __attribute__((ext_vector_type(8)));
typedef float f32x4 __attribute__((ext_vector_type(4)));
typedef float f32x2 __attribute__((ext_vector_type(2)));
typedef unsigned u32x4 __attribute__((ext_vector_type(4)));
typedef unsigned u32x2 __attribute__((ext_vector_type(2)));

constexpr int NWAVES = 8, NTHR = 512;
constexpr int NPHASES = 11;
constexpr int N_LAUNCHES = MK_N_LAUNCHES;
constexpr int BATCH = 4, SEQ = 4096, D = 1024, M = BATCH * SEQ;
constexpr int CONVW = 512, NH = 4, DK = 64, DV = 128, RANK = 16, CHUNK = 64, NCH = SEQ / CHUNK;
constexpr int DIN = 3088, NPROJ = 3072;
constexpr int C_UH = 0, C_GB = 512, C_GC = 1024, C_Q = 1536, C_K = 1792, C_V = 2048, C_G = 2560, C_GKL = 3072;
constexpr int NE = 32, TOPK = 4, FF = 1024;
constexpr int NUNITS_GLA = BATCH * NH * NCH;
constexpr int NROWS_MAX = M * TOPK + NE * 256;
constexpr int NTILES_MAX = NROWS_MAX / 256;
constexpr float RMS_EPS = 1e-5f;

constexpr size_t MiB = 1u << 20;
constexpr size_t WS_CTL = 0, CTL_ZERO_BYTES = 1 * MiB;
constexpr size_t WS_XN = 1 * MiB;
constexpr size_t WS_GKL = WS_XN + 32 * MiB;
constexpr size_t WS_W1T = WS_GKL + 1 * MiB;
constexpr size_t WS_WOT = WS_W1T + 6 * MiB;
constexpr size_t WS_WGUT = WS_WOT + 2 * MiB;
constexpr size_t WS_WDT = WS_WGUT + 128 * MiB;
constexpr size_t WS_PROJ = WS_WDT + 64 * MiB;
constexpr size_t WS_KVT = WS_PROJ + 96 * MiB;
constexpr size_t WS_DEC = WS_KVT + 32 * MiB;
constexpr size_t WS_ST = WS_DEC + 1 * MiB;
constexpr size_t WS_Y = WS_ST + 16 * MiB;
constexpr size_t WS_X1 = WS_Y + 32 * MiB;
constexpr size_t WS_ROUTE = WS_X1 + 64 * MiB;
constexpr size_t WS_H = WS_ROUTE + 2 * MiB;
constexpr size_t WS_CONTRIB = WS_H + 144 * MiB;
constexpr size_t WS_END = WS_CONTRIB + 144 * MiB;
constexpr size_t R_TOPI = 0;
constexpr size_t R_TOPG = 256 * 1024;
constexpr size_t R_POS = 512 * 1024;
constexpr size_t R_ROWTOK = 768 * 1024;
constexpr size_t R_ROWGATE = 1088 * 1024;
constexpr size_t R_HIST = 1408 * 1024;
constexpr size_t R_META = 1472 * 1024;
constexpr int CW_BAR = 4096;

constexpr int LDS_BYTES = 160 * 1024 - 2048;
constexpr int MISC_OFF = LDS_BYTES - 1024;

__device__ __forceinline__ unsigned f2bf(float f) { unsigned u = __builtin_bit_cast(unsigned, f); return (u + 0x7fffu + ((u >> 16) & 1u)) >> 16; }
__device__ __forceinline__ unsigned pk2(float lo, float hi) { return f2bf(lo) | (f2bf(hi) << 16); }
__device__ __forceinline__ float bf2f(unsigned short b) { return __builtin_bit_cast(float, (unsigned)b << 16); }
__device__ __forceinline__ float bflo(unsigned w) { return __builtin_bit_cast(float, w << 16); }
__device__ __forceinline__ float bfhi(unsigned w) { return __builtin_bit_cast(float, w & 0xffff0000u); }
__device__ __forceinline__ unsigned cvt_pk_bf16(float lo, float hi) { unsigned r; asm volatile("v_cvt_pk_bf16_f32 %0, %1, %2" : "=v"(r) : "v"(lo), "v"(hi)); return r; }
__device__ __forceinline__ float wave_sum(float v) {
#pragma unroll
    for (int o = 1; o < 64; o <<= 1) v += __shfl_xor(v, o);
    return v;
}
__device__ __forceinline__ float sigmoidf_(float x) { return 1.0f / (1.0f + __expf(-x)); }
__device__ __forceinline__ float log_sigmoidf_(float x) { return fminf(x, 0.f) - log1pf(__expf(-fabsf(x))); }
#define LDS_WAIT() asm volatile("s_waitcnt lgkmcnt(0)" ::: "memory")
#define VM_WAIT() asm volatile("s_waitcnt vmcnt(0)" ::: "memory")

#define XB_TMO      128
#define XB_XCNT(j)  (256  + 64 * (j))
#define XB_XSUB(j)  (1280 + 64 * (j))
#define XB_XGEN(j)  (2304 + 64 * (j))
#define XB_TOP      3328
#define XB_TOPGEN   3392
#define XCD_BAR_WORDS 3456
#define XB_SPIN_CAP (1u << 18)
__device__ __forceinline__ unsigned xb_ld(unsigned* p)              { return __hip_atomic_load(p, __ATOMIC_RELAXED, __HIP_MEMORY_SCOPE_AGENT); }
__device__ __forceinline__ unsigned xb_add(unsigned* p, unsigned v) { return __hip_atomic_fetch_add(p, v, __ATOMIC_RELAXED, __HIP_MEMORY_SCOPE_AGENT); }
__device__ __forceinline__ unsigned xb_xcc_id() { return (unsigned)__builtin_amdgcn_s_getreg((3 << 11) | 20) & 0xFu; }
#define XB_SPIN(cond, bar) do { unsigned _sp = 0; while (cond) { __builtin_amdgcn_s_sleep(1); \
    if ((++_sp & 255u) == 0u) { if (xb_ld(&(bar)[XB_TMO])) break; if (_sp > XB_SPIN_CAP) { atomicAdd(&(bar)[XB_TMO], 1u); break; } } } } while (0)
struct XcdBarrier { unsigned* bar; unsigned x; volatile LAS unsigned* st; };
__device__ __forceinline__ XcdBarrier xcd_barrier_post(unsigned* bar, volatile LAS unsigned* st) {
    XcdBarrier b; b.bar = bar; b.x = xb_xcc_id(); b.st = st;
    if (threadIdx.x == 0) (void)xb_add(&bar[XB_XCNT(b.x)], 1u);
    return b;
}
__device__ __forceinline__ void xcd_barrier_complete(unsigned* bar, unsigned x, unsigned& nloc, unsigned& nx) {
    const unsigned G = gridDim.x * gridDim.y * gridDim.z;
    unsigned sum, cnt, mine, sp = 0u;
    for (;;) {
        sum = 0u; cnt = 0u; mine = 0u;
#pragma unroll
        for (unsigned j = 0; j < 16; ++j) { const unsigned c = xb_ld(&bar[XB_XCNT(j)]); sum += c; cnt += (c > 0u) ? 1u : 0u; mine = (j == x) ? c : mine; }
        if (sum == G) break;
        __builtin_amdgcn_s_sleep(1);
        if ((++sp & 255u) == 0u) { if (xb_ld(&bar[XB_TMO])) break; if (sp > XB_SPIN_CAP) { atomicAdd(&bar[XB_TMO], 1u); break; } }
    }
    nloc = mine > 0u ? mine : 1u; nx = cnt > 0u ? cnt : 1u;
}
__device__ __forceinline__ void xcd_barrier(const XcdBarrier& b) {
    asm volatile("s_waitcnt vmcnt(0)" ::: "memory");
    __syncthreads();
    if (threadIdx.x == 0) {
        unsigned* bar = b.bar;
        __builtin_amdgcn_s_waitcnt(0);
        unsigned nloc = b.st[0], nx = b.st[1];
        if (nloc == 0u) { xcd_barrier_complete(bar, b.x, nloc, nx); b.st[0] = nloc; b.st[1] = nx; }
        const unsigned old = xb_add(&bar[XB_XSUB(b.x)], 1u);
        const unsigned gen = old / nloc;
        if (old + 1u == (gen + 1u) * nloc) {
            __builtin_amdgcn_fence(__ATOMIC_RELEASE, "agent");
            asm volatile("s_waitcnt vmcnt(0)" ::: "memory");
            const unsigned og = xb_add(&bar[XB_TOP], 1u);
            const unsigned tg = og / nx;
            if (og + 1u == (tg + 1u) * nx) xb_add(&bar[XB_TOPGEN], 1u);
            else XB_SPIN(xb_ld(&bar[XB_TOPGEN]) == tg, bar);
            __builtin_amdgcn_fence(__ATOMIC_ACQUIRE, "agent");
            xb_add(&bar[XB_XGEN(b.x)], 1u);
            asm volatile("s_waitcnt vmcnt(0)" ::: "memory");
        } else {
            XB_SPIN(xb_ld(&bar[XB_XGEN(b.x)]) == gen, bar);
            __builtin_amdgcn_fence(__ATOMIC_ACQUIRE, "agent");
            asm volatile("s_waitcnt vmcnt(0)" ::: "memory");
        }
    }
    __syncthreads();
}

namespace pg8 {
constexpr int BM = 256, BK = 64, HALF = 128, HTB = HALF * BK * 2, STAGE_BYTES = 8 * HTB, NXCD = 8, WGM = 8;
__host__ __device__ __forceinline__ int lds_byte(int r, int c) { const int st = (r >> 4) * 2 + (c >> 5), rr = r & 15, cc = c & 31, ob = rr * 64 + cc * 2; return st * 1024 + (ob ^ (((ob >> 9) & 1) << 5)); }
__host__ __device__ __forceinline__ void stage_rc(int b, int& R, int& C) { const int st = b / 1024, sb = b % 1024, swz = sb ^ (((sb >> 9) & 1) << 5); R = (st >> 1) * 16 + swz / 64; C = (st & 1) * 32 + (swz % 64) / 2; }
__host__ __device__ __forceinline__ int perm32(int rho) { const int n = rho >> 4, i = rho & 15; return 8 * (i >> 2) + 4 * n + (i & 3); }
struct Unit { int pm, pn, pb; };
struct StaticOrder {
    int nM, nN, nwg, G, c;
    __host__ __device__ void init(int nM_, int nN_, int G_, int c_) { nM = nM_; nN = nN_; nwg = nM * nN; G = G_; c = c_; }
    __host__ __device__ bool next(int i, Unit& u) const {
        const long L = (long)i * G + c; if (L >= nwg) return false;
        int wgid = (int)L; { const int q = nwg / NXCD, r = nwg % NXCD, xcd = wgid % NXCD, off = wgid / NXCD; wgid = (xcd < r ? xcd * (q + 1) : r * (q + 1) + (xcd - r) * q) + off; }
        const int nig = WGM * nN, gid = wgid / nig, fm = gid * WGM, gsz = (nM - fm) < WGM ? (nM - fm) : WGM;
        u.pm = fm + ((wgid % nig) % gsz); u.pn = (wgid % nig) / gsz; u.pb = u.pn; return true;
    }
};
struct MoeOrder {
    StaticOrder so; const int* tile_expert;
    __device__ bool next(int i, Unit& u) const { if (!so.next(i, u)) return false; u.pb = tile_expert[u.pm] * so.nN + u.pn; return true; }
};

template <class Epi, class Sched, bool ALIGN_EPI>
__device__ __forceinline__ void gemm_phase(LAS unsigned char* lds, const bf16_t* A, const bf16_t* Bt, const int K, const int* rowidx, const Sched& S, const Epi& E) {
    const int tid = threadIdx.x, wid = __builtin_amdgcn_readfirstlane(tid >> 6), lane = tid & 63, wr = wid >> 2, wc = wid & 3, fr = lane & 15, fq = lane >> 4;
    const int nt = K / BK;
    unsigned voffB[2];
#pragma unroll
    for (int i = 0; i < 2; ++i) { int R, C; stage_rc(tid * 16 + i * 8192, R, C); const int Rb = Epi::PERM ? ((R & ~31) + perm32(R & 31)) : R; voffB[i] = (unsigned)(Rb * K + C) * 2u; }
    const size_t kstep = (size_t)(BK * 2);
    const size_t hstep = (size_t)HALF * K * 2;
    const size_t tstep = 2 * hstep;
    const unsigned ldsw = (unsigned)wid * 1024u;
    const int aoff = lds_byte(wr * 64 + fr, fq * 8), boff = lds_byte(wc * 32 + fr, fq * 8);
#define PG8_SA(b, h) (((b) * 2 + (h)) * HTB)
#define PG8_SB(b, h) ((4 + (b) * 2 + (h)) * HTB)
#define PG8_STAGE(bufoff, gbase, voff) do { _Pragma("unroll") for (int _i = 0; _i < 2; ++_i) \
        __builtin_amdgcn_global_load_lds((const unsigned*)((const char*)(gbase) + (voff)[_i]), (LAS unsigned*)(lds + (bufoff) + ldsw + _i * 8192), 16, 0, 0); } while (0)
#define PG8_LDA(dst, b, h) do { _Pragma("unroll") for (int m = 0; m < 4; ++m) _Pragma("unroll") for (int k = 0; k < 2; ++k) dst[m][k] = *(const LAS bf16x8*)(lds + PG8_SA(b, h) + aoff + m * 2048 + k * 1024); } while (0)
#define PG8_LDB(dst, b, h) do { _Pragma("unroll") for (int n = 0; n < 2; ++n) _Pragma("unroll") for (int k = 0; k < 2; ++k) dst[n][k] = *(const LAS bf16x8*)(lds + PG8_SB(b, h) + boff + n * 2048 + k * 1024); } while (0)
#define PG8_MMA(ai, bj, At, Bt_) do { __builtin_amdgcn_s_setprio(1); _Pragma("unroll") for (int m = 0; m < 4; ++m) _Pragma("unroll") for (int n = 0; n < 2; ++n) _Pragma("unroll") for (int k = 0; k < 2; ++k) \
        acc[ai][bj][m][n] = __builtin_amdgcn_mfma_f32_16x16x32_bf16(Bt_[n][k], At[m][k], acc[ai][bj][m][n], 0, 0, 0); __builtin_amdgcn_s_setprio(0); } while (0)
#define PG8_WAIT_V(n) asm volatile("s_waitcnt vmcnt(" #n ")" ::: "memory")
#define PG8_WAIT_L(n) asm volatile("s_waitcnt lgkmcnt(" #n ")" ::: "memory")
#define PG8_BAR __builtin_amdgcn_s_barrier()
#define PG8_SCHED __builtin_amdgcn_sched_barrier(0)
#define PG8_AOFF(dst, u) do { _Pragma("unroll") for (int _h = 0; _h < 2; ++_h) _Pragma("unroll") for (int _i = 0; _i < 2; ++_i) { int _R, _C; stage_rc(tid * 16 + _i * 8192, _R, _C); \
        const int _r = (u).pm * BM + _h * HALF + _R; const int _src = rowidx ? rowidx[_r] : _r; dst[_h][_i] = (unsigned)(_src * K + _C) * 2u; } } while (0)
    Unit cur, nxt; int ui = 0;
    if (!S.next(0, cur)) return;
    f32x4 acc[2][2][4][2];
#pragma unroll
    for (int a = 0; a < 2; ++a)
#pragma unroll
        for (int b = 0; b < 2; ++b)
#pragma unroll
            for (int m = 0; m < 4; ++m)
#pragma unroll
                for (int n = 0; n < 2; ++n) acc[a][b][m][n] = (f32x4){0.f, 0.f, 0.f, 0.f};
    bf16x8 At[4][2], B0[2][2], B1[2][2];
    unsigned ca[2][2], na[2][2];
    PG8_AOFF(ca, cur);
    if (rowidx) VM_WAIT();
    const char* cA = (const char*)A; const char* cB = (const char*)Bt + (size_t)cur.pb * tstep;
    PG8_STAGE(PG8_SB(0, 0), cB, voffB); PG8_STAGE(PG8_SB(0, 1), cB + hstep, voffB); PG8_STAGE(PG8_SA(0, 0), cA, ca[0]); PG8_STAGE(PG8_SA(0, 1), cA, ca[1]);
    if (wr == 1) PG8_BAR;
    PG8_WAIT_V(2); PG8_BAR;
    PG8_STAGE(PG8_SB(1, 0), cB + kstep, voffB); PG8_STAGE(PG8_SA(1, 0), cA + kstep, ca[0]); PG8_STAGE(PG8_SB(1, 1), cB + hstep + kstep, voffB);
    PG8_WAIT_V(6); PG8_BAR;
    for (;;) {
        const bool has_next = S.next(ui + 1, nxt);
        if (has_next) { PG8_AOFF(na, nxt); }
        else {
#pragma unroll
            for (int h = 0; h < 2; ++h)
#pragma unroll
                for (int i = 0; i < 2; ++i) na[h][i] = ca[h][i];
        }
        const char* nB = has_next ? (const char*)Bt + (size_t)nxt.pb * tstep : cB;
        for (int t = 0; t < nt; t += 2) {
            const bool last = (t == nt - 2);
            const char* a1 = cA + (size_t)(t + 1) * kstep;
            const char* a2 = last ? cA : cA + (size_t)(t + 2) * kstep; const char* b2 = last ? nB : cB + (size_t)(t + 2) * kstep;
            const char* a3 = a2 + kstep; const char* b3 = b2 + kstep;
            unsigned o2[2][2];
#pragma unroll
            for (int h = 0; h < 2; ++h)
#pragma unroll
                for (int i = 0; i < 2; ++i) o2[h][i] = last ? na[h][i] : ca[h][i];
            PG8_LDB(B0, 0, 0); PG8_LDB(B1, 0, 1); PG8_SCHED; PG8_LDA(At, 0, 0); PG8_STAGE(PG8_SA(1, 1), a1, ca[1]);
            PG8_WAIT_V(8); PG8_WAIT_L(0); PG8_BAR; PG8_MMA(0, 0, At, B0); PG8_MMA(0, 1, At, B1); PG8_BAR; PG8_SCHED;
            PG8_LDA(At, 0, 1); PG8_STAGE(PG8_SB(0, 0), b2, voffB); PG8_STAGE(PG8_SB(0, 1), b2 + hstep, voffB); PG8_STAGE(PG8_SA(0, 0), a2, o2[0]);
            PG8_WAIT_V(8); PG8_WAIT_L(0); PG8_BAR; PG8_MMA(1, 0, At, B0); PG8_MMA(1, 1, At, B1); PG8_BAR; PG8_SCHED;
            PG8_LDB(B0, 1, 0); PG8_LDB(B1, 1, 1); PG8_SCHED; PG8_LDA(At, 1, 0); PG8_STAGE(PG8_SA(0, 1), a2, o2[1]);
            PG8_WAIT_V(8); PG8_WAIT_L(0); PG8_BAR; PG8_MMA(0, 0, At, B0); PG8_MMA(0, 1, At, B1); PG8_BAR; PG8_SCHED;
            PG8_LDA(At, 1, 1); PG8_STAGE(PG8_SB(1, 0), b3, voffB); PG8_STAGE(PG8_SB(1, 1), b3 + hstep, voffB); PG8_STAGE(PG8_SA(1, 0), a3, o2[0]);
            PG8_WAIT_V(8); PG8_WAIT_L(0); PG8_BAR; PG8_MMA(1, 0, At, B0); PG8_MMA(1, 1, At, B1); PG8_BAR; PG8_SCHED;
        }
        if constexpr (ALIGN_EPI) { if (wr == 0) PG8_BAR; }
        E(acc, cur, wr, wc, fr, fq);
        if (!has_next) break;
#pragma unroll
        for (int a = 0; a < 2; ++a)
#pragma unroll
            for (int b = 0; b < 2; ++b)
#pragma unroll
                for (int m = 0; m < 4; ++m)
#pragma unroll
                    for (int n = 0; n < 2; ++n) acc[a][b][m][n] = (f32x4){0.f, 0.f, 0.f, 0.f};
        cur = nxt; cB = nB; ++ui;
#pragma unroll
        for (int h = 0; h < 2; ++h)
#pragma unroll
            for (int i = 0; i < 2; ++i) ca[h][i] = na[h][i];
        if constexpr (ALIGN_EPI) { if (wr == 1) PG8_BAR; }
    }
    PG8_WAIT_V(0);
    if constexpr (!ALIGN_EPI) { if (wr == 0) PG8_BAR; }
    PG8_BAR;
#undef PG8_SA
#undef PG8_SB
#undef PG8_STAGE
#undef PG8_LDA
#undef PG8_LDB
#undef PG8_MMA
#undef PG8_WAIT_V
#undef PG8_WAIT_L
#undef PG8_BAR
#undef PG8_SCHED
#undef PG8_AOFF
}

struct EpiBf16 {
    static constexpr bool PERM = true;
    bf16_t* O; int ldc;
    __device__ __forceinline__ void operator()(const f32x4 (&acc)[2][2][4][2], const Unit& u, int wr, int wc, int fr, int fq) const {
        const int row0 = u.pm * BM + wr * 64 + fr, col0 = u.pn * BM + wc * 32 + 8 * fq;
#pragma unroll
        for (int ai = 0; ai < 2; ++ai)
#pragma unroll
            for (int m = 0; m < 4; ++m) { bf16_t* rowp = O + (size_t)(row0 + ai * HALF + m * 16) * ldc + col0;
#pragma unroll
                for (int bj = 0; bj < 2; ++bj) { const f32x4 v0 = acc[ai][bj][m][0], v1 = acc[ai][bj][m][1];
                    u32x4 w; w.x = cvt_pk_bf16(v0[0], v0[1]); w.y = cvt_pk_bf16(v0[2], v0[3]); w.z = cvt_pk_bf16(v1[0], v1[1]); w.w = cvt_pk_bf16(v1[2], v1[3]);
                    *(u32x4*)(rowp + bj * HALF) = w; } }
    }
};
struct EpiResF32 {
    static constexpr bool PERM = false;
    const float* base; float* C; int ldc;
    __device__ __forceinline__ void operator()(const f32x4 (&acc)[2][2][4][2], const Unit& u, int wr, int wc, int fr, int fq) const {
        const int row0 = u.pm * BM + wr * 64 + fr, col0 = u.pn * BM + wc * 32 + 4 * fq;
#pragma unroll
        for (int ai = 0; ai < 2; ++ai)
#pragma unroll
            for (int m = 0; m < 4; ++m) { const size_t off = (size_t)(row0 + ai * HALF + m * 16) * ldc + col0;
#pragma unroll
                for (int bj = 0; bj < 2; ++bj)
#pragma unroll
                    for (int n = 0; n < 2; ++n) { const f32x4 bs = *(const f32x4*)(base + off + bj * HALF + n * 16); *(f32x4*)(C + off + bj * HALF + n * 16) = bs + acc[ai][bj][m][n]; }
                asm volatile("" ::: "memory"); }
    }
};
struct EpiSwiglu {
    static constexpr bool PERM = true;
    bf16_t* Hb; const float* bgu; const int* tile_expert;
    __device__ __forceinline__ void operator()(const f32x4 (&acc)[2][2][4][2], const Unit& u, int wr, int wc, int fr, int fq) const {
        const int e = tile_expert[u.pm];
        const int row0 = u.pm * BM + wr * 64 + fr, col0 = u.pn * HALF + wc * 32 + 8 * fq;
        const float* bg = bgu + (size_t)e * 2048 + col0; const float* bu = bg + 1024;
        const f32x4 g0 = *(const f32x4*)bg, g1 = *(const f32x4*)(bg + 4), u0 = *(const f32x4*)bu, u1 = *(const f32x4*)(bu + 4);
#pragma unroll
        for (int ai = 0; ai < 2; ++ai)
#pragma unroll
            for (int m = 0; m < 4; ++m) {
                float r[8];
#pragma unroll
                for (int n = 0; n < 2; ++n)
#pragma unroll
                    for (int j = 0; j < 4; ++j) {
                        float gt = acc[ai][0][m][n][j] + (n ? g1[j] : g0[j]); float up = acc[ai][1][m][n][j] + (n ? u1[j] : u0[j]);
                        gt = fminf(gt, 7.0f); up = fminf(fmaxf(up, -7.0f), 7.0f);
                        const float glu = gt * sigmoidf_(gt * 1.702f);
                        r[n * 4 + j] = (up + 1.0f) * glu; }
                u32x4 w; w.x = cvt_pk_bf16(r[0], r[1]); w.y = cvt_pk_bf16(r[2], r[3]); w.z = cvt_pk_bf16(r[4], r[5]); w.w = cvt_pk_bf16(r[6], r[7]);
                *(u32x4*)(Hb + (size_t)(row0 + ai * HALF + m * 16) * FF + col0) = w; }
    }
};
struct EpiDown {
    static constexpr bool PERM = true;
    bf16_t* Cb; const float* bd; const float* row_gate; const int* tile_expert;
    __device__ __forceinline__ void operator()(const f32x4 (&acc)[2][2][4][2], const Unit& u, int wr, int wc, int fr, int fq) const {
        const int e = tile_expert[u.pm];
        const int row0 = u.pm * BM + wr * 64 + fr, col0 = u.pn * BM + wc * 32 + 8 * fq;
        f32x4 bv[2][2];
#pragma unroll
        for (int bj = 0; bj < 2; ++bj)
#pragma unroll
            for (int n = 0; n < 2; ++n) bv[bj][n] = *(const f32x4*)(bd + (size_t)e * D + col0 + bj * HALF + 4 * n);
#pragma unroll
        for (int ai = 0; ai < 2; ++ai)
#pragma unroll
            for (int m = 0; m < 4; ++m) { const int row = row0 + ai * HALF + m * 16; const float gt = row_gate[row]; bf16_t* rowp = Cb + (size_t)row * D + col0;
#pragma unroll
                for (int bj = 0; bj < 2; ++bj) { const f32x4 v0 = (acc[ai][bj][m][0] + bv[bj][0]) * gt, v1 = (acc[ai][bj][m][1] + bv[bj][1]) * gt;
                    u32x4 w; w.x = cvt_pk_bf16(v0[0], v0[1]); w.y = cvt_pk_bf16(v0[2], v0[3]); w.z = cvt_pk_bf16(v1[0], v1[1]); w.w = cvt_pk_bf16(v1[2], v1[3]);
                    *(u32x4*)(rowp + bj * HALF) = w; } }
    }
};
}

struct Args { const float* in[16]; float* out; unsigned char* ws; int ph_lo, ph_hi, li, pad; };
struct Frame {
    LAS unsigned char* lds; int tid, lane, wave, G, bx;
    const float *x, *g_mix, *w_in, *conv_w, *w_gk_up, *b_gk_up, *gla_g, *w_out, *g_ffn, *w_router, *b_router, *w_gu, *b_gu, *w_dn, *b_dn, *g_fin;
    float* out; unsigned char* ws;
};

__device__ __forceinline__ void p0_transpose_item(const float* W, int ldn, int K, int k0, int n0, bf16_t* WT, int drow0, LAS float* scr, int lane) {
#pragma unroll 8
    for (int i = 0; i < 32; ++i) { const int kk = 2 * i + (lane >> 5); scr[kk * 33 + (lane & 31)] = W[(size_t)(k0 + kk) * ldn + n0 + (lane & 31)]; }
    LDS_WAIT(); asm volatile("" ::: "memory");
    const int c = lane & 7;
#pragma unroll
    for (int j = 0; j < 4; ++j) { const int n = (lane >> 3) + 8 * j; const LAS float* s = scr + (8 * c) * 33 + n;
        u32x4 o; o.x = pk2(s[0 * 33], s[1 * 33]); o.y = pk2(s[2 * 33], s[3 * 33]); o.z = pk2(s[4 * 33], s[5 * 33]); o.w = pk2(s[6 * 33], s[7 * 33]);
        *(GAS u32x4*)(WT + (size_t)(drow0 + n) * K + k0 + 8 * c) = o; }
    LDS_WAIT(); asm volatile("" ::: "memory");
}
__device__ __forceinline__ void p0_prep(Frame& F) {
    LAS float* w16t = (LAS float*)F.lds;
    LAS float* scr = (LAS float*)(F.lds + 65536 + F.wave * 8448);
    for (int i = F.tid; i < 1024 * 16; i += NTHR) { const int k = i >> 4, r = i & 15; w16t[r * 1024 + k] = F.w_in[(size_t)k * DIN + C_GKL + r]; }
    __syncthreads();
    const int gw = F.bx * NWAVES + F.wave, NGW = F.G * NWAVES;
    bf16_t* XN = (bf16_t*)(F.ws + WS_XN); float* GKL = (float*)(F.ws + WS_GKL);
    for (int m = gw; m < M; m += NGW) {
        const GAS f32x4* xr = (const GAS f32x4*)(F.x + (size_t)m * D) + F.lane;
        f32x4 v[4]; float s2 = 0.f;
#pragma unroll
        for (int j = 0; j < 4; ++j) { v[j] = xr[64 * j]; s2 += (v[j].x * v[j].x + v[j].y * v[j].y) + (v[j].z * v[j].z + v[j].w * v[j].w); }
        const float rstd = 1.0f / sqrtf(wave_sum(s2) * (1.0f / D) + RMS_EPS);
        GAS u32x2* o8 = (GAS u32x2*)(XN + (size_t)m * D) + F.lane;
#pragma unroll
        for (int j = 0; j < 4; ++j) { const f32x4 g = *((const GAS f32x4*)F.g_mix + F.lane + 64 * j); v[j] = v[j] * rstd * g;
            u32x2 w; w.x = pk2(v[j].x, v[j].y); w.y = pk2(v[j].z, v[j].w); o8[64 * j] = w; }
        float acc[16];
#pragma unroll
        for (int r = 0; r < 16; ++r) { float a = 0.f;
#pragma unroll
            for (int j = 0; j < 4; ++j) { const f32x4 w = *(const LAS f32x4*)(w16t + r * 1024 + 4 * F.lane + 256 * j); a += (v[j].x * w.x + v[j].y * w.y) + (v[j].z * w.z + v[j].w * w.w); }
            acc[r] = a; if ((r & 3) == 3) asm volatile("" ::: "memory"); }
        float a8[8], a4[4], a2[2], a1;
        { const bool hi = (F.lane & 32) != 0;
#pragma unroll
          for (int i = 0; i < 8; ++i) { const float send = hi ? acc[i] : acc[i + 8]; const float keep = hi ? acc[i + 8] : acc[i]; a8[i] = keep + __shfl_xor(send, 32); } }
        { const bool hi = (F.lane & 16) != 0;
#pragma unroll
          for (int i = 0; i < 4; ++i) { const float send = hi ? a8[i] : a8[i + 4]; const float keep = hi ? a8[i + 4] : a8[i]; a4[i] = keep + __shfl_xor(send, 16); } }
        { const bool hi = (F.lane & 8) != 0;
#pragma unroll
          for (int i = 0; i < 2; ++i) { const float send = hi ? a4[i] : a4[i + 2]; const float keep = hi ? a4[i + 2] : a4[i]; a2[i] = keep + __shfl_xor(send, 8); } }
        { const bool hi = (F.lane & 4) != 0; const float send = hi ? a2[0] : a2[1]; const float keep = hi ? a2[1] : a2[0]; a1 = keep + __shfl_xor(send, 4); }
        a1 += __shfl_xor(a1, 2); a1 += __shfl_xor(a1, 1);
        if ((F.lane & 3) == 0) GKL[(size_t)m * 16 + (F.lane >> 2)] = a1;
    }
    constexpr int I_1 = (D / 64) * (NPROJ / 32), I_O = (D / 64) * (D / 32), I_GU = (D / 64) * (2 * FF / 32), I_DN = (FF / 64) * (D / 32);
    constexpr int NITEMS = I_1 + I_O + NE * (I_GU + I_DN);
    bf16_t* W1T = (bf16_t*)(F.ws + WS_W1T); bf16_t* WOT = (bf16_t*)(F.ws + WS_WOT); bf16_t* WGUT = (bf16_t*)(F.ws + WS_WGUT); bf16_t* WDT = (bf16_t*)(F.ws + WS_WDT);
    for (int it = gw; it < NITEMS; it += NGW) {
        int r = it;
        if (r < I_1) { const int nblk = NPROJ / 32, kb = r / nblk, nb = r % nblk; p0_transpose_item(F.w_in, DIN, D, 64 * kb, 32 * nb, W1T, 32 * nb, scr, F.lane); continue; } r -= I_1;
        if (r < I_O) { const int nblk = D / 32, kb = r / nblk, nb = r % nblk; p0_transpose_item(F.w_out, D, D, 64 * kb, 32 * nb, WOT, 32 * nb, scr, F.lane); continue; } r -= I_O;
        const int e = r / (I_GU + I_DN); r -= e * (I_GU + I_DN);
        if (r < I_GU) { const int nblk = 2 * FF / 32, kb = r / nblk, nb = r % nblk; const int n0 = 32 * nb, half = n0 / FF, j = n0 % FF, pn = j / 128, i0 = j % 128;
            p0_transpose_item(F.w_gu + (size_t)e * D * 2 * FF, 2 * FF, D, 64 * kb, n0, WGUT + (size_t)e * 2 * FF * D, pn * 256 + half * 128 + i0, scr, F.lane); continue; } r -= I_GU;
        { const int nblk = D / 32, kb = r / nblk, nb = r % nblk; p0_transpose_item(F.w_dn + (size_t)e * FF * D, D, FF, 64 * kb, 32 * nb, WDT + (size_t)e * D * FF, 32 * nb, scr, F.lane); }
    }
}

__device__ __forceinline__ void gla_decay(Frame& F, int tok, int h, float (&bc)[8], float (&blast)[8]) {
    const float* GKL = (const float*)(F.ws + WS_GKL);
    float gl[16];
#pragma unroll
    for (int q = 0; q < 4; ++q) { const f32x4 t = *(const f32x4*)(GKL + (size_t)tok * 16 + 4 * q); gl[4 * q] = t.x; gl[4 * q + 1] = t.y; gl[4 * q + 2] = t.z; gl[4 * q + 3] = t.w; }
    const int dbase = h * DK + 8 * F.wave;
#pragma unroll
    for (int i = 0; i < 8; ++i) {
        float gk = F.b_gk_up[dbase + i];
#pragma unroll
        for (int r = 0; r < 16; ++r) gk += gl[r] * F.w_gk_up[r * (NH * DK) + dbase + i];
        float la = log_sigmoidf_(gk) * (1.0f / 16.0f);
#pragma unroll
        for (int o = 1; o < 64; o <<= 1) { const float t = __shfl_up(la, o); if (F.lane >= o) la += t; }
        bc[i] = la; blast[i] = __shfl(la, 63);
    }
}

constexpr int LP = 72;
__device__ __forceinline__ void p2_gla_kv(Frame& F) {
    const bf16_t* PROJ = (const bf16_t*)(F.ws + WS_PROJ); float* KVT = (float*)(F.ws + WS_KVT); float* DEC = (float*)(F.ws + WS_DEC);
    LAS bf16_t* kremT = (LAS bf16_t*)F.lds;
    LAS bf16_t* vT = (LAS bf16_t*)(F.lds + 64 * LP * 2);
    const int lane = F.lane, w = F.wave;
    for (int u = F.bx; u < NUNITS_GLA; u += F.G) {
        const int b = u / (NH * NCH), h = (u / NCH) % NH, n = u % NCH;
        const int tok = b * SEQ + n * CHUNK + lane;
        float bc[8], blast[8];
        gla_decay(F, tok, h, bc, blast);
        const u32x4 kraw = *(const u32x4*)(PROJ + (size_t)tok * NPROJ + C_K + h * DK + 8 * w);
        const unsigned kw[4] = {kraw.x, kraw.y, kraw.z, kraw.w};
#pragma unroll
        for (int i = 0; i < 8; ++i) { const float kv = (i & 1) ? bfhi(kw[i >> 1]) : bflo(kw[i >> 1]);
            kremT[(8 * w + i) * LP + lane] = (bf16_t)f2bf(kv * __expf(blast[i] - bc[i])); }
        if (lane == 0) {
#pragma unroll
            for (int i = 0; i < 8; ++i) DEC[(size_t)u * DK + 8 * w + i] = __expf(blast[i]);
        }
#pragma unroll
        for (int q = 0; q < 2; ++q) { const u32x4 vraw = *(const u32x4*)(PROJ + (size_t)tok * NPROJ + C_V + h * DV + 16 * w + 8 * q);
            const unsigned vw[4] = {vraw.x, vraw.y, vraw.z, vraw.w};
#pragma unroll
            for (int i = 0; i < 8; ++i) vT[(16 * w + 8 * q + i) * LP + lane] = (bf16_t)((i & 1) ? (vw[i >> 1] >> 16) : (vw[i >> 1] & 0xffffu)); }
        __syncthreads();
        const int fr = lane & 15, fq = lane >> 4;
        bf16x8 a[2];
#pragma unroll
        for (int s = 0; s < 2; ++s) a[s] = *(const LAS bf16x8*)(vT + (16 * w + fr) * LP + 8 * fq + 32 * s);
#pragma unroll
        for (int dt = 0; dt < 4; ++dt) {
            f32x4 c = (f32x4){0.f, 0.f, 0.f, 0.f};
#pragma unroll
            for (int s = 0; s < 2; ++s) { const bf16x8 bb = *(const LAS bf16x8*)(kremT + (16 * dt + fr) * LP + 8 * fq + 32 * s); c = __builtin_amdgcn_mfma_f32_16x16x32_bf16(a[s], bb, c, 0, 0, 0); }
#pragma unroll
            for (int r = 0; r < 4; ++r) KVT[((size_t)u * DV + 16 * w + 4 * fq + r) * DK + 16 * dt + fr] = c[r];
        }
        __syncthreads();
    }
}

__device__ __forceinline__ void p3_scan(Frame& F) {
    const float* KVT = (const float*)(F.ws + WS_KVT); const float* DEC = (const float*)(F.ws + WS_DEC); bf16_t* ST = (bf16_t*)(F.ws + WS_ST);
    for (int gid = F.bx * NTHR + F.tid; gid < BATCH * NH * DV * DK; gid += F.G * NTHR) {
        const int bh = gid >> 13, vd = gid & 8191, d = gid & 63;
        float S = 0.f;
#pragma unroll 8
        for (int n = 0; n < NCH; ++n) { const size_t u = (size_t)bh * NCH + n;
            ST[u * (DV * DK) + vd] = (bf16_t)f2bf(S);
            S = DEC[u * DK + d] * S + KVT[u * (DV * DK) + vd]; }
    }
}

__device__ __forceinline__ void p4_gla_out(Frame& F) {
    const bf16_t* PROJ = (const bf16_t*)(F.ws + WS_PROJ); const bf16_t* ST = (const bf16_t*)(F.ws + WS_ST); bf16_t* Y = (bf16_t*)(F.ws + WS_Y);
    LAS bf16_t* qd = (LAS bf16_t*)F.lds;
    LAS bf16_t* kd = (LAS bf16_t*)(F.lds + 64 * LP * 2);
    LAS bf16_t* vT = (LAS bf16_t*)(F.lds + 2 * 64 * LP * 2);
    LAS bf16_t* pm = (LAS bf16_t*)(F.lds + 4 * 64 * LP * 2);
    LAS float* red = (LAS float*)(F.lds + 5 * 64 * LP * 2);
    const int lane = F.lane, w = F.wave, fr = lane & 15, fq = lane >> 4;
    for (int u = F.bx; u < NUNITS_GLA; u += F.G) {
        const int b = u / (NH * NCH), h = (u / NCH) % NH, n = u % NCH;
        const int tok0 = b * SEQ + n * CHUNK, tok = tok0 + lane;
        float bc[8], blast[8];
        gla_decay(F, tok, h, bc, blast);
        { const u32x4 qraw = *(const u32x4*)(PROJ + (size_t)tok * NPROJ + C_Q + h * DK + 8 * w);
          const u32x4 kraw = *(const u32x4*)(PROJ + (size_t)tok * NPROJ + C_K + h * DK + 8 * w);
          const unsigned qw[4] = {qraw.x, qraw.y, qraw.z, qraw.w}, kw[4] = {kraw.x, kraw.y, kraw.z, kraw.w};
          u32x4 qo, ko; unsigned qq[4], kk[4];
#pragma unroll
          for (int p = 0; p < 4; ++p) { const float e0 = __expf(bc[2 * p]), e1 = __expf(bc[2 * p + 1]);
              qq[p] = pk2(bflo(qw[p]) * 0.125f * e0, bfhi(qw[p]) * 0.125f * e1);
              kk[p] = pk2(bflo(kw[p]) * __expf(-bc[2 * p]), bfhi(kw[p]) * __expf(-bc[2 * p + 1])); }
          qo.x = qq[0]; qo.y = qq[1]; qo.z = qq[2]; qo.w = qq[3]; ko.x = kk[0]; ko.y = kk[1]; ko.z = kk[2]; ko.w = kk[3];
          *(LAS u32x4*)(qd + lane * LP + 8 * w) = qo; *(LAS u32x4*)(kd + lane * LP + 8 * w) = ko; }
#pragma unroll
        for (int q = 0; q < 2; ++q) { const u32x4 vraw = *(const u32x4*)(PROJ + (size_t)tok * NPROJ + C_V + h * DV + 16 * w + 8 * q);
            const unsigned vw[4] = {vraw.x, vraw.y, vraw.z, vraw.w};
#pragma unroll
            for (int i = 0; i < 8; ++i) vT[(16 * w + 8 * q + i) * LP + lane] = (bf16_t)((i & 1) ? (vw[i >> 1] >> 16) : (vw[i >> 1] & 0xffffu)); }
        __syncthreads();
        { const int ct = w >> 1;
          bf16x8 a[2];
#pragma unroll
          for (int s = 0; s < 2; ++s) a[s] = *(const LAS bf16x8*)(qd + (16 * ct + fr) * LP + 8 * fq + 32 * s);
#pragma unroll
          for (int jj = 0; jj < 2; ++jj) { const int jt = 2 * (w & 1) + jj;
              f32x4 c = (f32x4){0.f, 0.f, 0.f, 0.f};
#pragma unroll
              for (int s = 0; s < 2; ++s) { const bf16x8 bb = *(const LAS bf16x8*)(kd + (16 * jt + fr) * LP + 8 * fq + 32 * s); c = __builtin_amdgcn_mfma_f32_16x16x32_bf16(a[s], bb, c, 0, 0, 0); }
#pragma unroll
              for (int r = 0; r < 4; ++r) { const int cc = 16 * ct + 4 * fq + r, jcol = 16 * jt + fr; pm[cc * LP + jcol] = (bf16_t)f2bf(jcol <= cc ? c[r] : 0.f); } } }
        __syncthreads();
        const int ct = w & 3, vt0 = 4 * (w >> 2);
        bf16x8 ap[2], aq[2];
#pragma unroll
        for (int s = 0; s < 2; ++s) { ap[s] = *(const LAS bf16x8*)(pm + (16 * ct + fr) * LP + 8 * fq + 32 * s); aq[s] = *(const LAS bf16x8*)(qd + (16 * ct + fr) * LP + 8 * fq + 32 * s); }
        f32x4 o[4]; float ss[4] = {0.f, 0.f, 0.f, 0.f};
#pragma unroll
        for (int vi = 0; vi < 4; ++vi) { const int vt = vt0 + vi;
            f32x4 c = (f32x4){0.f, 0.f, 0.f, 0.f};
#pragma unroll
            for (int s = 0; s < 2; ++s) { const bf16x8 bb = *(const LAS bf16x8*)(vT + (16 * vt + fr) * LP + 8 * fq + 32 * s); c = __builtin_amdgcn_mfma_f32_16x16x32_bf16(ap[s], bb, c, 0, 0, 0); }
#pragma unroll
            for (int s = 0; s < 2; ++s) { const bf16x8 bb = *(const bf16x8*)(ST + ((size_t)u * DV + 16 * vt + fr) * DK + 8 * fq + 32 * s); c = __builtin_amdgcn_mfma_f32_16x16x32_bf16(aq[s], bb, c, 0, 0, 0); }
            o[vi] = c;
#pragma unroll
            for (int r = 0; r < 4; ++r) ss[r] += c[r] * c[r]; }
#pragma unroll
        for (int r = 0; r < 4; ++r) { float t = ss[r]; t += __shfl_xor(t, 1); t += __shfl_xor(t, 2); t += __shfl_xor(t, 4); t += __shfl_xor(t, 8); ss[r] = t; }
        if (fr == 0) {
#pragma unroll
            for (int r = 0; r < 4; ++r) red[w * 16 + 4 * fq + r] = ss[r];
        }
        __syncthreads();
#pragma unroll
        for (int r = 0; r < 4; ++r) { const float tot = red[ct * 16 + 4 * fq + r] + red[(ct + 4) * 16 + 4 * fq + r]; const float rstd = 1.0f / sqrtf(tot * (1.0f / DV) + RMS_EPS);
            const int trow = tok0 + 16 * ct + 4 * fq + r;
#pragma unroll
            for (int vi = 0; vi < 4; ++vi) { const int v = 16 * (vt0 + vi) + fr;
                const float g = bf2f(PROJ[(size_t)trow * NPROJ + C_G + h * DV + v]);
                const float val = o[vi][r] * rstd * F.gla_g[v] * (g * sigmoidf_(g));
                Y[(size_t)trow * D + CONVW + h * DV + v] = (bf16_t)f2bf(val); } }
        __syncthreads();
    }
    for (int it = F.bx * NTHR + F.tid; it < M * (CONVW / 8); it += F.G * NTHR) {
        const int t = it >> 6, c8 = (it & 63) * 8, s = t & (SEQ - 1);
        float acc[8];
#pragma unroll
        for (int j = 0; j < 8; ++j) acc[j] = 0.f;
#pragma unroll
        for (int i = 0; i < 3; ++i) { const int sp = s - 2 + i; if (sp < 0) continue;
            const size_t ro = (size_t)(t - 2 + i) * NPROJ;
            const u32x4 uh = *(const u32x4*)(PROJ + ro + C_UH + c8), gc = *(const u32x4*)(PROJ + ro + C_GC + c8);
            const unsigned uw[4] = {uh.x, uh.y, uh.z, uh.w}, gw[4] = {gc.x, gc.y, gc.z, gc.w};
            const f32x4 w0 = *(const f32x4*)(F.conv_w + i * CONVW + c8), w1 = *(const f32x4*)(F.conv_w + i * CONVW + c8 + 4);
            const float ww[8] = {w0.x, w0.y, w0.z, w0.w, w1.x, w1.y, w1.z, w1.w};
#pragma unroll
            for (int p = 0; p < 4; ++p) { acc[2 * p] += ww[2 * p] * (bflo(uw[p]) * bflo(gw[p])); acc[2 * p + 1] += ww[2 * p + 1] * (bfhi(uw[p]) * bfhi(gw[p])); } }
        const u32x4 gb = *(const u32x4*)(PROJ + (size_t)t * NPROJ + C_GB + c8); const unsigned bw[4] = {gb.x, gb.y, gb.z, gb.w};
        u32x4 o;
        o.x = pk2(bflo(bw[0]) * acc[0], bfhi(bw[0]) * acc[1]); o.y = pk2(bflo(bw[1]) * acc[2], bfhi(bw[1]) * acc[3]);
        o.z = pk2(bflo(bw[2]) * acc[4], bfhi(bw[2]) * acc[5]); o.w = pk2(bflo(bw[3]) * acc[6], bfhi(bw[3]) * acc[7]);
        *(u32x4*)(Y + (size_t)t * D + c8) = o;
    }
}

__device__ __forceinline__ void p6_router(Frame& F) {
    LAS float* wrT = (LAS float*)F.lds;
    LAS float* lg = (LAS float*)(F.lds + 131072);
    LAS int* hist = (LAS int*)(F.lds + 131072 + 1024);
    const float* X1 = (const float*)(F.ws + WS_X1); bf16_t* XN2 = (bf16_t*)(F.ws + WS_XN);
    int* TOPI = (int*)(F.ws + WS_ROUTE + R_TOPI); float* TOPG = (float*)(F.ws + WS_ROUTE + R_TOPG); int* HIST = (int*)(F.ws + WS_ROUTE + R_HIST);
    for (int i = F.tid; i < 1024 * 32; i += NTHR) { const int k = i >> 5, e = i & 31; wrT[e * 1024 + k] = F.w_router[i]; }
    const int lane = F.lane;
    for (int wg = F.bx; wg < M / 64; wg += F.G) {
        if (F.tid < 32) hist[F.tid] = 0;
        __syncthreads();
        for (int ti = 0; ti < 8; ++ti) {
            const int m = wg * 64 + F.wave * 8 + ti;
            const GAS f32x4* xr = (const GAS f32x4*)(X1 + (size_t)m * D) + lane;
            f32x4 v[4]; float s2 = 0.f;
#pragma unroll
            for (int j = 0; j < 4; ++j) { v[j] = xr[64 * j]; s2 += (v[j].x * v[j].x + v[j].y * v[j].y) + (v[j].z * v[j].z + v[j].w * v[j].w); }
            const float rstd = 1.0f / sqrtf(wave_sum(s2) * (1.0f / D) + RMS_EPS);
            GAS u32x2* o8 = (GAS u32x2*)(XN2 + (size_t)m * D) + lane;
#pragma unroll
            for (int j = 0; j < 4; ++j) { const f32x4 g = *((const GAS f32x4*)F.g_ffn + lane + 64 * j); v[j] = v[j] * rstd * g;
                u32x2 w; w.x = pk2(v[j].x, v[j].y); w.y = pk2(v[j].z, v[j].w); o8[64 * j] = w; }
            float res[2];
#pragma unroll
            for (int grp = 0; grp < 2; ++grp) {
                float acc[16];
#pragma unroll
                for (int r = 0; r < 16; ++r) { float a = 0.f;
#pragma unroll
                    for (int j = 0; j < 4; ++j) { const f32x4 w = *(const LAS f32x4*)(wrT + (grp * 16 + r) * 1024 + 4 * lane + 256 * j); a += (v[j].x * w.x + v[j].y * w.y) + (v[j].z * w.z + v[j].w * w.w); }
                    acc[r] = a; if ((r & 3) == 3) asm volatile("" ::: "memory"); }
                float a8[8], a4[4], a2[2], a1;
                { const bool hi = (lane & 32) != 0;
#pragma unroll
                  for (int i = 0; i < 8; ++i) { const float send = hi ? acc[i] : acc[i + 8]; const float keep = hi ? acc[i + 8] : acc[i]; a8[i] = keep + __shfl_xor(send, 32); } }
                { const bool hi = (lane & 16) != 0;
#pragma unroll
                  for (int i = 0; i < 4; ++i) { const float send = hi ? a8[i] : a8[i + 4]; const float keep = hi ? a8[i + 4] : a8[i]; a4[i] = keep + __shfl_xor(send, 16); } }
                { const bool hi = (lane & 8) != 0;
#pragma unroll
                  for (int i = 0; i < 2; ++i) { const float send = hi ? a4[i] : a4[i + 2]; const float keep = hi ? a4[i + 2] : a4[i]; a2[i] = keep + __shfl_xor(send, 8); } }
                { const bool hi = (lane & 4) != 0; const float send = hi ? a2[0] : a2[1]; const float keep = hi ? a2[1] : a2[0]; a1 = keep + __shfl_xor(send, 4); }
                a1 += __shfl_xor(a1, 2); a1 += __shfl_xor(a1, 1);
                res[grp] = a1;
            }
            if ((lane & 3) == 0) { const int r = lane >> 2; lg[F.wave * 32 + r] = res[0] + F.b_router[r]; lg[F.wave * 32 + 16 + r] = res[1] + F.b_router[16 + r]; }
            LDS_WAIT(); asm volatile("" ::: "memory");
            if (lane == 0) {
                float l[32];
#pragma unroll
                for (int e = 0; e < 32; ++e) l[e] = lg[F.wave * 32 + e];
                int bi[4]; float bv[4]; unsigned used = 0u;
#pragma unroll
                for (int k = 0; k < 4; ++k) { float best = -3.0e38f; int be = 0;
#pragma unroll
                    for (int e = 0; e < 32; ++e) { const bool ok = !((used >> e) & 1u) && l[e] > best; best = ok ? l[e] : best; be = ok ? e : be; }
                    used |= 1u << be; bi[k] = be; bv[k] = best; }
                const float e1 = __expf(bv[1] - bv[0]), e2 = __expf(bv[2] - bv[0]), e3 = __expf(bv[3] - bv[0]); const float inv = 1.0f / (1.0f + e1 + e2 + e3);
                *(int4*)(TOPI + (size_t)m * 4) = make_int4(bi[0], bi[1], bi[2], bi[3]);
                *(f32x4*)(TOPG + (size_t)m * 4) = (f32x4){inv, e1 * inv, e2 * inv, e3 * inv};
#pragma unroll
                for (int k = 0; k < 4; ++k) atomicAdd((int*)&hist[bi[k]], 1);
            }
            asm volatile("" ::: "memory");
        }
        __syncthreads();
        if (F.tid < 32) HIST[wg * 32 + F.tid] = hist[F.tid];
        __syncthreads();
    }
}

__device__ __forceinline__ void p7_slots(Frame& F) {
    LAS int* part = (LAS int*)F.lds;
    LAS int* cnt = part + 1024;
    LAS int* pre = cnt + 32;
    LAS int* pst = pre + 32;
    LAS int* exa = pst + 64;
    const int* TOPI = (const int*)(F.ws + WS_ROUTE + R_TOPI); const float* TOPG = (const float*)(F.ws + WS_ROUTE + R_TOPG); const int* HIST = (const int*)(F.ws + WS_ROUTE + R_HIST);
    int* POS = (int*)(F.ws + WS_ROUTE + R_POS); int* ROWTOK = (int*)(F.ws + WS_ROUTE + R_ROWTOK); float* ROWGATE = (float*)(F.ws + WS_ROUTE + R_ROWGATE); int* META = (int*)(F.ws + WS_ROUTE + R_META);
    constexpr int NWG = M / 64;
    for (int wg = F.bx; wg < NWG; wg += F.G) {
        { const int e = F.tid & 31, p = F.tid >> 5; int tot = 0, bef = 0;
          for (int q = p * 16; q < p * 16 + 16; ++q) { const int hv = HIST[q * 32 + e]; tot += hv; bef += (q < wg) ? hv : 0; }
          part[(p * 32 + e) * 2] = tot; part[(p * 32 + e) * 2 + 1] = bef; }
        __syncthreads();
        if (F.tid < 32) { int tot = 0, bef = 0; for (int p = 0; p < 16; ++p) { tot += part[(p * 32 + F.tid) * 2]; bef += part[(p * 32 + F.tid) * 2 + 1]; } cnt[F.tid] = tot; pre[F.tid] = bef; }
        __syncthreads();
        if (F.tid == 0) { int s = 0; for (int e = 0; e < 32; ++e) { pst[e] = s; s += (cnt[e] + 255) & ~255; } pst[32] = s; }
        int my_e = 0, tokn = 0, kk = 0; float my_g = 0.f;
        if (F.tid < 256) { tokn = wg * 64 + (F.tid >> 2); kk = F.tid & 3; my_e = TOPI[(size_t)tokn * 4 + kk]; my_g = TOPG[(size_t)tokn * 4 + kk]; exa[F.tid] = my_e; }
        __syncthreads();
        if (F.tid < 256) { int rank = 0; for (int a = 0; a < F.tid; ++a) rank += (exa[a] == my_e) ? 1 : 0;
            const int slot = pst[my_e] + pre[my_e] + rank;
            ROWTOK[slot] = tokn; ROWGATE[slot] = my_g; POS[(size_t)tokn * 4 + kk] = slot; }
        if (wg < NE) { const int e = wg, c = cnt[e], s0 = pst[e] + c, s1 = pst[e] + ((c + 255) & ~255);
            for (int s = s0 + F.tid; s < s1; s += NTHR) { ROWTOK[s] = 0; ROWGATE[s] = 0.f; } }
        if (wg == 0) { if (F.tid == 0) META[0] = pst[32] >> 8;
            for (int t = F.tid; t < NTILES_MAX; t += NTHR) { int e = 0; for (int q = 0; q < 32; ++q) e += (t * 256 >= pst[q + 1]) ? 1 : 0; META[32 + t] = e < 32 ? e : 31; } }
        __syncthreads();
    }
}

__device__ __forceinline__ void p10_combine(Frame& F) {
    const float* X1 = (const float*)(F.ws + WS_X1); const bf16_t* CB = (const bf16_t*)(F.ws + WS_CONTRIB); const int* POS = (const int*)(F.ws + WS_ROUTE + R_POS);
    const int gw = F.bx * NWAVES + F.wave, NGW = F.G * NWAVES;
    for (int m = gw; m < M; m += NGW) {
        const GAS f32x4* xr = (const GAS f32x4*)(X1 + (size_t)m * D) + F.lane;
        f32x4 v[4];
#pragma unroll
        for (int j = 0; j < 4; ++j) v[j] = xr[64 * j];
        const int4 ps = *(const int4*)(POS + (size_t)m * 4); const int pp[4] = {ps.x, ps.y, ps.z, ps.w};
#pragma unroll
        for (int k = 0; k < 4; ++k) { const GAS u32x2* cr = (const GAS u32x2*)(CB + (size_t)pp[k] * D) + F.lane;
#pragma unroll
            for (int j = 0; j < 4; ++j) { const u32x2 c = cr[64 * j]; v[j].x += bflo(c.x); v[j].y += bfhi(c.x); v[j].z += bflo(c.y); v[j].w += bfhi(c.y); } }
        float s2 = 0.f;
#pragma unroll
        for (int j = 0; j < 4; ++j) s2 += (v[j].x * v[j].x + v[j].y * v[j].y) + (v[j].z * v[j].z + v[j].w * v[j].w);
        const float rstd = 1.0f / sqrtf(wave_sum(s2) * (1.0f / D) + RMS_EPS);
        GAS f32x4* orow = (GAS f32x4*)(F.out + (size_t)m * D) + F.lane;
#pragma unroll
        for (int j = 0; j < 4; ++j) { const f32x4 g = *((const GAS f32x4*)F.g_fin + F.lane + 64 * j); orow[64 * j] = v[j] * rstd * g; }
    }
}

__global__ void __launch_bounds__(NTHR, 2) fwd_kernel(Args args) {
    extern __shared__ __attribute__((aligned(16))) unsigned char lds_raw[];
    Frame F;
    F.lds = (LAS unsigned char*)lds_raw;
    F.tid = threadIdx.x; F.lane = F.tid & 63; F.wave = __builtin_amdgcn_readfirstlane(F.tid >> 6); F.G = gridDim.x; F.bx = blockIdx.x;
    F.x = args.in[0]; F.g_mix = args.in[1]; F.w_in = args.in[2]; F.conv_w = args.in[3]; F.w_gk_up = args.in[4]; F.b_gk_up = args.in[5]; F.gla_g = args.in[6]; F.w_out = args.in[7];
    F.g_ffn = args.in[8]; F.w_router = args.in[9]; F.b_router = args.in[10]; F.w_gu = args.in[11]; F.b_gu = args.in[12]; F.w_dn = args.in[13]; F.b_dn = args.in[14]; F.g_fin = args.in[15];
    F.out = args.out; F.ws = args.ws;
    volatile LAS unsigned* MISC = (volatile LAS unsigned*)(F.lds + MISC_OFF);
    for (int u = F.tid; u < 256; u += NTHR) MISC[u] = 0u;
    __syncthreads();
    unsigned* ctl = (unsigned*)(F.ws + WS_CTL);
    XcdBarrier bar; bar.bar = ctl + CW_BAR; bar.x = 0; bar.st = nullptr;
    if (N_LAUNCHES == 1) bar = xcd_barrier_post(ctl + CW_BAR, MISC + 8);
    const int lo = args.ph_lo, hi = args.ph_hi;
#define IN(k) (lo <= (k) && (k) < hi)
#define SEAM(k) do { if (IN(k) && IN((k) + 1)) xcd_barrier(bar); } while (0)
    const int* META = (const int*)(F.ws + WS_ROUTE + R_META);

    if (IN(0)) { p0_prep(F); } SEAM(0);
    if (IN(1)) {
        pg8::StaticOrder S; S.init(M / 256, NPROJ / 256, F.G, F.bx);
        pg8::EpiBf16 E{(bf16_t*)(F.ws + WS_PROJ), NPROJ};
        pg8::gemm_phase<pg8::EpiBf16, pg8::StaticOrder, true>(F.lds, (const bf16_t*)(F.ws + WS_XN), (const bf16_t*)(F.ws + WS_W1T), D, nullptr, S, E);
    } SEAM(1);
    if (IN(2)) { p2_gla_kv(F); } SEAM(2);
    if (IN(3)) { p3_scan(F); } SEAM(3);
    if (IN(4)) { p4_gla_out(F); } SEAM(4);
    if (IN(5)) {
        pg8::StaticOrder S; S.init(M / 256, D / 256, F.G, F.bx);
        pg8::EpiResF32 E{F.x, (float*)(F.ws + WS_X1), D};
        pg8::gemm_phase<pg8::EpiResF32, pg8::StaticOrder, true>(F.lds, (const bf16_t*)(F.ws + WS_Y), (const bf16_t*)(F.ws + WS_WOT), D, nullptr, S, E);
    } SEAM(5);
    if (IN(6)) { p6_router(F); } SEAM(6);
    if (IN(7)) { p7_slots(F); } SEAM(7);
    if (IN(8)) {
        const int ntiles = META[0];
        pg8::MoeOrder S; S.so.init(ntiles, 2 * FF / 256, F.G, F.bx); S.tile_expert = META + 32;
        pg8::EpiSwiglu E{(bf16_t*)(F.ws + WS_H), F.b_gu, META + 32};
        pg8::gemm_phase<pg8::EpiSwiglu, pg8::MoeOrder, true>(F.lds, (const bf16_t*)(F.ws + WS_XN), (const bf16_t*)(F.ws + WS_WGUT), D, (const int*)(F.ws + WS_ROUTE + R_ROWTOK), S, E);
    } SEAM(8);
    if (IN(9)) {
        const int ntiles = META[0];
        pg8::MoeOrder S; S.so.init(ntiles, D / 256, F.G, F.bx); S.tile_expert = META + 32;
        pg8::EpiDown E{(bf16_t*)(F.ws + WS_CONTRIB), F.b_dn, (const float*)(F.ws + WS_ROUTE + R_ROWGATE), META + 32};
        pg8::gemm_phase<pg8::EpiDown, pg8::MoeOrder, true>(F.lds, (const bf16_t*)(F.ws + WS_H), (const bf16_t*)(F.ws + WS_WDT), FF, nullptr, S, E);
    } SEAM(9);
    if (IN(10)) { p10_combine(F); }
#undef IN
#undef SEAM
}

extern "C" void kernel_launch(void* const* d_in, const int* in_sizes, int n_in, void* d_out, int out_size, void* d_ws, size_t ws_size, hipStream_t stream) {
    static int grid = 0;
    if (grid == 0) {
        if (n_in != 16 || in_sizes[0] != M * D || out_size != M * D || ws_size < WS_END) { fprintf(stderr, "kernel_launch: unexpected shapes (n_in %d, in0 %d, out %d, ws %zu < %zu)\n", n_in, n_in > 0 ? in_sizes[0] : -1, out_size, ws_size, (size_t)WS_END); grid = -1; return; }
        int dev = 0, cus = 0, per_cu = 0;
        if (hipGetDevice(&dev) != hipSuccess || hipDeviceGetAttribute(&cus, hipDeviceAttributeMultiprocessorCount, dev) != hipSuccess) { grid = -1; return; }
        if (hipFuncSetAttribute((const void*)fwd_kernel, hipFuncAttributeMaxDynamicSharedMemorySize, LDS_BYTES) != hipSuccess) { fprintf(stderr, "kernel_launch: hipFuncSetAttribute failed\n"); grid = -1; return; }
        if (hipOccupancyMaxActiveBlocksPerMultiprocessor(&per_cu, (const void*)fwd_kernel, NTHR, LDS_BYTES) != hipSuccess || per_cu < 1) fprintf(stderr, "kernel_launch: occupancy query reports %d\n", per_cu);
        (void)hipGetLastError();
        grid = cus;
    }
    if (grid < 0) return;
    (void)hipMemsetAsync((char*)d_ws + WS_CTL, 0, CTL_ZERO_BYTES, stream);
    Args a{};
    for (int i = 0; i < 16; ++i) a.in[i] = (const float*)d_in[i];
    a.out = (float*)d_out; a.ws = (unsigned char*)d_ws;
    for (int li = 0; li < N_LAUNCHES; ++li) {
        if (N_LAUNCHES == 1) { a.ph_lo = 0; a.ph_hi = NPHASES; } else { a.ph_lo = li; a.ph_hi = li + 1; }
        a.li = li;
        hipLaunchKernelGGL(fwd_kernel, dim3(grid), dim3(NTHR), LDS_BYTES, stream, a);
    }
}
```

```cpp
#include <hip/hip_runtime.h>
#include <cstdio>
#include <cstdint>

#ifndef MK_N_LAUNCHES
#define MK_N_LAUNCHES 1
#endif

#define LAS __attribute__((address_space(3)))
#define GAS __attribute__((address_space(1)))
typedef unsigned short bf16_t;
typedef short bf16x8 __attribute__((ext_vector_type(8)));
typedef float f32x4 __attribute__((ext_vector_type(4)));
typedef float f32x2 __attribute__((ext_vector_type(2)));
typedef unsigned u32x4 __attribute__((ext_vector_type(4)));
typedef unsigned u32x2 __attribute__((ext_vector_type(2)));

constexpr int NWAVES = 8, NTHR = 512;
constexpr int NPHASES = 11;
constexpr int N_LAUNCHES = MK_N_LAUNCHES;
constexpr int BATCH = 4, SEQ = 4096, D = 1024, M = BATCH * SEQ;
constexpr int CONVW = 512, NH = 4, DK = 64, DV = 128, RANK = 16, CHUNK = 64, NCH = SEQ / CHUNK;
constexpr int DIN = 3088, NPROJ = 3072;
constexpr int C_UH = 0, C_GB = 512, C_GC = 1024, C_Q = 1536, C_K = 1792, C_V = 2048, C_G = 2560, C_GKL = 3072;
constexpr int NE = 32, TOPK = 4, FF = 1024;
constexpr int NUNITS_GLA = BATCH * NH * NCH;
constexpr int NROWS_MAX = M * TOPK + NE * 256;
constexpr int NTILES_MAX = NROWS_MAX / 256;
constexpr float RMS_EPS = 1e-5f;

constexpr size_t MiB = 1u << 20;
constexpr size_t WS_CTL = 0, CTL_ZERO_BYTES = 1 * MiB;
constexpr size_t WS_XN = 1 * MiB;
constexpr size_t WS_GKL = WS_XN + 32 * MiB;
constexpr size_t WS_W1T = WS_GKL + 1 * MiB;
constexpr size_t WS_WOT = WS_W1T + 6 * MiB;
constexpr size_t WS_WGUT = WS_WOT + 2 * MiB;
constexpr size_t WS_WDT = WS_WGUT + 128 * MiB;
constexpr size_t WS_PROJ = WS_WDT + 64 * MiB;
constexpr size_t WS_KVT = WS_PROJ + 96 * MiB;
constexpr size_t WS_DEC = WS_KVT + 32 * MiB;
constexpr size_t WS_ST = WS_DEC + 1 * MiB;
constexpr size_t WS_Y = WS_ST + 16 * MiB;
constexpr size_t WS_X1 = WS_Y + 32 * MiB;
constexpr size_t WS_ROUTE = WS_X1 + 64 * MiB;
constexpr size_t WS_H = WS_ROUTE + 2 * MiB;
constexpr size_t WS_CONTRIB = WS_H + 144 * MiB;
constexpr size_t WS_END = WS_CONTRIB + 144 * MiB;
constexpr size_t R_TOPI = 0;
constexpr size_t R_TOPG = 256 * 1024;
constexpr size_t R_POS = 512 * 1024;
constexpr size_t R_ROWTOK = 768 * 1024;
constexpr size_t R_ROWGATE = 1088 * 1024;
constexpr size_t R_HIST = 1408 * 1024;
constexpr size_t R_META = 1472 * 1024;
constexpr int CW_BAR = 4096;

constexpr int LDS_BYTES = 160 * 1024 - 2048;
constexpr int MISC_OFF = LDS_BYTES - 1024;

__device__ __forceinline__ unsigned f2bf(float f) { unsigned u = __builtin_bit_cast(unsigned, f); return (u + 0x7fffu + ((u >> 16) & 1u)) >> 16; }
__device__ __forceinline__ unsigned pk2(float lo, float hi) { return f2bf(lo) | (f2bf(hi) << 16); }
__device__ __forceinline__ float bf2f(unsigned short b) { return __builtin_bit_cast(float, (unsigned)b << 16); }
__device__ __forceinline__ float bflo(unsigned w) { return __builtin_bit_cast(float, w << 16); }
__device__ __forceinline__ float bfhi(unsigned w) { return __builtin_bit_cast(float, w & 0xffff0000u); }
__device__ __forceinline__ unsigned cvt_pk_bf16(float lo, float hi) { unsigned r; asm volatile("v_cvt_pk_bf16_f32 %0, %1, %2" : "=v"(r) : "v"(lo), "v"(hi)); return r; }
__device__ __forceinline__ float wave_sum(float v) {
#pragma unroll
    for (int o = 1; o < 64; o <<= 1) v += __shfl_xor(v, o);
    return v;
}
__device__ __forceinline__ float sigmoidf_(float x) { return 1.0f / (1.0f + __expf(-x)); }
__device__ __forceinline__ float log_sigmoidf_(float x) { return fminf(x, 0.f) - log1pf(__expf(-fabsf(x))); }
#define LDS_WAIT() asm volatile("s_waitcnt lgkmcnt(0)" ::: "memory")
#define VM_WAIT() asm volatile("s_waitcnt vmcnt(0)" ::: "memory")

#define XB_TMO      128
#define XB_XCNT(j)  (256  + 64 * (j))
#define XB_XSUB(j)  (1280 + 64 * (j))
#define XB_XGEN(j)  (2304 + 64 * (j))
#define XB_TOP      3328
#define XB_TOPGEN   3392
#define XCD_BAR_WORDS 3456
#define XB_SPIN_CAP (1u << 18)
__device__ __forceinline__ unsigned xb_ld(unsigned* p)              { return __hip_atomic_load(p, __ATOMIC_RELAXED, __HIP_MEMORY_SCOPE_AGENT); }
__device__ __forceinline__ unsigned xb_add(unsigned* p, unsigned v) { return __hip_atomic_fetch_add(p, v, __ATOMIC_RELAXED, __HIP_MEMORY_SCOPE_AGENT); }
__device__ __forceinline__ unsigned xb_xcc_id() { return (unsigned)__builtin_amdgcn_s_getreg((3 << 11) | 20) & 0xFu; }
#define XB_SPIN(cond, bar) do { unsigned _sp = 0; while (cond) { __builtin_amdgcn_s_sleep(1); \
    if ((++_sp & 255u) == 0u) { if (xb_ld(&(bar)[XB_TMO])) break; if (_sp > XB_SPIN_CAP) { atomicAdd(&(bar)[XB_TMO], 1u); break; } } } } while (0)
struct XcdBarrier { unsigned* bar; unsigned x; volatile LAS unsigned* st; };
__device__ __forceinline__ XcdBarrier xcd_barrier_post(unsigned* bar, volatile LAS unsigned* st) {
    XcdBarrier b; b.bar = bar; b.x = xb_xcc_id(); b.st = st;
    if (threadIdx.x == 0) (void)xb_add(&bar[XB_XCNT(b.x)], 1u);
    return b;
}
__device__ __forceinline__ void xcd_barrier_complete(unsigned* bar, unsigned x, unsigned& nloc, unsigned& nx) {
    const unsigned G = gridDim.x * gridDim.y * gridDim.z;
    unsigned sum, cnt, mine, sp = 0u;
    for (;;) {
        sum = 0u; cnt = 0u; mine = 0u;
#pragma unroll
        for (unsigned j = 0; j < 16; ++j) { const unsigned c = xb_ld(&bar[XB_XCNT(j)]); sum += c; cnt += (c > 0u) ? 1u : 0u; mine = (j == x) ? c : mine; }
        if (sum == G) break;
        __builtin_amdgcn_s_sleep(1);
        if ((++sp & 255u) == 0u) { if (xb_ld(&bar[XB_TMO])) break; if (sp > XB_SPIN_CAP) { atomicAdd(&bar[XB_TMO], 1u); break; } }
    }
    nloc = mine > 0u ? mine : 1u; nx = cnt > 0u ? cnt : 1u;
}
__device__ __forceinline__ void xcd_barrier(const XcdBarrier& b) {
    asm volatile("s_waitcnt vmcnt(0)" ::: "memory");
    __syncthreads();
    if (threadIdx.x == 0) {
        unsigned* bar = b.bar;
        __builtin_amdgcn_s_waitcnt(0);
        unsigned nloc = b.st[0], nx = b.st[1];
        if (nloc == 0u) { xcd_barrier_complete(bar, b.x, nloc, nx); b.st[0] = nloc; b.st[1] = nx; }
        const unsigned old = xb_add(&bar[XB_XSUB(b.x)], 1u);
        const unsigned gen = old / nloc;
        if (old + 1u == (gen + 1u) * nloc) {
            __builtin_amdgcn_fence(__ATOMIC_RELEASE, "agent");
            asm volatile("s_waitcnt vmcnt(0)" ::: "memory");
            const unsigned og = xb_add(&bar[XB_TOP], 1u);
            const unsigned tg = og / nx;
            if (og + 1u == (tg + 1u) * nx) xb_add(&bar[XB_TOPGEN], 1u);
            else XB_SPIN(xb_ld(&bar[XB_TOPGEN]) == tg, bar);
            __builtin_amdgcn_fence(__ATOMIC_ACQUIRE, "agent");
            xb_add(&bar[XB_XGEN(b.x)], 1u);
            asm volatile("s_waitcnt vmcnt(0)" ::: "memory");
        } else {
            XB_SPIN(xb_ld(&bar[XB_XGEN(b.x)]) == gen, bar);
            __builtin_amdgcn_fence(__ATOMIC_ACQUIRE, "agent");
            asm volatile("s_waitcnt vmcnt(0)" ::: "memory");
        }
    }
    __syncthreads();
}

namespace pg8 {
constexpr int BM = 256, BK = 64, HALF = 128, HTB = HALF * BK * 2, STAGE_BYTES = 8 * HTB, NXCD = 8, WGM = 8;
__host__ __device__ __forceinline__ int lds_byte(int r, int c) { const int st = (r >> 4) * 2 + (c >> 5), rr = r & 15, cc = c & 31, ob = rr * 64 + cc * 2; return st * 1024 + (ob ^ (((ob >> 9) & 1) << 5)); }
__host__ __device__ __forceinline__ void stage_rc(int b, int& R, int& C) { const int st = b / 1024, sb = b % 1024, swz = sb ^ (((sb >> 9) & 1) << 5); R = (st >> 1) * 16 + swz / 64; C = (st & 1) * 32 + (swz % 64) / 2; }
__host__ __device__ __forceinline__ int perm32(int rho) { const int n = rho >> 4, i = rho & 15; return 8 * (i >> 2) + 4 * n + (i & 3); }
struct Unit { int pm, pn, pb; };
struct StaticOrder {
    int nM, nN, nwg, G, c;
    __host__ __device__ void init(int nM_, int nN_, int G_, int c_) { nM = nM_; nN = nN_; nwg = nM * nN; G = G_; c = c_; }
    __host__ __device__ bool next(int i, Unit& u) const {
        const long L = (long)i * G + c; if (L >= nwg) return false;
        int wgid = (int)L; { const int q = nwg / NXCD, r = nwg % NXCD, xcd = wgid % NXCD, off = wgid / NXCD; wgid = (xcd < r ? xcd * (q + 1) : r * (q + 1) + (xcd - r) * q) + off; }
        const int nig = WGM * nN, gid = wgid / nig, fm = gid * WGM, gsz = (nM - fm) < WGM ? (nM - fm) : WGM;
        u.pm = fm + ((wgid % nig) % gsz); u.pn = (wgid % nig) / gsz; u.pb = u.pn; return true;
    }
};
struct MoeOrder {
    StaticOrder so; const int* tile_expert;
    __device__ bool next(int i, Unit& u) const { if (!so.next(i, u)) return false; u.pb = tile_expert[u.pm] * so.nN + u.pn; return true; }
};

template <class Epi, class Sched, bool ALIGN_EPI>
__device__ __forceinline__ void gemm_phase(LAS unsigned char* lds, const bf16_t* A, const bf16_t* Bt, const int K, const int* rowidx, const Sched& S, const Epi& E) {
    const int tid = threadIdx.x, wid = __builtin_amdgcn_readfirstlane(tid >> 6), lane = tid & 63, wr = wid >> 2, wc = wid & 3, fr = lane & 15, fq = lane >> 4;
    const int nt = K / BK;
    unsigned voffB[2];
#pragma unroll
    for (int i = 0; i < 2; ++i) { int R, C; stage_rc(tid * 16 + i * 8192, R, C); const int Rb = Epi::PERM ? ((R & ~31) + perm32(R & 31)) : R; voffB[i] = (unsigned)(Rb * K + C) * 2u; }
    const size_t kstep = (size_t)(BK * 2);
    const size_t hstep = (size_t)HALF * K * 2;
    const size_t tstep = 2 * hstep;
    const unsigned ldsw = (unsigned)wid * 1024u;
    const int aoff = lds_byte(wr * 64 + fr, fq * 8), boff = lds_byte(wc * 32 + fr, fq * 8);
#define PG8_SA(b, h) (((b) * 2 + (h)) * HTB)
#define PG8_SB(b, h) ((4 + (b) * 2 + (h)) * HTB)
#define PG8_STAGE(bufoff, gbase, voff) do { _Pragma("unroll") for (int _i = 0; _i < 2; ++_i) \
        __builtin_amdgcn_global_load_lds((const unsigned*)((const char*)(gbase) + (voff)[_i]), (LAS unsigned*)(lds + (bufoff) + ldsw + _i * 8192), 16, 0, 0); } while (0)
#define PG8_LDA(dst, b, h) do { _Pragma("unroll") for (int m = 0; m < 4; ++m) _Pragma("unroll") for (int k = 0; k < 2; ++k) dst[m][k] = *(const LAS bf16x8*)(lds + PG8_SA(b, h) + aoff + m * 2048 + k * 1024); } while (0)
#define PG8_LDB(dst, b, h) do { _Pragma("unroll") for (int n = 0; n < 2; ++n) _Pragma("unroll") for (int k = 0; k < 2; ++k) dst[n][k] = *(const LAS bf16x8*)(lds + PG8_SB(b, h) + boff + n * 2048 + k * 1024); } while (0)
#define PG8_MMA(ai, bj, At, Bt_) do { __builtin_amdgcn_s_setprio(1); _Pragma("unroll") for (int m = 0; m < 4; ++m) _Pragma("unroll") for (int n = 0; n < 2; ++n) _Pragma("unroll") for (int k = 0; k < 2; ++k) \
        acc[ai][bj][m][n] = __builtin_amdgcn_mfma_f32_16x16x32_bf16(Bt_[n][k], At[m][k], acc[ai][bj][m][n], 0, 0, 0); __builtin_amdgcn_s_setprio(0); } while (0)
#define PG8_WAIT_V(n) asm volatile("s_waitcnt vmcnt(" #n ")" ::: "memory")
#define PG8_WAIT_L(n) asm volatile("s_waitcnt lgkmcnt(" #n ")" ::: "memory")
#define PG8_BAR __builtin_amdgcn_s_barrier()
#define PG8_SCHED __builtin_amdgcn_sched_barrier(0)
#define PG8_AOFF(dst, u) do { _Pragma("unroll") for (int _h = 0; _h < 2; ++_h) _Pragma("unroll") for (int _i = 0; _i < 2; ++_i) { int _R, _C; stage_rc(tid * 16 + _i * 8192, _R, _C); \
        const int _r = (u).pm * BM + _h * HALF + _R; const int _src = rowidx ? rowidx[_r] : _r; dst[_h][_i] = (unsigned)(_src * K + _C) * 2u; } } while (0)
    Unit cur, nxt; int ui = 0;
    if (!S.next(0, cur)) return;
    f32x4 acc[2][2][4][2];
#pragma unroll
    for (int a = 0; a < 2; ++a)
#pragma unroll
        for (int b = 0; b < 2; ++b)
#pragma unroll
            for (int m = 0; m < 4; ++m)
#pragma unroll
                for (int n = 0; n < 2; ++n) acc[a][b][m][n] = (f32x4){0.f, 0.f, 0.f, 0.f};
    bf16x8 At[4][2], B0[2][2], B1[2][2];
    unsigned ca[2][2], na[2][2];
    PG8_AOFF(ca, cur);
    if (rowidx) VM_WAIT();
    const char* cA = (const char*)A; const char* cB = (const char*)Bt + (size_t)cur.pb * tstep;
    PG8_STAGE(PG8_SB(0, 0), cB, voffB); PG8_STAGE(PG8_SB(0, 1), cB + hstep, voffB); PG8_STAGE(PG8_SA(0, 0), cA, ca[0]); PG8_STAGE(PG8_SA(0, 1), cA, ca[1]);
    if (wr == 1) PG8_BAR;
    PG8_WAIT_V(2); PG8_BAR;
    PG8_STAGE(PG8_SB(1, 0), cB + kstep, voffB); PG8_STAGE(PG8_SA(1, 0), cA + kstep, ca[0]); PG8_STAGE(PG8_SB(1, 1), cB + hstep + kstep, voffB);
    PG8_WAIT_V(6); PG8_BAR;
    for (;;) {
        const bool has_next = S.next(ui + 1, nxt);
        if (has_next) { PG8_AOFF(na, nxt); }
        else {
#pragma unroll
            for (int h = 0; h < 2; ++h)
#pragma unroll
                for (int i = 0; i < 2; ++i) na[h][i] = ca[h][i];
        }
        const char* nB = has_next ? (const char*)Bt + (size_t)nxt.pb * tstep : cB;
        for (int t = 0; t < nt; t += 2) {
            const bool last = (t == nt - 2);
            const char* a1 = cA + (size_t)(t + 1) * kstep;
            const char* a2 = last ? cA : cA + (size_t)(t + 2) * kstep; const char* b2 = last ? nB : cB + (size_t)(t + 2) * kstep;
            const char* a3 = a2 + kstep; const char* b3 = b2 + kstep;
            unsigned o2[2][2];
#pragma unroll
            for (int h = 0; h < 2; ++h)
#pragma unroll
                for (int i = 0; i < 2; ++i) o2[h][i] = last ? na[h][i] : ca[h][i];
            PG8_LDB(B0, 0, 0); PG8_LDB(B1, 0, 1); PG8_SCHED; PG8_LDA(At, 0, 0); PG8_STAGE(PG8_SA(1, 1), a1, ca[1]);
            PG8_WAIT_V(8); PG8_WAIT_L(0); PG8_BAR; PG8_MMA(0, 0, At, B0); PG8_MMA(0, 1, At, B1); PG8_BAR; PG8_SCHED;
            PG8_LDA(At, 0, 1); PG8_STAGE(PG8_SB(0, 0), b2, voffB); PG8_STAGE(PG8_SB(0, 1), b2 + hstep, voffB); PG8_STAGE(PG8_SA(0, 0), a2, o2[0]);
            PG8_WAIT_V(8); PG8_WAIT_L(0); PG8_BAR; PG8_MMA(1, 0, At, B0); PG8_MMA(1, 1, At, B1); PG8_BAR; PG8_SCHED;
            PG8_LDB(B0, 1, 0); PG8_LDB(B1, 1, 1); PG8_SCHED; PG8_LDA(At, 1, 0); PG8_STAGE(PG8_SA(0, 1), a2, o2[1]);
            PG8_WAIT_V(8); PG8_WAIT_L(0); PG8_BAR; PG8_MMA(0, 0, At, B0); PG8_MMA(0, 1, At, B1); PG8_BAR; PG8_SCHED;
            PG8_LDA(At, 1, 1); PG8_STAGE(PG8_SB(1, 0), b3, voffB); PG8_STAGE(PG8_SB(1, 1), b3 + hstep, voffB); PG8_STAGE(PG8_SA(1, 0), a3, o2[0]);
            PG8_WAIT_V(8); PG8_WAIT_L(0); PG8_BAR; PG8_MMA(1, 0, At, B0); PG8_MMA(1, 1, At, B1); PG8_BAR; PG8_SCHED;
        }
        if constexpr (ALIGN_EPI) { if (wr == 0) PG8_BAR; }
        E(acc, cur, wr, wc, fr, fq);
        if (!has_next) break;
#pragma unroll
        for (int a = 0; a < 2; ++a)
#pragma unroll
            for (int b = 0; b < 2; ++b)
#pragma unroll
                for (int m = 0; m < 4; ++m)
#pragma unroll
                    for (int n = 0; n < 2; ++n) acc[a][b][m][n] = (f32x4){0.f, 0.f, 0.f, 0.f};
        cur = nxt; cB = nB; ++ui;
#pragma unroll
        for (int h = 0; h < 2; ++h)
#pragma unroll
            for (int i = 0; i < 2; ++i) ca[h][i] = na[h][i];
        if constexpr (ALIGN_EPI) { if (wr == 1) PG8_BAR; }
    }
    PG8_WAIT_V(0);
    if constexpr (!ALIGN_EPI) { if (wr == 0) PG8_BAR; }
    PG8_BAR;
#undef PG8_SA
#undef PG8_SB
#undef PG8_STAGE
#undef PG8_LDA
#undef PG8_LDB
#undef PG8_MMA
#undef PG8_WAIT_V
#undef PG8_WAIT_L
#undef PG8_BAR
#undef PG8_SCHED
#undef PG8_AOFF
}

struct EpiBf16 {
    static constexpr bool PERM = true;
    bf16_t* O; int ldc;
    __device__ __forceinline__ void operator()(const f32x4 (&acc)[2][2][4][2], const Unit& u, int wr, int wc, int fr, int fq) const {
        const int row0 = u.pm * BM + wr * 64 + fr, col0 = u.pn * BM + wc * 32 + 8 * fq;
#pragma unroll
        for (int ai = 0; ai < 2; ++ai)
#pragma unroll
            for (int m = 0; m < 4; ++m) { bf16_t* rowp = O + (size_t)(row0 + ai * HALF + m * 16) * ldc + col0;
#pragma unroll
                for (int bj = 0; bj < 2; ++bj) { const f32x4 v0 = acc[ai][bj][m][0], v1 = acc[ai][bj][m][1];
                    u32x4 w; w.x = cvt_pk_bf16(v0[0], v0[1]); w.y = cvt_pk_bf16(v0[2], v0[3]); w.z = cvt_pk_bf16(v1[0], v1[1]); w.w = cvt_pk_bf16(v1[2], v1[3]);
                    *(u32x4*)(rowp + bj * HALF) = w; } }
    }
};
struct EpiResF32 {
    static constexpr bool PERM = false;
    const float* base; float* C; int ldc;
    __device__ __forceinline__ void operator()(const f32x4 (&acc)[2][2][4][2], const Unit& u, int wr, int wc, int fr, int fq) const {
        const int row0 = u.pm * BM + wr * 64 + fr, col0 = u.pn * BM + wc * 32 + 4 * fq;
#pragma unroll
        for (int ai = 0; ai < 2; ++ai)
#pragma unroll
            for (int m = 0; m < 4; ++m) { const size_t off = (size_t)(row0 + ai * HALF + m * 16) * ldc + col0;
#pragma unroll
                for (int bj = 0; bj < 2; ++bj)
#pragma unroll
                    for (int n = 0; n < 2; ++n) { const f32x4 bs = *(const f32x4*)(base + off + bj * HALF + n * 16); *(f32x4*)(C + off + bj * HALF + n * 16) = bs + acc[ai][bj][m][n]; }
                asm volatile("" ::: "memory"); }
    }
};
struct EpiSwiglu {
    static constexpr bool PERM = true;
    bf16_t* Hb; const float* bgu; const int* tile_expert;
    __device__ __forceinline__ void operator()(const f32x4 (&acc)[2][2][4][2], const Unit& u, int wr, int wc, int fr, int fq) const {
        const int e = tile_expert[u.pm];
        const int row0 = u.pm * BM + wr * 64 + fr, col0 = u.pn * HALF + wc * 32 + 8 * fq;
        const float* bg = bgu + (size_t)e * 2048 + col0; const float* bu = bg + 1024;
        const f32x4 g0 = *(const f32x4*)bg, g1 = *(const f32x4*)(bg + 4), u0 = *(const f32x4*)bu, u1 = *(const f32x4*)(bu + 4);
#pragma unroll
        for (int ai = 0; ai < 2; ++ai)
#pragma unroll
            for (int m = 0; m < 4; ++m) {
                float r[8];
#pragma unroll
                for (int n = 0; n < 2; ++n)
#pragma unroll
                    for (int j = 0; j < 4; ++j) {
                        float gt = acc[ai][0][m][n][j] + (n ? g1[j] : g0[j]); float up = acc[ai][1][m][n][j] + (n ? u1[j] : u0[j]);
                        gt = fminf(gt, 7.0f); up = fminf(fmaxf(up, -7.0f), 7.0f);
                        const float glu = gt * sigmoidf_(gt * 1.702f);
                        r[n * 4 + j] = (up + 1.0f) * glu; }
                u32x4 w; w.x = cvt_pk_bf16(r[0], r[1]); w.y = cvt_pk_bf16(r[2], r[3]); w.z = cvt_pk_bf16(r[4], r[5]); w.w = cvt_pk_bf16(r[6], r[7]);
                *(u32x4*)(Hb + (size_t)(row0 + ai * HALF + m * 16) * FF + col0) = w; }
    }
};
struct EpiDown {
    static constexpr bool PERM = true;
    bf16_t* Cb; const float* bd; const float* row_gate; const int* tile_expert;
    __device__ __forceinline__ void operator()(const f32x4 (&acc)[2][2][4][2], const Unit& u, int wr, int wc, int fr, int fq) const {
        const int e = tile_expert[u.pm];
        const int row0 = u.pm * BM + wr * 64 + fr, col0 = u.pn * BM + wc * 32 + 8 * fq;
        f32x4 bv[2][2];
#pragma unroll
        for (int bj = 0; bj < 2; ++bj)
#pragma unroll
            for (int n = 0; n < 2; ++n) bv[bj][n] = *(const f32x4*)(bd + (size_t)e * D + col0 + bj * HALF + 4 * n);
#pragma unroll
        for (int ai = 0; ai < 2; ++ai)
#pragma unroll
            for (int m = 0; m < 4; ++m) { const int row = row0 + ai * HALF + m * 16; const float gt = row_gate[row]; bf16_t* rowp = Cb + (size_t)row * D + col0;
#pragma unroll
                for (int bj = 0; bj < 2; ++bj) { const f32x4 v0 = (acc[ai][bj][m][0] + bv[bj][0]) * gt, v1 = (acc[ai][bj][m][1] + bv[bj][1]) * gt;
                    u32x4 w; w.x = cvt_pk_bf16(v0[0], v0[1]); w.y = cvt_pk_bf16(v0[2], v0[3]); w.z = cvt_pk_bf16(v1[0], v1[1]); w.w = cvt_pk_bf16(v1[2], v1[3]);
                    *(u32x4*)(rowp + bj * HALF) = w; } }
    }
};
}

struct Args { const float* in[16]; float* out; unsigned char* ws; int ph_lo, ph_hi, li, pad; };
struct Frame {
    LAS unsigned char* lds; int tid, lane, wave, G, bx;
    const float *x, *g_mix, *w_in, *conv_w, *w_gk_up, *b_gk_up, *gla_g, *w_out, *g_ffn, *w_router, *b_router, *w_gu, *b_gu, *w_dn, *b_dn, *g_fin;
    float* out; unsigned char* ws;
};

__device__ __forceinline__ void p0_transpose_item(const float* W, int ldn, int K, int k0, int n0, bf16_t* WT, int drow0, LAS float* scr, int lane) {
#pragma unroll 8
    for (int i = 0; i < 32; ++i) { const int kk = 2 * i + (lane >> 5); scr[kk * 33 + (lane & 31)] = W[(size_t)(k0 + kk) * ldn + n0 + (lane & 31)]; }
    LDS_WAIT(); asm volatile("" ::: "memory");
    const int c = lane & 7;
#pragma unroll
    for (int j = 0; j < 4; ++j) { const int n = (lane >> 3) + 8 * j; const LAS float* s = scr + (8 * c) * 33 + n;
        u32x4 o; o.x = pk2(s[0 * 33], s[1 * 33]); o.y = pk2(s[2 * 33], s[3 * 33]); o.z = pk2(s[4 * 33], s[5 * 33]); o.w = pk2(s[6 * 33], s[7 * 33]);
        *(GAS u32x4*)(WT + (size_t)(drow0 + n) * K + k0 + 8 * c) = o; }
    LDS_WAIT(); asm volatile("" ::: "memory");
}
__device__ __forceinline__ void p0_prep(Frame& F) {
    LAS float* w16t = (LAS float*)F.lds;
    LAS float* scr = (LAS float*)(F.lds + 65536 + F.wave * 8448);
    for (int i = F.tid; i < 1024 * 16; i += NTHR) { const int k = i >> 4, r = i & 15; w16t[r * 1024 + k] = F.w_in[(size_t)k * DIN + C_GKL + r]; }
    __syncthreads();
    const int gw = F.bx * NWAVES + F.wave, NGW = F.G * NWAVES;
    bf16_t* XN = (bf16_t*)(F.ws + WS_XN); float* GKL = (float*)(F.ws + WS_GKL);
    for (int m = gw; m < M; m += NGW) {
        const GAS f32x4* xr = (const GAS f32x4*)(F.x + (size_t)m * D) + F.lane;
        f32x4 v[4]; float s2 = 0.f;
#pragma unroll
        for (int j = 0; j < 4; ++j) { v[j] = xr[64 * j]; s2 += (v[j].x * v[j].x + v[j].y * v[j].y) + (v[j].z * v[j].z + v[j].w * v[j].w); }
        const float rstd = 1.0f / sqrtf(wave_sum(s2) * (1.0f / D) + RMS_EPS);
        GAS u32x2* o8 = (GAS u32x2*)(XN + (size_t)m * D) + F.lane;
#pragma unroll
        for (int j = 0; j < 4; ++j) { const f32x4 g = *((const GAS f32x4*)F.g_mix + F.lane + 64 * j); v[j] = v[j] * rstd * g;
            u32x2 w; w.x = pk2(v[j].x, v[j].y); w.y = pk2(v[j].z, v[j].w); o8[64 * j] = w; }
        float acc[16];
#pragma unroll
        for (int r = 0; r < 16; ++r) { float a = 0.f;
#pragma unroll
            for (int j = 0; j < 4; ++j) { const f32x4 w = *(const LAS f32x4*)(w16t + r * 1024 + 4 * F.lane + 256 * j); a += (v[j].x * w.x + v[j].y * w.y) + (v[j].z * w.z + v[j].w * w.w); }
            acc[r] = a; if ((r & 3) == 3) asm volatile("" ::: "memory"); }
        float a8[8], a4[4], a2[2], a1;
        { const bool hi = (F.lane & 32) != 0;
#pragma unroll
          for (int i = 0; i < 8; ++i) { const float send = hi ? acc[i] : acc[i + 8]; const float keep = hi ? acc[i + 8] : acc[i]; a8[i] = keep + __shfl_xor(send, 32); } }
        { const bool hi = (F.lane & 16) != 0;
#pragma unroll
          for (int i = 0; i < 4; ++i) { const float send = hi ? a8[i] : a8[i + 4]; const float keep = hi ? a8[i + 4] : a8[i]; a4[i] = keep + __shfl_xor(send, 16); } }
        { const bool hi = (F.lane & 8) != 0;
#pragma unroll
          for (int i = 0; i < 2; ++i) { const float send = hi ? a4[i] : a4[i + 2]; const float keep = hi ? a4[i + 2] : a4[i]; a2[i] = keep + __shfl_xor(send, 8); } }
        { const bool hi = (F.lane & 4) != 0; const float send = hi ? a2[0] : a2[1]; const float keep = hi ? a2[1] : a2[0]; a1 = keep + __shfl_xor(send, 4); }
        a1 += __shfl_xor(a1, 2); a1 += __shfl_xor(a1, 1);
        if ((F.lane & 3) == 0) GKL[(size_t)m * 16 + (F.lane >> 2)] = a1;
    }
    constexpr int I_1 = (D / 64) * (NPROJ / 32), I_O = (D / 64) * (D / 32), I_GU = (D / 64) * (2 * FF / 32), I_DN = (FF / 64) * (D / 32);
    constexpr int NITEMS = I_1 + I_O + NE * (I_GU + I_DN);
    bf16_t* W1T = (bf16_t*)(F.ws + WS_W1T); bf16_t* WOT = (bf16_t*)(F.ws + WS_WOT); bf16_t* WGUT = (bf16_t*)(F.ws + WS_WGUT); bf16_t* WDT = (bf16_t*)(F.ws + WS_WDT);
    for (int it = gw; it < NITEMS; it += NGW) {
        int r = it;
        if (r < I_1) { const int nblk = NPROJ / 32, kb = r / nblk, nb = r % nblk; p0_transpose_item(F.w_in, DIN, D, 64 * kb, 32 * nb, W1T, 32 * nb, scr, F.lane); continue; } r -= I_1;
        if (r < I_O) { const int nblk = D / 32, kb = r / nblk, nb = r % nblk; p0_transpose_item(F.w_out, D, D, 64 * kb, 32 * nb, WOT, 32 * nb, scr, F.lane); continue; } r -= I_O;
        const int e = r / (I_GU + I_DN); r -= e * (I_GU + I_DN);
        if (r < I_GU) { const int nblk = 2 * FF / 32, kb = r / nblk, nb = r % nblk; const int n0 = 32 * nb, half = n0 / FF, j = n0 % FF, pn = j / 128, i0 = j % 128;
            p0_transpose_item(F.w_gu + (size_t)e * D * 2 * FF, 2 * FF, D, 64 * kb, n0, WGUT + (size_t)e * 2 * FF * D, pn * 256 + half * 128 + i0, scr, F.lane); continue; } r -= I_GU;
        { const int nblk = D / 32, kb = r / nblk, nb = r % nblk; p0_transpose_item(F.w_dn + (size_t)e * FF * D, D, FF, 64 * kb, 32 * nb, WDT + (size_t)e * D * FF, 32 * nb, scr, F.lane); }
    }
}

__device__ __forceinline__ void gla_decay(Frame& F, int tok, int h, float (&bc)[8], float (&blast)[8]) {
    const float* GKL = (const float*)(F.ws + WS_GKL);
    float gl[16];
#pragma unroll
    for (int q = 0; q < 4; ++q) { const f32x4 t = *(const f32x4*)(GKL + (size_t)tok * 16 + 4 * q); gl[4 * q] = t.x; gl[4 * q + 1] = t.y; gl[4 * q + 2] = t.z; gl[4 * q + 3] = t.w; }
    const int dbase = h * DK + 8 * F.wave;
#pragma unroll
    for (int i = 0; i < 8; ++i) {
        float gk = F.b_gk_up[dbase + i];
#pragma unroll
        for (int r = 0; r < 16; ++r) gk += gl[r] * F.w_gk_up[r * (NH * DK) + dbase + i];
        float la = log_sigmoidf_(gk) * (1.0f / 16.0f);
#pragma unroll
        for (int o = 1; o < 64; o <<= 1) { const float t = __shfl_up(la, o); if (F.lane >= o) la += t; }
        bc[i] = la; blast[i] = __shfl(la, 63);
    }
}

constexpr int LP = 72;
__device__ __forceinline__ void p2_gla_kv(Frame& F) {
    const bf16_t* PROJ = (const bf16_t*)(F.ws + WS_PROJ); float* KVT = (float*)(F.ws + WS_KVT); float* DEC = (float*)(F.ws + WS_DEC);
    LAS bf16_t* kremT = (LAS bf16_t*)F.lds;
    LAS bf16_t* vT = (LAS bf16_t*)(F.lds + 64 * LP * 2);
    const int lane = F.lane, w = F.wave;
    for (int u = F.bx; u < NUNITS_GLA; u += F.G) {
        const int b = u / (NH * NCH), h = (u / NCH) % NH, n = u % NCH;
        const int tok = b * SEQ + n * CHUNK + lane;
        float bc[8], blast[8];
        gla_decay(F, tok, h, bc, blast);
        const u32x4 kraw = *(const u32x4*)(PROJ + (size_t)tok * NPROJ + C_K + h * DK + 8 * w);
        const unsigned kw[4] = {kraw.x, kraw.y, kraw.z, kraw.w};
#pragma unroll
        for (int i = 0; i < 8; ++i) { const float kv = (i & 1) ? bfhi(kw[i >> 1]) : bflo(kw[i >> 1]);
            kremT[(8 * w + i) * LP + lane] = (bf16_t)f2bf(kv * __expf(blast[i] - bc[i])); }
        if (lane == 0) {
#pragma unroll
            for (int i = 0; i < 8; ++i) DEC[(size_t)u * DK + 8 * w + i] = __expf(blast[i]);
        }
#pragma unroll
        for (int q = 0; q < 2; ++q) { const u32x4 vraw = *(const u32x4*)(PROJ + (size_t)tok * NPROJ + C_V + h * DV + 16 * w + 8 * q);
            const unsigned vw[4] = {vraw.x, vraw.y, vraw.z, vraw.w};
#pragma unroll
            for (int i = 0; i < 8; ++i) vT[(16 * w + 8 * q + i) * LP + lane] = (bf16_t)((i & 1) ? (vw[i >> 1] >> 16) : (vw[i >> 1] & 0xffffu)); }
        __syncthreads();
        const int fr = lane & 15, fq = lane >> 4;
        bf16x8 a[2];
#pragma unroll
        for (int s = 0; s < 2; ++s) a[s] = *(const LAS bf16x8*)(vT + (16 * w + fr) * LP + 8 * fq + 32 * s);
#pragma unroll
        for (int dt = 0; dt < 4; ++dt) {
            f32x4 c = (f32x4){0.f, 0.f, 0.f, 0.f};
#pragma unroll
            for (int s = 0; s < 2; ++s) { const bf16x8 bb = *(const LAS bf16x8*)(kremT + (16 * dt + fr) * LP + 8 * fq + 32 * s); c = __builtin_amdgcn_mfma_f32_16x16x32_bf16(a[s], bb, c, 0, 0, 0); }
#pragma unroll
            for (int r = 0; r < 4; ++r) KVT[((size_t)u * DV + 16 * w + 4 * fq + r) * DK + 16 * dt + fr] = c[r];
        }
        __syncthreads();
    }
}

__device__ __forceinline__ void p3_scan(Frame& F) {
    const float* KVT = (const float*)(F.ws + WS_KVT); const float* DEC = (const float*)(F.ws + WS_DEC); bf16_t* ST = (bf16_t*)(F.ws + WS_ST);
    for (int gid = F.bx * NTHR + F.tid; gid < BATCH * NH * DV * DK; gid += F.G * NTHR) {
        const int bh = gid >> 13, vd = gid & 8191, d = gid & 63;
        float S = 0.f;
#pragma unroll 8
        for (int n = 0; n < NCH; ++n) { const size_t u = (size_t)bh * NCH + n;
            ST[u * (DV * DK) + vd] = (bf16_t)f2bf(S);
            S = DEC[u * DK + d] * S + KVT[u * (DV * DK) + vd]; }
    }
}

__device__ __forceinline__ void p4_gla_out(Frame& F) {
    const bf16_t* PROJ = (const bf16_t*)(F.ws + WS_PROJ); const bf16_t* ST = (const bf16_t*)(F.ws + WS_ST); bf16_t* Y = (bf16_t*)(F.ws + WS_Y);
    LAS bf16_t* qd = (LAS bf16_t*)F.lds;
    LAS bf16_t* kd = (LAS bf16_t*)(F.lds + 64 * LP * 2);
    LAS bf16_t* vT = (LAS bf16_t*)(F.lds + 2 * 64 * LP * 2);
    LAS bf16_t* pm = (LAS bf16_t*)(F.lds + 4 * 64 * LP * 2);
    LAS float* red = (LAS float*)(F.lds + 5 * 64 * LP * 2);
    const int lane = F.lane, w = F.wave, fr = lane & 15, fq = lane >> 4;
    for (int u = F.bx; u < NUNITS_GLA; u += F.G) {
        const int b = u / (NH * NCH), h = (u / NCH) % NH, n = u % NCH;
        const int tok0 = b * SEQ + n * CHUNK, tok = tok0 + lane;
        float bc[8], blast[8];
        gla_decay(F, tok, h, bc, blast);
        { const u32x4 qraw = *(const u32x4*)(PROJ + (size_t)tok * NPROJ + C_Q + h * DK + 8 * w);
          const u32x4 kraw = *(const u32x4*)(PROJ + (size_t)tok * NPROJ + C_K + h * DK + 8 * w);
          const unsigned qw[4] = {qraw.x, qraw.y, qraw.z, qraw.w}, kw[4] = {kraw.x, kraw.y, kraw.z, kraw.w};
          u32x4 qo, ko; unsigned qq[4], kk[4];
#pragma unroll
          for (int p = 0; p < 4; ++p) { const float e0 = __expf(bc[2 * p]), e1 = __expf(bc[2 * p + 1]);
              qq[p] = pk2(bflo(qw[p]) * 0.125f * e0, bfhi(qw[p]) * 0.125f * e1);
              kk[p] = pk2(bflo(kw[p]) * __expf(-bc[2 * p]), bfhi(kw[p]) * __expf(-bc[2 * p + 1])); }
          qo.x = qq[0]; qo.y = qq[1]; qo.z = qq[2]; qo.w = qq[3]; ko.x = kk[0]; ko.y = kk[1]; ko.z = kk[2]; ko.w = kk[3];
          *(LAS u32x4*)(qd + lane * LP + 8 * w) = qo; *(LAS u32x4*)(kd + lane * LP + 8 * w) = ko; }
#pragma unroll
        for (int q = 0; q < 2; ++q) { const u32x4 vraw = *(const u32x4*)(PROJ + (size_t)tok * NPROJ + C_V + h * DV + 16 * w + 8 * q);
            const unsigned vw[4] = {vraw.x, vraw.y, vraw.z, vraw.w};
#pragma unroll
            for (int i = 0; i < 8; ++i) vT[(16 * w + 8 * q + i) * LP + lane] = (bf16_t)((i & 1) ? (vw[i >> 1] >> 16) : (vw[i >> 1] & 0xffffu)); }
        __syncthreads();
        { const int ct = w >> 1;
          bf16x8 a[2];
#pragma unroll
          for (int s = 0; s < 2; ++s) a[s] = *(const LAS bf16x8*)(qd + (16 * ct + fr) * LP + 8 * fq + 32 * s);
#pragma unroll
          for (int jj = 0; jj < 2; ++jj) { const int jt = 2 * (w & 1) + jj;
              f32x4 c = (f32x4){0.f, 0.f, 0.f, 0.f};
#pragma unroll
              for (int s = 0; s < 2; ++s) { const bf16x8 bb = *(const LAS bf16x8*)(kd + (16 * jt + fr) * LP + 8 * fq + 32 * s); c = __builtin_amdgcn_mfma_f32_16x16x32_bf16(a[s], bb, c, 0, 0, 0); }
#pragma unroll
              for (int r = 0; r < 4; ++r) { const int cc = 16 * ct + 4 * fq + r, jcol = 16 * jt + fr; pm[cc * LP + jcol] = (bf16_t)f2bf(jcol <= cc ? c[r] : 0.f); } } }
        __syncthreads();
        const int ct = w & 3, vt0 = 4 * (w >> 2);
        bf16x8 ap[2], aq[2];
#pragma unroll
        for (int s = 0; s < 2; ++s) { ap[s] = *(const LAS bf16x8*)(pm + (16 * ct + fr) * LP + 8 * fq + 32 * s); aq[s] = *(const LAS bf16x8*)(qd + (16 * ct + fr) * LP + 8 * fq + 32 * s); }
        f32x4 o[4]; float ss[4] = {0.f, 0.f, 0.f, 0.f};
#pragma unroll
        for (int vi = 0; vi < 4; ++vi) { const int vt = vt0 + vi;
            f32x4 c = (f32x4){0.f, 0.f, 0.f, 0.f};
#pragma unroll
            for (int s = 0; s < 2; ++s) { const bf16x8 bb = *(const LAS bf16x8*)(vT + (16 * vt + fr) * LP + 8 * fq + 32 * s); c = __builtin_amdgcn_mfma_f32_16x16x32_bf16(ap[s], bb, c, 0, 0, 0); }
#pragma unroll
            for (int s = 0; s < 2; ++s) { const bf16x8 bb = *(const bf16x8*)(ST + ((size_t)u * DV + 16 * vt + fr) * DK + 8 * fq + 32 * s); c = __builtin_amdgcn_mfma_f32_16x16x32_bf16(aq[s], bb, c, 0, 0, 0); }
            o[vi] = c;
#pragma unroll
            for (int r = 0; r < 4; ++r) ss[r] += c[r] * c[r]; }
#pragma unroll
        for (int r = 0; r < 4; ++r) { float t = ss[r]; t += __shfl_xor(t, 1); t += __shfl_xor(t, 2); t += __shfl_xor(t, 4); t += __shfl_xor(t, 8); ss[r] = t; }
        if (fr == 0) {
#pragma unroll
            for (int r = 0; r < 4; ++r) red[w * 16 + 4 * fq + r] = ss[r];
        }
        __syncthreads();
#pragma unroll
        for (int r = 0; r < 4; ++r) { const float tot = red[ct * 16 + 4 * fq + r] + red[(ct + 4) * 16 + 4 * fq + r]; const float rstd = 1.0f / sqrtf(tot * (1.0f / DV) + RMS_EPS);
            const int trow = tok0 + 16 * ct + 4 * fq + r;
#pragma unroll
            for (int vi = 0; vi < 4; ++vi) { const int v = 16 * (vt0 + vi) + fr;
                const float g = bf2f(PROJ[(size_t)trow * NPROJ + C_G + h * DV + v]);
                const float val = o[vi][r] * rstd * F.gla_g[v] * (g * sigmoidf_(g));
                Y[(size_t)trow * D + CONVW + h * DV + v] = (bf16_t)f2bf(val); } }
        __syncthreads();
    }
    for (int it = F.bx * NTHR + F.tid; it < M * (CONVW / 8); it += F.G * NTHR) {
        const int t = it >> 6, c8 = (it & 63) * 8, s = t & (SEQ - 1);
        float acc[8];
#pragma unroll
        for (int j = 0; j < 8; ++j) acc[j] = 0.f;
#pragma unroll
        for (int i = 0; i < 3; ++i) { const int sp = s - 2 + i; if (sp < 0) continue;
            const size_t ro = (size_t)(t - 2 + i) * NPROJ;
            const u32x4 uh = *(const u32x4*)(PROJ + ro + C_UH + c8), gc = *(const u32x4*)(PROJ + ro + C_GC + c8);
            const unsigned uw[4] = {uh.x, uh.y, uh.z, uh.w}, gw[4] = {gc.x, gc.y, gc.z, gc.w};
            const f32x4 w0 = *(const f32x4*)(F.conv_w + i * CONVW + c8), w1 = *(const f32x4*)(F.conv_w + i * CONVW + c8 + 4);
            const float ww[8] = {w0.x, w0.y, w0.z, w0.w, w1.x, w1.y, w1.z, w1.w};
#pragma unroll
            for (int p = 0; p < 4; ++p) { acc[2 * p] += ww[2 * p] * (bflo(uw[p]) * bflo(gw[p])); acc[2 * p + 1] += ww[2 * p + 1] * (bfhi(uw[p]) * bfhi(gw[p])); } }
        const u32x4 gb = *(const u32x4*)(PROJ + (size_t)t * NPROJ + C_GB + c8); const unsigned bw[4] = {gb.x, gb.y, gb.z, gb.w};
        u32x4 o;
        o.x = pk2(bflo(bw[0]) * acc[0], bfhi(bw[0]) * acc[1]); o.y = pk2(bflo(bw[1]) * acc[2], bfhi(bw[1]) * acc[3]);
        o.z = pk2(bflo(bw[2]) * acc[4], bfhi(bw[2]) * acc[5]); o.w = pk2(bflo(bw[3]) * acc[6], bfhi(bw[3]) * acc[7]);
        *(u32x4*)(Y + (size_t)t * D + c8) = o;
    }
}

__device__ __forceinline__ void p6_router(Frame& F) {
    LAS float* wrT = (LAS float*)F.lds;
    LAS float* lg = (LAS float*)(F.lds + 131072);
    LAS int* hist = (LAS int*)(F.lds + 131072 + 1024);
    const float* X1 = (const float*)(F.ws + WS_X1); bf16_t* XN2 = (bf16_t*)(F.ws + WS_XN);
    int* TOPI = (int*)(F.ws + WS_ROUTE + R_TOPI); float* TOPG = (float*)(F.ws + WS_ROUTE + R_TOPG); int* HIST = (int*)(F.ws + WS_ROUTE + R_HIST);
    for (int i = F.tid; i < 1024 * 32; i += NTHR) { const int k = i >> 5, e = i & 31; wrT[e * 1024 + k] = F.w_router[i]; }
    const int lane = F.lane;
    for (int wg = F.bx; wg < M / 64; wg += F.G) {
        if (F.tid < 32) hist[F.tid] = 0;
        __syncthreads();
        for (int ti = 0; ti < 8; ++ti) {
            const int m = wg * 64 + F.wave * 8 + ti;
            const GAS f32x4* xr = (const GAS f32x4*)(X1 + (size_t)m * D) + lane;
            f32x4 v[4]; float s2 = 0.f;
#pragma unroll
            for (int j = 0; j < 4; ++j) { v[j] = xr[64 * j]; s2 += (v[j].x * v[j].x + v[j].y * v[j].y) + (v[j].z * v[j].z + v[j].w * v[j].w); }
            const float rstd = 1.0f / sqrtf(wave_sum(s2) * (1.0f / D) + RMS_EPS);
            GAS u32x2* o8 = (GAS u32x2*)(XN2 + (size_t)m * D) + lane;
#pragma unroll
            for (int j = 0; j < 4; ++j) { const f32x4 g = *((const GAS f32x4*)F.g_ffn + lane + 64 * j); v[j] = v[j] * rstd * g;
                u32x2 w; w.x = pk2(v[j].x, v[j].y); w.y = pk2(v[j].z, v[j].w); o8[64 * j] = w; }
            float res[2];
#pragma unroll
            for (int grp = 0; grp < 2; ++grp) {
                float acc[16];
#pragma unroll
                for (int r = 0; r < 16; ++r) { float a = 0.f;
#pragma unroll
                    for (int j = 0; j < 4; ++j) { const f32x4 w = *(const LAS f32x4*)(wrT + (grp * 16 + r) * 1024 + 4 * lane + 256 * j); a += (v[j].x * w.x + v[j].y * w.y) + (v[j].z * w.z + v[j].w * w.w); }
                    acc[r] = a; if ((r & 3) == 3) asm volatile("" ::: "memory"); }
                float a8[8], a4[4], a2[2], a1;
                { const bool hi = (lane & 32) != 0;
#pragma unroll
                  for (int i = 0; i < 8; ++i) { const float send = hi ? acc[i] : acc[i + 8]; const float keep = hi ? acc[i + 8] : acc[i]; a8[i] = keep + __shfl_xor(send, 32); } }
                { const bool hi = (lane & 16) != 0;
#pragma unroll
                  for (int i = 0; i < 4; ++i) { const float send = hi ? a8[i] : a8[i + 4]; const float keep = hi ? a8[i + 4] : a8[i]; a4[i] = keep + __shfl_xor(send, 16); } }
                { const bool hi = (lane & 8) != 0;
#pragma unroll
                  for (int i = 0; i < 2; ++i) { const float send = hi ? a4[i] : a4[i + 2]; const float keep = hi ? a4[i + 2] : a4[i]; a2[i] = keep + __shfl_xor(send, 8); } }
                { const bool hi = (lane & 4) != 0; const float send = hi ? a2[0] : a2[1]; const float keep = hi ? a2[1] : a2[0]; a1 = keep + __shfl_xor(send, 4); }
                a1 += __shfl_xor(a1, 2); a1 += __shfl_xor(a1, 1);
                res[grp] = a1;
            }
            if ((lane & 3) == 0) { const int r = lane >> 2; lg[F.wave * 32 + r] = res[0] + F.b_router[r]; lg[F.wave * 32 + 16 + r] = res[1] + F.b_router[16 + r]; }
            LDS_WAIT(); asm volatile("" ::: "memory");
            if (lane == 0) {
                float l[32];
#pragma unroll
                for (int e = 0; e < 32; ++e) l[e] = lg[F.wave * 32 + e];
                int bi[4]; float bv[4]; unsigned used = 0u;
#pragma unroll
                for (int k = 0; k < 4; ++k) { float best = -3.0e38f; int be = 0;
#pragma unroll
                    for (int e = 0; e < 32; ++e) { const bool ok = !((used >> e) & 1u) && l[e] > best; best = ok ? l[e] : best; be = ok ? e : be; }
                    used |= 1u << be; bi[k] = be; bv[k] = best; }
                const float e1 = __expf(bv[1] - bv[0]), e2 = __expf(bv[2] - bv[0]), e3 = __expf(bv[3] - bv[0]); const float inv = 1.0f / (1.0f + e1 + e2 + e3);
                *(int4*)(TOPI + (size_t)m * 4) = make_int4(bi[0], bi[1], bi[2], bi[3]);
                *(f32x4*)(TOPG + (size_t)m * 4) = (f32x4){inv, e1 * inv, e2 * inv, e3 * inv};
#pragma unroll
                for (int k = 0; k < 4; ++k) atomicAdd((int*)&hist[bi[k]], 1);
            }
            asm volatile("" ::: "memory");
        }
        __syncthreads();
        if (F.tid < 32) HIST[wg * 32 + F.tid] = hist[F.tid];
        __syncthreads();
    }
}

__device__ __forceinline__ void p7_slots(Frame& F) {
    LAS int* part = (LAS int*)F.lds;
    LAS int* cnt = part + 1024;
    LAS int* pre = cnt + 32;
    LAS int* pst = pre + 32;
    LAS int* exa = pst + 64;
    const int* TOPI = (const int*)(F.ws + WS_ROUTE + R_TOPI); const float* TOPG = (const float*)(F.ws + WS_ROUTE + R_TOPG); const int* HIST = (const int*)(F.ws + WS_ROUTE + R_HIST);
    int* POS = (int*)(F.ws + WS_ROUTE + R_POS); int* ROWTOK = (int*)(F.ws + WS_ROUTE + R_ROWTOK); float* ROWGATE = (float*)(F.ws + WS_ROUTE + R_ROWGATE); int* META = (int*)(F.ws + WS_ROUTE + R_META);
    constexpr int NWG = M / 64;
    for (int wg = F.bx; wg < NWG; wg += F.G) {
        { const int e = F.tid & 31, p = F.tid >> 5; int tot = 0, bef = 0;
          for (int q = p * 16; q < p * 16 + 16; ++q) { const int hv = HIST[q * 32 + e]; tot += hv; bef += (q < wg) ? hv : 0; }
          part[(p * 32 + e) * 2] = tot; part[(p * 32 + e) * 2 + 1] = bef; }
        __syncthreads();
        if (F.tid < 32) { int tot = 0, bef = 0; for (int p = 0; p < 16; ++p) { tot += part[(p * 32 + F.tid) * 2]; bef += part[(p * 32 + F.tid) * 2 + 1]; } cnt[F.tid] = tot; pre[F.tid] = bef; }
        __syncthreads();
        if (F.tid == 0) { int s = 0; for (int e = 0; e < 32; ++e) { pst[e] = s; s += (cnt[e] + 255) & ~255; } pst[32] = s; }
        int my_e = 0, tokn = 0, kk = 0; float my_g = 0.f;
        if (F.tid < 256) { tokn = wg * 64 + (F.tid >> 2); kk = F.tid & 3; my_e = TOPI[(size_t)tokn * 4 + kk]; my_g = TOPG[(size_t)tokn * 4 + kk]; exa[F.tid] = my_e; }
        __syncthreads();
        if (F.tid < 256) { int rank = 0; for (int a = 0; a < F.tid; ++a) rank += (exa[a] == my_e) ? 1 : 0;
            const int slot = pst[my_e] + pre[my_e] + rank;
            ROWTOK[slot] = tokn; ROWGATE[slot] = my_g; POS[(size_t)tokn * 4 + kk] = slot; }
        if (wg < NE) { const int e = wg, c = cnt[e], s0 = pst[e] + c, s1 = pst[e] + ((c + 255) & ~255);
            for (int s = s0 + F.tid; s < s1; s += NTHR) { ROWTOK[s] = 0; ROWGATE[s] = 0.f; } }
        if (wg == 0) { if (F.tid == 0) META[0] = pst[32] >> 8;
            for (int t = F.tid; t < NTILES_MAX; t += NTHR) { int e = 0; for (int q = 0; q < 32; ++q) e += (t * 256 >= pst[q + 1]) ? 1 : 0; META[32 + t] = e < 32 ? e : 31; } }
        __syncthreads();
    }
}

__device__ __forceinline__ void p10_combine(Frame& F) {
    const float* X1 = (const float*)(F.ws + WS_X1); const bf16_t* CB = (const bf16_t*)(F.ws + WS_CONTRIB); const int* POS = (const int*)(F.ws + WS_ROUTE + R_POS);
    const int gw = F.bx * NWAVES + F.wave, NGW = F.G * NWAVES;
    for (int m = gw; m < M; m += NGW) {
        const GAS f32x4* xr = (const GAS f32x4*)(X1 + (size_t)m * D) + F.lane;
        f32x4 v[4];
#pragma unroll
        for (int j = 0; j < 4; ++j) v[j] = xr[64 * j];
        const int4 ps = *(const int4*)(POS + (size_t)m * 4); const int pp[4] = {ps.x, ps.y, ps.z, ps.w};
#pragma unroll
        for (int k = 0; k < 4; ++k) { const GAS u32x2* cr = (const GAS u32x2*)(CB + (size_t)pp[k] * D) + F.lane;
#pragma unroll
            for (int j = 0; j < 4; ++j) { const u32x2 c = cr[64 * j]; v[j].x += bflo(c.x); v[j].y += bfhi(c.x); v[j].z += bflo(c.y); v[j].w += bfhi(c.y); } }
        float s2 = 0.f;
#pragma unroll
        for (int j = 0; j < 4; ++j) s2 += (v[j].x * v[j].x + v[j].y * v[j].y) + (v[j].z * v[j].z + v[j].w * v[j].w);
        const float rstd = 1.0f / sqrtf(wave_sum(s2) * (1.0f / D) + RMS_EPS);
        GAS f32x4* orow = (GAS f32x4*)(F.out + (size_t)m * D) + F.lane;
#pragma unroll
        for (int j = 0; j < 4; ++j) { const f32x4 g = *((const GAS f32x4*)F.g_fin + F.lane + 64 * j); orow[64 * j] = v[j] * rstd * g; }
    }
}

__global__ void __launch_bounds__(NTHR, 2) fwd_kernel(Args args) {
    extern __shared__ __attribute__((aligned(16))) unsigned char lds_raw[];
    Frame F;
    F.lds = (LAS unsigned char*)lds_raw;
    F.tid = threadIdx.x; F.lane = F.tid & 63; F.wave = __builtin_amdgcn_readfirstlane(F.tid >> 6); F.G = gridDim.x; F.bx = blockIdx.x;
    F.x = args.in[0]; F.g_mix = args.in[1]; F.w_in = args.in[2]; F.conv_w = args.in[3]; F.w_gk_up = args.in[4]; F.b_gk_up = args.in[5]; F.gla_g = args.in[6]; F.w_out = args.in[7];
    F.g_ffn = args.in[8]; F.w_router = args.in[9]; F.b_router = args.in[10]; F.w_gu = args.in[11]; F.b_gu = args.in[12]; F.w_dn = args.in[13]; F.b_dn = args.in[14]; F.g_fin = args.in[15];
    F.out = args.out; F.ws = args.ws;
    volatile LAS unsigned* MISC = (volatile LAS unsigned*)(F.lds + MISC_OFF);
    for (int u = F.tid; u < 256; u += NTHR) MISC[u] = 0u;
    __syncthreads();
    unsigned* ctl = (unsigned*)(F.ws + WS_CTL);
    XcdBarrier bar; bar.bar = ctl + CW_BAR; bar.x = 0; bar.st = nullptr;
    if (N_LAUNCHES == 1) bar = xcd_barrier_post(ctl + CW_BAR, MISC + 8);
    const int lo = args.ph_lo, hi = args.ph_hi;
#define IN(k) (lo <= (k) && (k) < hi)
#define SEAM(k) do { if (IN(k) && IN((k) + 1)) xcd_barrier(bar); } while (0)
    const int* META = (const int*)(F.ws + WS_ROUTE + R_META);

    if (IN(0)) { p0_prep(F); } SEAM(0);
    if (IN(1)) {
        pg8::StaticOrder S; S.init(M / 256, NPROJ / 256, F.G, F.bx);
        pg8::EpiBf16 E{(bf16_t*)(F.ws + WS_PROJ), NPROJ};
        pg8::gemm_phase<pg8::EpiBf16, pg8::StaticOrder, true>(F.lds, (const bf16_t*)(F.ws + WS_XN), (const bf16_t*)(F.ws + WS_W1T), D, nullptr, S, E);
    } SEAM(1);
    if (IN(2)) { p2_gla_kv(F); } SEAM(2);
    if (IN(3)) { p3_scan(F); } SEAM(3);
    if (IN(4)) { p4_gla_out(F); } SEAM(4);
    if (IN(5)) {
        pg8::StaticOrder S; S.init(M / 256, D / 256, F.G, F.bx);
        pg8::EpiResF32 E{F.x, (float*)(F.ws + WS_X1), D};
        pg8::gemm_phase<pg8::EpiResF32, pg8::StaticOrder, true>(F.lds, (const bf16_t*)(F.ws + WS_Y), (const bf16_t*)(F.ws + WS_WOT), D, nullptr, S, E);
    } SEAM(5);
    if (IN(6)) { p6_router(F); } SEAM(6);
    if (IN(7)) { p7_slots(F); } SEAM(7);
    if (IN(8)) {
        const int ntiles = META[0];
        pg8::MoeOrder S; S.so.init(ntiles, 2 * FF / 256, F.G, F.bx); S.tile_expert = META + 32;
        pg8::EpiSwiglu E{(bf16_t*)(F.ws + WS_H), F.b_gu, META + 32};
        pg8::gemm_phase<pg8::EpiSwiglu, pg8::MoeOrder, true>(F.lds, (const bf16_t*)(F.ws + WS_XN), (const bf16_t*)(F.ws + WS_WGUT), D, (const int*)(F.ws + WS_ROUTE + R_ROWTOK), S, E);
    } SEAM(8);
    if (IN(9)) {
        const int ntiles = META[0];
        pg8::MoeOrder S; S.so.init(ntiles, D / 256, F.G, F.bx); S.tile_expert = META + 32;
        pg8::EpiDown E{(bf16_t*)(F.ws + WS_CONTRIB), F.b_dn, (const float*)(F.ws + WS_ROUTE + R_ROWGATE), META + 32};
        pg8::gemm_phase<pg8::EpiDown, pg8::MoeOrder, true>(F.lds, (const bf16_t*)(F.ws + WS_H), (const bf16_t*)(F.ws + WS_WDT), FF, nullptr, S, E);
    } SEAM(9);
    if (IN(10)) { p10_combine(F); }
#undef IN
#undef SEAM
}

extern "C" void kernel_launch(void* const* d_in, const int* in_sizes, int n_in, void* d_out, int out_size, void* d_ws, size_t ws_size, hipStream_t stream) {
    static int grid = 0;
    if (grid == 0) {
        if (n_in != 16 || in_sizes[0] != M * D || out_size != M * D || ws_size < WS_END) { fprintf(stderr, "kernel_launch: unexpected shapes (n_in %d, in0 %d, out %d, ws %zu < %zu)\n", n_in, n_in > 0 ? in_sizes[0] : -1, out_size, ws_size, (size_t)WS_END); grid = -1; return; }
        int dev = 0, cus = 0, per_cu = 0;
        if (hipGetDevice(&dev) != hipSuccess || hipDeviceGetAttribute(&cus, hipDeviceAttributeMultiprocessorCount, dev) != hipSuccess) { grid = -1; return; }
        if (hipFuncSetAttribute((const void*)fwd_kernel, hipFuncAttributeMaxDynamicSharedMemorySize, LDS_BYTES) != hipSuccess) { fprintf(stderr, "kernel_launch: hipFuncSetAttribute failed\n"); grid = -1; return; }
        if (hipOccupancyMaxActiveBlocksPerMultiprocessor(&per_cu, (const void*)fwd_kernel, NTHR, LDS_BYTES) != hipSuccess || per_cu < 1) fprintf(stderr, "kernel_launch: occupancy query reports %d\n", per_cu);
        (void)hipGetLastError();
        grid = cus;
    }
    if (grid < 0) return;
    (void)hipMemsetAsync((char*)d_ws + WS_CTL, 0, CTL_ZERO_BYTES, stream);
    Args a{};
    for (int i = 0; i < 16; ++i) a.in[i] = (const float*)d_in[i];
    a.out = (float*)d_out; a.ws = (unsigned char*)d_ws;
    for (int li = 0; li < N_LAUNCHES; ++li) {
        if (N_LAUNCHES == 1) { a.ph_lo = 0; a.ph_hi = NPHASES; } else { a.ph_lo = li; a.ph_hi = li + 1; }
        a.li = li;
        hipLaunchKernelGGL(fwd_kernel, dim3(grid), dim3(NTHR), LDS_BYTES, stream, a);
    }
}
```

```cpp
#include <hip/hip_runtime.h>
#include <cstdio>
#include <cstdint>

#ifndef MK_N_LAUNCHES
#define MK_N_LAUNCHES 1
#endif

#define LAS __attribute__((address_space(3)))
#define GAS __attribute__((address_space(1)))
typedef unsigned short bf16_t;
typedef short bf16x8 __attribute__((ext_vector_type(8)));
typedef float f32x4 __attribute__((ext_vector_type(4)));
typedef float f32x2 __attribute__((ext_vector_type(2)));
typedef unsigned u32x4 __attribute__((ext_vector_type(4)));
typedef unsigned u32x2 __attribute__((ext_vector_type(2)));

constexpr int NWAVES = 8, NTHR = 512;
constexpr int NPHASES = 11;
constexpr int N_LAUNCHES = MK_N_LAUNCHES;
constexpr int BATCH = 4, SEQ = 4096, D = 1024, M = BATCH * SEQ;
constexpr int CONVW = 512, NH = 4, DK = 64, DV = 128, RANK = 16, CHUNK = 64, NCH = SEQ / CHUNK;
constexpr int DIN = 3088, NPROJ = 3072;
constexpr int C_UH = 0, C_GB = 512, C_GC = 1024, C_Q = 1536, C_K = 1792, C_V = 2048, C_G = 2560, C_GKL = 3072;
constexpr int NE = 32, TOPK = 4, FF = 1024;
constexpr int NUNITS_GLA = BATCH * NH * NCH;
constexpr int NROWS_MAX = M * TOPK + NE * 256;
constexpr int NTILES_MAX = NROWS_MAX / 256;
constexpr float RMS_EPS = 1e-5f;

constexpr size_t MiB = 1u << 20;
constexpr size_t WS_CTL = 0, CTL_ZERO_BYTES = 1 * MiB;
constexpr size_t WS_XN = 1 * MiB;
constexpr size_t WS_GKL = WS_XN + 32 * MiB;
constexpr size_t WS_W1T = WS_GKL + 1 * MiB;
constexpr size_t WS_WOT = WS_W1T + 6 * MiB;
constexpr size_t WS_WGUT = WS_WOT + 2 * MiB;
constexpr size_t WS_WDT = WS_WGUT + 128 * MiB;
constexpr size_t WS_PROJ = WS_WDT + 64 * MiB;
constexpr size_t WS_KVT = WS_PROJ + 96 * MiB;
constexpr size_t WS_DEC = WS_KVT + 32 * MiB;
constexpr size_t WS_ST = WS_DEC + 1 * MiB;
constexpr size_t WS_Y = WS_ST + 16 * MiB;
constexpr size_t WS_X1 = WS_Y + 32 * MiB;
constexpr size_t WS_ROUTE = WS_X1 + 64 * MiB;
constexpr size_t WS_H = WS_ROUTE + 2 * MiB;
constexpr size_t WS_CONTRIB = WS_H + 144 * MiB;
constexpr size_t WS_END = WS_CONTRIB + 144 * MiB;
constexpr size_t R_TOPI = 0;
constexpr size_t R_TOPG = 256 * 1024;
constexpr size_t R_POS = 512 * 1024;
constexpr size_t R_ROWTOK = 768 * 1024;
constexpr size_t R_ROWGATE = 1088 * 1024;
constexpr size_t R_HIST = 1408 * 1024;
constexpr size_t R_META = 1472 * 1024;
constexpr size_t R_RSTD = 1536 * 1024;
constexpr size_t R_ROWRSTD = 1664 * 1024;
constexpr int CW_BAR = 4096;

constexpr int LDS_BYTES = 160 * 1024 - 2048;
constexpr int MISC_OFF = LDS_BYTES - 1024;

__device__ __forceinline__ unsigned f2bf(float f) { unsigned u = __builtin_bit_cast(unsigned, f); return (u + 0x7fffu + ((u >> 16) & 1u)) >> 16; }
__device__ __forceinline__ unsigned pk2(float lo, float hi) { return f2bf(lo) | (f2bf(hi) << 16); }
__device__ __forceinline__ float bf2f(unsigned short b) { return __builtin_bit_cast(float, (unsigned)b << 16); }
__device__ __forceinline__ float bflo(unsigned w) { return __builtin_bit_cast(float, w << 16); }
__device__ __forceinline__ float bfhi(unsigned w) { return __builtin_bit_cast(float, w & 0xffff0000u); }
__device__ __forceinline__ unsigned cvt_pk_bf16(float lo, float hi) { unsigned r; asm volatile("v_cvt_pk_bf16_f32 %0, %1, %2" : "=v"(r) : "v"(lo), "v"(hi)); return r; }
__device__ __forceinline__ float wave_sum(float v) {
#pragma unroll
    for (int o = 1; o < 64; o <<= 1) v += __shfl_xor(v, o);
    return v;
}
__device__ __forceinline__ float sigmoidf_(float x) { return 1.0f / (1.0f + __expf(-x)); }
__device__ __forceinline__ float log_sigmoidf_(float x) { return fminf(x, 0.f) - log1pf(__expf(-fabsf(x))); }
#define LDS_WAIT() asm volatile("s_waitcnt lgkmcnt(0)" ::: "memory")
#define VM_WAIT() asm volatile("s_waitcnt vmcnt(0)" ::: "memory")

#define XB_TMO      128
#define XB_XCNT(j)  (256  + 64 * (j))
#define XB_XSUB(j)  (1280 + 64 * (j))
#define XB_XGEN(j)  (2304 + 64 * (j))
#define XB_TOP      3328
#define XB_TOPGEN   3392
#define XCD_BAR_WORDS 3456
#define XB_SPIN_CAP (1u << 18)
__device__ __forceinline__ unsigned xb_ld(unsigned* p)              { return __hip_atomic_load(p, __ATOMIC_RELAXED, __HIP_MEMORY_SCOPE_AGENT); }
__device__ __forceinline__ unsigned xb_add(unsigned* p, unsigned v) { return __hip_atomic_fetch_add(p, v, __ATOMIC_RELAXED, __HIP_MEMORY_SCOPE_AGENT); }
__device__ __forceinline__ unsigned xb_xcc_id() { return (unsigned)__builtin_amdgcn_s_getreg((3 << 11) | 20) & 0xFu; }
#define XB_SPIN(cond, bar) do { unsigned _sp = 0; while (cond) { __builtin_amdgcn_s_sleep(1); \
    if ((++_sp & 255u) == 0u) { if (xb_ld(&(bar)[XB_TMO])) break; if (_sp > XB_SPIN_CAP) { atomicAdd(&(bar)[XB_TMO], 1u); break; } } } } while (0)
struct XcdBarrier { unsigned* bar; unsigned x; volatile LAS unsigned* st; };
__device__ __forceinline__ XcdBarrier xcd_barrier_post(unsigned* bar, volatile LAS unsigned* st) {
    XcdBarrier b; b.bar = bar; b.x = xb_xcc_id(); b.st = st;
    if (threadIdx.x == 0) (void)xb_add(&bar[XB_XCNT(b.x)], 1u);
    return b;
}
__device__ __forceinline__ void xcd_barrier_complete(unsigned* bar, unsigned x, unsigned& nloc, unsigned& nx) {
    const unsigned G = gridDim.x * gridDim.y * gridDim.z;
    unsigned sum, cnt, mine, sp = 0u;
    for (;;) {
        sum = 0u; cnt = 0u; mine = 0u;
#pragma unroll
        for (unsigned j = 0; j < 16; ++j) { const unsigned c = xb_ld(&bar[XB_XCNT(j)]); sum += c; cnt += (c > 0u) ? 1u : 0u; mine = (j == x) ? c : mine; }
        if (sum == G) break;
        __builtin_amdgcn_s_sleep(1);
        if ((++sp & 255u) == 0u) { if (xb_ld(&bar[XB_TMO])) break; if (sp > XB_SPIN_CAP) { atomicAdd(&bar[XB_TMO], 1u); break; } }
    }
    nloc = mine > 0u ? mine : 1u; nx = cnt > 0u ? cnt : 1u;
}
__device__ __forceinline__ void xcd_barrier(const XcdBarrier& b) {
    asm volatile("s_waitcnt vmcnt(0)" ::: "memory");
    __syncthreads();
    if (threadIdx.x == 0) {
        unsigned* bar = b.bar;
        __builtin_amdgcn_s_waitcnt(0);
        unsigned nloc = b.st[0], nx = b.st[1];
        if (nloc == 0u) { xcd_barrier_complete(bar, b.x, nloc, nx); b.st[0] = nloc; b.st[1] = nx; }
        const unsigned old = xb_add(&bar[XB_XSUB(b.x)], 1u);
        const unsigned gen = old / nloc;
        if (old + 1u == (gen + 1u) * nloc) {
            __builtin_amdgcn_fence(__ATOMIC_RELEASE, "agent");
            asm volatile("s_waitcnt vmcnt(0)" ::: "memory");
            const unsigned og = xb_add(&bar[XB_TOP], 1u);
            const unsigned tg = og / nx;
            if (og + 1u == (tg + 1u) * nx) xb_add(&bar[XB_TOPGEN], 1u);
            else XB_SPIN(xb_ld(&bar[XB_TOPGEN]) == tg, bar);
            __builtin_amdgcn_fence(__ATOMIC_ACQUIRE, "agent");
            xb_add(&bar[XB_XGEN(b.x)], 1u);
            asm volatile("s_waitcnt vmcnt(0)" ::: "memory");
        } else {
            XB_SPIN(xb_ld(&bar[XB_XGEN(b.x)]) == gen, bar);
            __builtin_amdgcn_fence(__ATOMIC_ACQUIRE, "agent");
            asm volatile("s_waitcnt vmcnt(0)" ::: "memory");
        }
    }
    __syncthreads();
}

namespace pg8 {
constexpr int BM = 256, BK = 64, HALF = 128, HTB = HALF * BK * 2, STAGE_BYTES = 8 * HTB, NXCD = 8, WGM = 8;
__host__ __device__ __forceinline__ int lds_byte(int r, int c) { const int st = (r >> 4) * 2 + (c >> 5), rr = r & 15, cc = c & 31, ob = rr * 64 + cc * 2; return st * 1024 + (ob ^ (((ob >> 9) & 1) << 5)); }
__host__ __device__ __forceinline__ void stage_rc(int b, int& R, int& C) { const int st = b / 1024, sb = b % 1024, swz = sb ^ (((sb >> 9) & 1) << 5); R = (st >> 1) * 16 + swz / 64; C = (st & 1) * 32 + (swz % 64) / 2; }
__host__ __device__ __forceinline__ int perm32(int rho) { const int n = rho >> 4, i = rho & 15; return 8 * (i >> 2) + 4 * n + (i & 3); }
struct Unit { int pm, pn, pb; };
struct StaticOrder {
    int nM, nN, nwg, G, c, reps;
    __host__ __device__ void init(int nM_, int nN_, int G_, int c_, int reps_ = 1) { nM = nM_; nN = nN_; nwg = nM * nN; G = G_; c = c_; reps = reps_; }
    __host__ __device__ bool next(int i, Unit& u) const {
        const long L = (long)i * G + c; if (L >= (long)nwg * reps) return false;
        int wgid = (int)(L % nwg); { const int q = nwg / NXCD, r = nwg % NXCD, xcd = wgid % NXCD, off = wgid / NXCD; wgid = (xcd < r ? xcd * (q + 1) : r * (q + 1) + (xcd - r) * q) + off; }
        const int nig = WGM * nN, gid = wgid / nig, fm = gid * WGM, gsz = (nM - fm) < WGM ? (nM - fm) : WGM;
        u.pm = fm + ((wgid % nig) % gsz); u.pn = (wgid % nig) / gsz; u.pb = u.pn; return true;
    }
};
struct MoeOrder {
    StaticOrder so; const int* tile_expert;
    __device__ bool next(int i, Unit& u) const { if (!so.next(i, u)) return false; u.pb = tile_expert[u.pm] * so.nN + u.pn; return true; }
};

template <class Epi, class Sched, bool ALIGN_EPI>
__device__ __forceinline__ void gemm_phase(LAS unsigned char* lds, const bf16_t* A, const bf16_t* Bt, const int K, const int* rowidx, const Sched& S, const Epi& E) {
    const int tid = threadIdx.x, wid = __builtin_amdgcn_readfirstlane(tid >> 6), lane = tid & 63, wr = wid >> 2, wc = wid & 3, fr = lane & 15, fq = lane >> 4;
    const int nt = K / BK;
    unsigned voffB[2];
#pragma unroll
    for (int i = 0; i < 2; ++i) { int R, C; stage_rc(tid * 16 + i * 8192, R, C); const int Rb = Epi::PERM ? ((R & ~31) + perm32(R & 31)) : R; voffB[i] = (unsigned)(Rb * K + C) * 2u; }
    const size_t kstep = (size_t)(BK * 2);
    const size_t hstep = (size_t)HALF * K * 2;
    const size_t tstep = 2 * hstep;
    const unsigned ldsw = (unsigned)wid * 1024u;
    const int aoff = lds_byte(wr * 64 + fr, fq * 8), boff = lds_byte(wc * 32 + fr, fq * 8);
#define PG8_SA(b, h) (((b) * 2 + (h)) * HTB)
#define PG8_SB(b, h) ((4 + (b) * 2 + (h)) * HTB)
#define PG8_STAGE(bufoff, gbase, voff) do { _Pragma("unroll") for (int _i = 0; _i < 2; ++_i) \
        __builtin_amdgcn_global_load_lds((const unsigned*)((const char*)(gbase) + (voff)[_i]), (LAS unsigned*)(lds + (bufoff) + ldsw + _i * 8192), 16, 0, 0); } while (0)
#define PG8_LDA(dst, b, h) do { _Pragma("unroll") for (int m = 0; m < 4; ++m) _Pragma("unroll") for (int k = 0; k < 2; ++k) dst[m][k] = *(const LAS bf16x8*)(lds + PG8_SA(b, h) + aoff + m * 2048 + k * 1024); } while (0)
#define PG8_LDB(dst, b, h) do { _Pragma("unroll") for (int n = 0; n < 2; ++n) _Pragma("unroll") for (int k = 0; k < 2; ++k) dst[n][k] = *(const LAS bf16x8*)(lds + PG8_SB(b, h) + boff + n * 2048 + k * 1024); } while (0)
#define PG8_MMA(ai, bj, At, Bt_) do { __builtin_amdgcn_s_setprio(1); _Pragma("unroll") for (int m = 0; m < 4; ++m) _Pragma("unroll") for (int n = 0; n < 2; ++n) _Pragma("unroll") for (int k = 0; k < 2; ++k) \
        acc[ai][bj][m][n] = __builtin_amdgcn_mfma_f32_16x16x32_bf16(Bt_[n][k], At[m][k], acc[ai][bj][m][n], 0, 0, 0); __builtin_amdgcn_s_setprio(0); } while (0)
#define PG8_WAIT_V(n) asm volatile("s_waitcnt vmcnt(" #n ")" ::: "memory")
#define PG8_WAIT_L(n) asm volatile("s_waitcnt lgkmcnt(" #n ")" ::: "memory")
#define PG8_BAR __builtin_amdgcn_s_barrier()
#define PG8_SCHED __builtin_amdgcn_sched_barrier(0)
#define PG8_AOFF(dst, u) do { _Pragma("unroll") for (int _h = 0; _h < 2; ++_h) _Pragma("unroll") for (int _i = 0; _i < 2; ++_i) { int _R, _C; stage_rc(tid * 16 + _i * 8192, _R, _C); \
        const int _r = (u).pm * BM + _h * HALF + _R; const int _src = rowidx ? rowidx[_r] : _r; dst[_h][_i] = (unsigned)(_src * K + _C) * 2u; } } while (0)
    Unit cur, nxt; int ui = 0;
    if (!S.next(0, cur)) return;
    f32x4 acc[2][2][4][2];
#pragma unroll
    for (int a = 0; a < 2; ++a)
#pragma unroll
        for (int b = 0; b < 2; ++b)
#pragma unroll
            for (int m = 0; m < 4; ++m)
#pragma unroll
                for (int n = 0; n < 2; ++n) acc[a][b][m][n] = (f32x4){0.f, 0.f, 0.f, 0.f};
    bf16x8 At[4][2], B0[2][2], B1[2][2];
    unsigned ca[2][2], na[2][2];
    PG8_AOFF(ca, cur);
    if (rowidx) VM_WAIT();
    const char* cA = (const char*)A; const char* cB = (const char*)Bt + (size_t)cur.pb * tstep;
    PG8_STAGE(PG8_SB(0, 0), cB, voffB); PG8_STAGE(PG8_SB(0, 1), cB + hstep, voffB); PG8_STAGE(PG8_SA(0, 0), cA, ca[0]); PG8_STAGE(PG8_SA(0, 1), cA, ca[1]);
    if (wr == 1) PG8_BAR;
    PG8_WAIT_V(2); PG8_BAR;
    PG8_STAGE(PG8_SB(1, 0), cB + kstep, voffB); PG8_STAGE(PG8_SA(1, 0), cA + kstep, ca[0]); PG8_STAGE(PG8_SB(1, 1), cB + hstep + kstep, voffB);
    PG8_WAIT_V(6); PG8_BAR;
    for (;;) {
        const bool has_next = S.next(ui + 1, nxt);
        if (has_next) { PG8_AOFF(na, nxt); }
        else {
#pragma unroll
            for (int h = 0; h < 2; ++h)
#pragma unroll
                for (int i = 0; i < 2; ++i) na[h][i] = ca[h][i];
        }
        const char* nB = has_next ? (const char*)Bt + (size_t)nxt.pb * tstep : cB;
        for (int t = 0; t < nt; t += 2) {
            const bool last = (t == nt - 2);
            const char* a1 = cA + (size_t)(t + 1) * kstep;
            const char* a2 = last ? cA : cA + (size_t)(t + 2) * kstep; const char* b2 = last ? nB : cB + (size_t)(t + 2) * kstep;
            const char* a3 = a2 + kstep; const char* b3 = b2 + kstep;
            unsigned o2[2][2];
#pragma unroll
            for (int h = 0; h < 2; ++h)
#pragma unroll
                for (int i = 0; i < 2; ++i) o2[h][i] = last ? na[h][i] : ca[h][i];
            PG8_LDB(B0, 0, 0); PG8_LDB(B1, 0, 1); PG8_SCHED; PG8_LDA(At, 0, 0); PG8_STAGE(PG8_SA(1, 1), a1, ca[1]);
            PG8_WAIT_V(8); PG8_WAIT_L(0); PG8_BAR; PG8_MMA(0, 0, At, B0); PG8_MMA(0, 1, At, B1); PG8_BAR; PG8_SCHED;
            PG8_LDA(At, 0, 1); PG8_STAGE(PG8_SB(0, 0), b2, voffB); PG8_STAGE(PG8_SB(0, 1), b2 + hstep, voffB); PG8_STAGE(PG8_SA(0, 0), a2, o2[0]);
            PG8_WAIT_V(8); PG8_WAIT_L(0); PG8_BAR; PG8_MMA(1, 0, At, B0); PG8_MMA(1, 1, At, B1); PG8_BAR; PG8_SCHED;
            PG8_LDB(B0, 1, 0); PG8_LDB(B1, 1, 1); PG8_SCHED; PG8_LDA(At, 1, 0); PG8_STAGE(PG8_SA(0, 1), a2, o2[1]);
            PG8_WAIT_V(8); PG8_WAIT_L(0); PG8_BAR; PG8_MMA(0, 0, At, B0); PG8_MMA(0, 1, At, B1); PG8_BAR; PG8_SCHED;
            PG8_LDA(At, 1, 1); PG8_STAGE(PG8_SB(1, 0), b3, voffB); PG8_STAGE(PG8_SB(1, 1), b3 + hstep, voffB); PG8_STAGE(PG8_SA(1, 0), a3, o2[0]);
            PG8_WAIT_V(8); PG8_WAIT_L(0); PG8_BAR; PG8_MMA(1, 0, At, B0); PG8_MMA(1, 1, At, B1); PG8_BAR; PG8_SCHED;
        }
        if constexpr (ALIGN_EPI) { if (wr == 0) PG8_BAR; }
        E(acc, cur, wr, wc, fr, fq);
        if (!has_next) break;
#pragma unroll
        for (int a = 0; a < 2; ++a)
#pragma unroll
            for (int b = 0; b < 2; ++b)
#pragma unroll
                for (int m = 0; m < 4; ++m)
#pragma unroll
                    for (int n = 0; n < 2; ++n) acc[a][b][m][n] = (f32x4){0.f, 0.f, 0.f, 0.f};
        cur = nxt; cB = nB; ++ui;
#pragma unroll
        for (int h = 0; h < 2; ++h)
#pragma unroll
            for (int i = 0; i < 2; ++i) ca[h][i] = na[h][i];
        if constexpr (ALIGN_EPI) { if (wr == 1) PG8_BAR; }
    }
    PG8_WAIT_V(0);
    if constexpr (!ALIGN_EPI) { if (wr == 0) PG8_BAR; }
    PG8_BAR;
#undef PG8_SA
#undef PG8_SB
#undef PG8_STAGE
#undef PG8_LDA
#undef PG8_LDB
#undef PG8_MMA
#undef PG8_WAIT_V
#undef PG8_WAIT_L
#undef PG8_BAR
#undef PG8_SCHED
#undef PG8_AOFF
}

struct EpiBf16 {
    static constexpr bool PERM = true;
    bf16_t* O; int ldc;
    __device__ __forceinline__ void operator()(const f32x4 (&acc)[2][2][4][2], const Unit& u, int wr, int wc, int fr, int fq) const {
        const int row0 = u.pm * BM + wr * 64 + fr, col0 = u.pn * BM + wc * 32 + 8 * fq;
#pragma unroll
        for (int ai = 0; ai < 2; ++ai)
#pragma unroll
            for (int m = 0; m < 4; ++m) { bf16_t* rowp = O + (size_t)(row0 + ai * HALF + m * 16) * ldc + col0;
#pragma unroll
                for (int bj = 0; bj < 2; ++bj) { const f32x4 v0 = acc[ai][bj][m][0], v1 = acc[ai][bj][m][1];
                    u32x4 w; w.x = cvt_pk_bf16(v0[0], v0[1]); w.y = cvt_pk_bf16(v0[2], v0[3]); w.z = cvt_pk_bf16(v1[0], v1[1]); w.w = cvt_pk_bf16(v1[2], v1[3]);
                    *(u32x4*)(rowp + bj * HALF) = w; } }
    }
};
struct EpiResF32 {
    static constexpr bool PERM = false;
    const float* base; float* C; int ldc;
    __device__ __forceinline__ void operator()(const f32x4 (&acc)[2][2][4][2], const Unit& u, int wr, int wc, int fr, int fq) const {
        const int row0 = u.pm * BM + wr * 64 + fr, col0 = u.pn * BM + wc * 32 + 4 * fq;
#pragma unroll
        for (int ai = 0; ai < 2; ++ai)
#pragma unroll
            for (int m = 0; m < 4; ++m) { const size_t off = (size_t)(row0 + ai * HALF + m * 16) * ldc + col0;
#pragma unroll
                for (int bj = 0; bj < 2; ++bj)
#pragma unroll
                    for (int n = 0; n < 2; ++n) { const f32x4 bs = *(const f32x4*)(base + off + bj * HALF + n * 16); *(f32x4*)(C + off + bj * HALF + n * 16) = bs + acc[ai][bj][m][n]; }
                asm volatile("" ::: "memory"); }
    }
};
struct EpiSwiglu {
    static constexpr bool PERM = true;
    bf16_t* Hb; const float* bgu; const int* tile_expert; const float* row_rstd;
    __device__ __forceinline__ void operator()(const f32x4 (&acc)[2][2][4][2], const Unit& u, int wr, int wc, int fr, int fq) const {
        const int e = tile_expert[u.pm];
        const int row0 = u.pm * BM + wr * 64 + fr, col0 = u.pn * HALF + wc * 32 + 8 * fq;
        const float* bg = bgu + (size_t)e * 2048 + col0; const float* bu = bg + 1024;
        const f32x4 g0 = *(const f32x4*)bg, g1 = *(const f32x4*)(bg + 4), u0 = *(const f32x4*)bu, u1 = *(const f32x4*)(bu + 4);
#pragma unroll
        for (int ai = 0; ai < 2; ++ai)
#pragma unroll
            for (int m = 0; m < 4; ++m) {
                float r[8]; const float rs = row_rstd[row0 + ai * HALF + m * 16];
#pragma unroll
                for (int n = 0; n < 2; ++n)
#pragma unroll
                    for (int j = 0; j < 4; ++j) {
                        float gt = acc[ai][0][m][n][j] * rs + (n ? g1[j] : g0[j]); float up = acc[ai][1][m][n][j] * rs + (n ? u1[j] : u0[j]);
                        gt = fminf(gt, 7.0f); up = fminf(fmaxf(up, -7.0f), 7.0f);
                        const float glu = gt * sigmoidf_(gt * 1.702f);
                        r[n * 4 + j] = (up + 1.0f) * glu; }
                u32x4 w; w.x = cvt_pk_bf16(r[0], r[1]); w.y = cvt_pk_bf16(r[2], r[3]); w.z = cvt_pk_bf16(r[4], r[5]); w.w = cvt_pk_bf16(r[6], r[7]);
                *(u32x4*)(Hb + (size_t)(row0 + ai * HALF + m * 16) * FF + col0) = w; }
    }
};
struct EpiDown {
    static constexpr bool PERM = true;
    bf16_t* Cb; const float* bd; const float* row_gate; const int* tile_expert;
    __device__ __forceinline__ void operator()(const f32x4 (&acc)[2][2][4][2], const Unit& u, int wr, int wc, int fr, int fq) const {
        const int e = tile_expert[u.pm];
        const int row0 = u.pm * BM + wr * 64 + fr, col0 = u.pn * BM + wc * 32 + 8 * fq;
        f32x4 bv[2][2];
#pragma unroll
        for (int bj = 0; bj < 2; ++bj)
#pragma unroll
            for (int n = 0; n < 2; ++n) bv[bj][n] = *(const f32x4*)(bd + (size_t)e * D + col0 + bj * HALF + 4 * n);
#pragma unroll
        for (int ai = 0; ai < 2; ++ai)
#pragma unroll
            for (int m = 0; m < 4; ++m) { const int row = row0 + ai * HALF + m * 16; const float gt = row_gate[row]; bf16_t* rowp = Cb + (size_t)row * D + col0;
#pragma unroll
                for (int bj = 0; bj < 2; ++bj) { const f32x4 v0 = (acc[ai][bj][m][0] + bv[bj][0]) * gt, v1 = (acc[ai][bj][m][1] + bv[bj][1]) * gt;
                    u32x4 w; w.x = cvt_pk_bf16(v0[0], v0[1]); w.y = cvt_pk_bf16(v0[2], v0[3]); w.z = cvt_pk_bf16(v1[0], v1[1]); w.w = cvt_pk_bf16(v1[2], v1[3]);
                    *(u32x4*)(rowp + bj * HALF) = w; } }
    }
};
}

struct Args { const float* in[16]; float* out; unsigned char* ws; int ph_lo, ph_hi, li, pad; };
struct Frame {
    LAS unsigned char* lds; int tid, lane, wave, G, bx;
    const float *x, *g_mix, *w_in, *conv_w, *w_gk_up, *b_gk_up, *gla_g, *w_out, *g_ffn, *w_router, *b_router, *w_gu, *b_gu, *w_dn, *b_dn, *g_fin;
    float* out; unsigned char* ws;
};

__device__ __forceinline__ void p0_transpose_item(const float* W, int ldn, int K, int k0, int n0, bf16_t* WT, int drow0, LAS float* scr, int lane) {
#pragma unroll 8
    for (int i = 0; i < 32; ++i) { const int kk = 2 * i + (lane >> 5); scr[kk * 33 + (lane & 31)] = W[(size_t)(k0 + kk) * ldn + n0 + (lane & 31)]; }
    LDS_WAIT(); asm volatile("" ::: "memory");
    const int c = lane & 7;
#pragma unroll
    for (int j = 0; j < 4; ++j) { const int n = (lane >> 3) + 8 * j; const LAS float* s = scr + (8 * c) * 33 + n;
        u32x4 o; o.x = pk2(s[0 * 33], s[1 * 33]); o.y = pk2(s[2 * 33], s[3 * 33]); o.z = pk2(s[4 * 33], s[5 * 33]); o.w = pk2(s[6 * 33], s[7 * 33]);
        *(GAS u32x4*)(WT + (size_t)(drow0 + n) * K + k0 + 8 * c) = o; }
    LDS_WAIT(); asm volatile("" ::: "memory");
}
__device__ __forceinline__ void p0_prep(Frame& F) {
    LAS float* w16t = (LAS float*)F.lds;
    LAS float* scr = (LAS float*)(F.lds + 65536 + F.wave * 8448);
    for (int i = F.tid; i < 1024 * 16; i += NTHR) { const int k = i >> 4, r = i & 15; w16t[r * 1024 + k] = F.w_in[(size_t)k * DIN + C_GKL + r]; }
    __syncthreads();
    const int gw = F.bx * NWAVES + F.wave, NGW = F.G * NWAVES;
    bf16_t* XN = (bf16_t*)(F.ws + WS_XN); float* GKL = (float*)(F.ws + WS_GKL);
    for (int m = gw; m < M; m += NGW) {
        const GAS f32x4* xr = (const GAS f32x4*)(F.x + (size_t)m * D) + F.lane;
        f32x4 v[4]; float s2 = 0.f;
#pragma unroll
        for (int j = 0; j < 4; ++j) { v[j] = xr[64 * j]; s2 += (v[j].x * v[j].x + v[j].y * v[j].y) + (v[j].z * v[j].z + v[j].w * v[j].w); }
        const float rstd = 1.0f / sqrtf(wave_sum(s2) * (1.0f / D) + RMS_EPS);
        GAS u32x2* o8 = (GAS u32x2*)(XN + (size_t)m * D) + F.lane;
#pragma unroll
        for (int j = 0; j < 4; ++j) { const f32x4 g = *((const GAS f32x4*)F.g_mix + F.lane + 64 * j); v[j] = v[j] * rstd * g;
            u32x2 w; w.x = pk2(v[j].x, v[j].y); w.y = pk2(v[j].z, v[j].w); o8[64 * j] = w; }
        float acc[16];
#pragma unroll
        for (int r = 0; r < 16; ++r) { float a = 0.f;
#pragma unroll
            for (int j = 0; j < 4; ++j) { const f32x4 w = *(const LAS f32x4*)(w16t + r * 1024 + 4 * F.lane + 256 * j); a += (v[j].x * w.x + v[j].y * w.y) + (v[j].z * w.z + v[j].w * w.w); }
            acc[r] = a; if ((r & 3) == 3) asm volatile("" ::: "memory"); }
        float a8[8], a4[4], a2[2], a1;
        { const bool hi = (F.lane & 32) != 0;
#pragma unroll
          for (int i = 0; i < 8; ++i) { const float send = hi ? acc[i] : acc[i + 8]; const float keep = hi ? acc[i + 8] : acc[i]; a8[i] = keep + __shfl_xor(send, 32); } }
        { const bool hi = (F.lane & 16) != 0;
#pragma unroll
          for (int i = 0; i < 4; ++i) { const float send = hi ? a8[i] : a8[i + 4]; const float keep = hi ? a8[i + 4] : a8[i]; a4[i] = keep + __shfl_xor(send, 16); } }
        { const bool hi = (F.lane & 8) != 0;
#pragma unroll
          for (int i = 0; i < 2; ++i) { const float send = hi ? a4[i] : a4[i + 2]; const float keep = hi ? a4[i + 2] : a4[i]; a2[i] = keep + __shfl_xor(send, 8); } }
        { const bool hi = (F.lane & 4) != 0; const float send = hi ? a2[0] : a2[1]; const float keep = hi ? a2[1] : a2[0]; a1 = keep + __shfl_xor(send, 4); }
        a1 += __shfl_xor(a1, 2); a1 += __shfl_xor(a1, 1);
        if ((F.lane & 3) == 0) GKL[(size_t)m * 16 + (F.lane >> 2)] = a1;
    }
    constexpr int I_1 = (D / 64) * (NPROJ / 32), I_O = (D / 64) * (D / 32), I_GU = (D / 64) * (2 * FF / 32), I_DN = (FF / 64) * (D / 32);
    constexpr int NITEMS = I_1 + I_O + NE * (I_GU + I_DN);
    bf16_t* W1T = (bf16_t*)(F.ws + WS_W1T); bf16_t* WOT = (bf16_t*)(F.ws + WS_WOT); bf16_t* WGUT = (bf16_t*)(F.ws + WS_WGUT); bf16_t* WDT = (bf16_t*)(F.ws + WS_WDT);
    for (int it = gw; it < NITEMS; it += NGW) {
        int r = it;
        if (r < I_1) { const int nblk = NPROJ / 32, kb = r / nblk, nb = r % nblk; p0_transpose_item(F.w_in, DIN, D, 64 * kb, 32 * nb, W1T, 32 * nb, scr, F.lane); continue; } r -= I_1;
        if (r < I_O) { const int nblk = D / 32, kb = r / nblk, nb = r % nblk; p0_transpose_item(F.w_out, D, D, 64 * kb, 32 * nb, WOT, 32 * nb, scr, F.lane); continue; } r -= I_O;
        const int e = r / (I_GU + I_DN); r -= e * (I_GU + I_DN);
        if (r < I_GU) { const int nblk = 2 * FF / 32, kb = r / nblk, nb = r % nblk; const int n0 = 32 * nb, half = n0 / FF, j = n0 % FF, pn = j / 128, i0 = j % 128;
            p0_transpose_item(F.w_gu + (size_t)e * D * 2 * FF, 2 * FF, D, 64 * kb, n0, WGUT + (size_t)e * 2 * FF * D, pn * 256 + half * 128 + i0, scr, F.lane); continue; } r -= I_GU;
        { const int nblk = D / 32, kb = r / nblk, nb = r % nblk; p0_transpose_item(F.w_dn + (size_t)e * FF * D, D, FF, 64 * kb, 32 * nb, WDT + (size_t)e * D * FF, 32 * nb, scr, F.lane); }
    }
}

__device__ __forceinline__ void gla_decay(Frame& F, int tok, int h, float (&bc)[8], float (&blast)[8]) {
    const float* GKL = (const float*)(F.ws + WS_GKL);
    float gl[16];
#pragma unroll
    for (int q = 0; q < 4; ++q) { const f32x4 t = *(const f32x4*)(GKL + (size_t)tok * 16 + 4 * q); gl[4 * q] = t.x; gl[4 * q + 1] = t.y; gl[4 * q + 2] = t.z; gl[4 * q + 3] = t.w; }
    const int dbase = h * DK + 8 * F.wave;
#pragma unroll
    for (int i = 0; i < 8; ++i) {
        float gk = F.b_gk_up[dbase + i];
#pragma unroll
        for (int r = 0; r < 16; ++r) gk += gl[r] * F.w_gk_up[r * (NH * DK) + dbase + i];
        float la = log_sigmoidf_(gk) * (1.0f / 16.0f);
#pragma unroll
        for (int o = 1; o < 64; o <<= 1) { const float t = __shfl_up(la, o); if (F.lane >= o) la += t; }
        bc[i] = la; blast[i] = __shfl(la, 63);
    }
}

constexpr int LP = 72;
__device__ __forceinline__ void p2_gla_kv(Frame& F) {
    const bf16_t* PROJ = (const bf16_t*)(F.ws + WS_PROJ); float* KVT = (float*)(F.ws + WS_KVT); float* DEC = (float*)(F.ws + WS_DEC);
    LAS bf16_t* kremT = (LAS bf16_t*)F.lds;
    LAS bf16_t* vT = (LAS bf16_t*)(F.lds + 64 * LP * 2);
    const int lane = F.lane, w = F.wave;
    for (int u = F.bx; u < NUNITS_GLA; u += F.G) {
        const int b = u / (NH * NCH), h = (u / NCH) % NH, n = u % NCH;
        const int tok = b * SEQ + n * CHUNK + lane;
        float bc[8], blast[8];
        gla_decay(F, tok, h, bc, blast);
        const u32x4 kraw = *(const u32x4*)(PROJ + (size_t)tok * NPROJ + C_K + h * DK + 8 * w);
        const unsigned kw[4] = {kraw.x, kraw.y, kraw.z, kraw.w};
#pragma unroll
        for (int i = 0; i < 8; ++i) { const float kv = (i & 1) ? bfhi(kw[i >> 1]) : bflo(kw[i >> 1]);
            kremT[(8 * w + i) * LP + lane] = (bf16_t)f2bf(kv * __expf(blast[i] - bc[i])); }
        if (lane == 0) {
#pragma unroll
            for (int i = 0; i < 8; ++i) DEC[(size_t)u * DK + 8 * w + i] = __expf(blast[i]);
        }
#pragma unroll
        for (int q = 0; q < 2; ++q) { const u32x4 vraw = *(const u32x4*)(PROJ + (size_t)tok * NPROJ + C_V + h * DV + 16 * w + 8 * q);
            const unsigned vw[4] = {vraw.x, vraw.y, vraw.z, vraw.w};
#pragma unroll
            for (int i = 0; i < 8; ++i) vT[(16 * w + 8 * q + i) * LP + lane] = (bf16_t)((i & 1) ? (vw[i >> 1] >> 16) : (vw[i >> 1] & 0xffffu)); }
        __syncthreads();
        const int fr = lane & 15, fq = lane >> 4;
        bf16x8 a[2];
#pragma unroll
        for (int s = 0; s < 2; ++s) a[s] = *(const LAS bf16x8*)(vT + (16 * w + fr) * LP + 8 * fq + 32 * s);
#pragma unroll
        for (int dt = 0; dt < 4; ++dt) {
            f32x4 c = (f32x4){0.f, 0.f, 0.f, 0.f};
#pragma unroll
            for (int s = 0; s < 2; ++s) { const bf16x8 bb = *(const LAS bf16x8*)(kremT + (16 * dt + fr) * LP + 8 * fq + 32 * s); c = __builtin_amdgcn_mfma_f32_16x16x32_bf16(a[s], bb, c, 0, 0, 0); }
#pragma unroll
            for (int r = 0; r < 4; ++r) KVT[((size_t)u * DV + 16 * w + 4 * fq + r) * DK + 16 * dt + fr] = c[r];
        }
        __syncthreads();
    }
}

__device__ __forceinline__ void p3_scan(Frame& F) {
    const float* KVT = (const float*)(F.ws + WS_KVT); const float* DEC = (const float*)(F.ws + WS_DEC); bf16_t* ST = (bf16_t*)(F.ws + WS_ST);
    for (int gid = F.bx * NTHR + F.tid; gid < BATCH * NH * DV * DK; gid += F.G * NTHR) {
        const int bh = gid >> 13, vd = gid & 8191, d = gid & 63;
        float S = 0.f;
#pragma unroll 8
        for (int n = 0; n < NCH; ++n) { const size_t u = (size_t)bh * NCH + n;
            ST[u * (DV * DK) + vd] = (bf16_t)f2bf(S);
            S = DEC[u * DK + d] * S + KVT[u * (DV * DK) + vd]; }
    }
}

__device__ __forceinline__ void p4_gla_out(Frame& F) {
    const bf16_t* PROJ = (const bf16_t*)(F.ws + WS_PROJ); const bf16_t* ST = (const bf16_t*)(F.ws + WS_ST); bf16_t* Y = (bf16_t*)(F.ws + WS_Y);
    LAS bf16_t* qd = (LAS bf16_t*)F.lds;
    LAS bf16_t* kd = (LAS bf16_t*)(F.lds + 64 * LP * 2);
    LAS bf16_t* vT = (LAS bf16_t*)(F.lds + 2 * 64 * LP * 2);
    LAS bf16_t* pm = (LAS bf16_t*)(F.lds + 4 * 64 * LP * 2);
    LAS float* red = (LAS float*)(F.lds + 5 * 64 * LP * 2);
    const int lane = F.lane, w = F.wave, fr = lane & 15, fq = lane >> 4;
    for (int u = F.bx; u < NUNITS_GLA; u += F.G) {
        const int b = u / (NH * NCH), h = (u / NCH) % NH, n = u % NCH;
        const int tok0 = b * SEQ + n * CHUNK, tok = tok0 + lane;
        float bc[8], blast[8];
        gla_decay(F, tok, h, bc, blast);
        { const u32x4 qraw = *(const u32x4*)(PROJ + (size_t)tok * NPROJ + C_Q + h * DK + 8 * w);
          const u32x4 kraw = *(const u32x4*)(PROJ + (size_t)tok * NPROJ + C_K + h * DK + 8 * w);
          const unsigned qw[4] = {qraw.x, qraw.y, qraw.z, qraw.w}, kw[4] = {kraw.x, kraw.y, kraw.z, kraw.w};
          u32x4 qo, ko; unsigned qq[4], kk[4];
#pragma unroll
          for (int p = 0; p < 4; ++p) { const float e0 = __expf(bc[2 * p]), e1 = __expf(bc[2 * p + 1]);
              qq[p] = pk2(bflo(qw[p]) * 0.125f * e0, bfhi(qw[p]) * 0.125f * e1);
              kk[p] = pk2(bflo(kw[p]) * __expf(-bc[2 * p]), bfhi(kw[p]) * __expf(-bc[2 * p + 1])); }
          qo.x = qq[0]; qo.y = qq[1]; qo.z = qq[2]; qo.w = qq[3]; ko.x = kk[0]; ko.y = kk[1]; ko.z = kk[2]; ko.w = kk[3];
          *(LAS u32x4*)(qd + lane * LP + 8 * w) = qo; *(LAS u32x4*)(kd + lane * LP + 8 * w) = ko; }
#pragma unroll
        for (int q = 0; q < 2; ++q) { const u32x4 vraw = *(const u32x4*)(PROJ + (size_t)tok * NPROJ + C_V + h * DV + 16 * w + 8 * q);
            const unsigned vw[4] = {vraw.x, vraw.y, vraw.z, vraw.w};
#pragma unroll
            for (int i = 0; i < 8; ++i) vT[(16 * w + 8 * q + i) * LP + lane] = (bf16_t)((i & 1) ? (vw[i >> 1] >> 16) : (vw[i >> 1] & 0xffffu)); }
        __syncthreads();
        { const int ct = w >> 1;
          bf16x8 a[2];
#pragma unroll
          for (int s = 0; s < 2; ++s) a[s] = *(const LAS bf16x8*)(qd + (16 * ct + fr) * LP + 8 * fq + 32 * s);
#pragma unroll
          for (int jj = 0; jj < 2; ++jj) { const int jt = 2 * (w & 1) + jj;
              f32x4 c = (f32x4){0.f, 0.f, 0.f, 0.f};
#pragma unroll
              for (int s = 0; s < 2; ++s) { const bf16x8 bb = *(const LAS bf16x8*)(kd + (16 * jt + fr) * LP + 8 * fq + 32 * s); c = __builtin_amdgcn_mfma_f32_16x16x32_bf16(a[s], bb, c, 0, 0, 0); }
#pragma unroll
              for (int r = 0; r < 4; ++r) { const int cc = 16 * ct + 4 * fq + r, jcol = 16 * jt + fr; pm[cc * LP + jcol] = (bf16_t)f2bf(jcol <= cc ? c[r] : 0.f); } } }
        __syncthreads();
        const int ct = w & 3, vt0 = 4 * (w >> 2);
        bf16x8 ap[2], aq[2];
#pragma unroll
        for (int s = 0; s < 2; ++s) { ap[s] = *(const LAS bf16x8*)(pm + (16 * ct + fr) * LP + 8 * fq + 32 * s); aq[s] = *(const LAS bf16x8*)(qd + (16 * ct + fr) * LP + 8 * fq + 32 * s); }
        f32x4 o[4]; float ss[4] = {0.f, 0.f, 0.f, 0.f};
#pragma unroll
        for (int vi = 0; vi < 4; ++vi) { const int vt = vt0 + vi;
            f32x4 c = (f32x4){0.f, 0.f, 0.f, 0.f};
#pragma unroll
            for (int s = 0; s < 2; ++s) { const bf16x8 bb = *(const LAS bf16x8*)(vT + (16 * vt + fr) * LP + 8 * fq + 32 * s); c = __builtin_amdgcn_mfma_f32_16x16x32_bf16(ap[s], bb, c, 0, 0, 0); }
#pragma unroll
            for (int s = 0; s < 2; ++s) { const bf16x8 bb = *(const bf16x8*)(ST + ((size_t)u * DV + 16 * vt + fr) * DK + 8 * fq + 32 * s); c = __builtin_amdgcn_mfma_f32_16x16x32_bf16(aq[s], bb, c, 0, 0, 0); }
            o[vi] = c;
#pragma unroll
            for (int r = 0; r < 4; ++r) ss[r] += c[r] * c[r]; }
#pragma unroll
        for (int r = 0; r < 4; ++r) { float t = ss[r]; t += __shfl_xor(t, 1); t += __shfl_xor(t, 2); t += __shfl_xor(t, 4); t += __shfl_xor(t, 8); ss[r] = t; }
        if (fr == 0) {
#pragma unroll
            for (int r = 0; r < 4; ++r) red[w * 16 + 4 * fq + r] = ss[r];
        }
        __syncthreads();
#pragma unroll
        for (int r = 0; r < 4; ++r) { const float tot = red[ct * 16 + 4 * fq + r] + red[(ct + 4) * 16 + 4 * fq + r]; const float rstd = 1.0f / sqrtf(tot * (1.0f / DV) + RMS_EPS);
            const int trow = tok0 + 16 * ct + 4 * fq + r;
#pragma unroll
            for (int vi = 0; vi < 4; ++vi) { const int v = 16 * (vt0 + vi) + fr;
                const float g = bf2f(PROJ[(size_t)trow * NPROJ + C_G + h * DV + v]);
                const float val = o[vi][r] * rstd * F.gla_g[v] * (g * sigmoidf_(g));
                Y[(size_t)trow * D + CONVW + h * DV + v] = (bf16_t)f2bf(val); } }
        __syncthreads();
    }
    for (int it = F.bx * NTHR + F.tid; it < M * (CONVW / 8); it += F.G * NTHR) {
        const int t = it >> 6, c8 = (it & 63) * 8, s = t & (SEQ - 1);
        float acc[8];
#pragma unroll
        for (int j = 0; j < 8; ++j) acc[j] = 0.f;
#pragma unroll
        for (int i = 0; i < 3; ++i) { const int sp = s - 2 + i; if (sp < 0) continue;
            const size_t ro = (size_t)(t - 2 + i) * NPROJ;
            const u32x4 uh = *(const u32x4*)(PROJ + ro + C_UH + c8), gc = *(const u32x4*)(PROJ + ro + C_GC + c8);
            const unsigned uw[4] = {uh.x, uh.y, uh.z, uh.w}, gw[4] = {gc.x, gc.y, gc.z, gc.w};
            const f32x4 w0 = *(const f32x4*)(F.conv_w + i * CONVW + c8), w1 = *(const f32x4*)(F.conv_w + i * CONVW + c8 + 4);
            const float ww[8] = {w0.x, w0.y, w0.z, w0.w, w1.x, w1.y, w1.z, w1.w};
#pragma unroll
            for (int p = 0; p < 4; ++p) { acc[2 * p] += ww[2 * p] * (bflo(uw[p]) * bflo(gw[p])); acc[2 * p + 1] += ww[2 * p + 1] * (bfhi(uw[p]) * bfhi(gw[p])); } }
        const u32x4 gb = *(const u32x4*)(PROJ + (size_t)t * NPROJ + C_GB + c8); const unsigned bw[4] = {gb.x, gb.y, gb.z, gb.w};
        u32x4 o;
        o.x = pk2(bflo(bw[0]) * acc[0], bfhi(bw[0]) * acc[1]); o.y = pk2(bflo(bw[1]) * acc[2], bfhi(bw[1]) * acc[3]);
        o.z = pk2(bflo(bw[2]) * acc[4], bfhi(bw[2]) * acc[5]); o.w = pk2(bflo(bw[3]) * acc[6], bfhi(bw[3]) * acc[7]);
        *(u32x4*)(Y + (size_t)t * D + c8) = o;
    }
}

constexpr int WRP = 1032;
__device__ __forceinline__ void p6_router(Frame& F) {
    LAS bf16_t* wh = (LAS bf16_t*)F.lds;
    LAS bf16_t* wl = (LAS bf16_t*)(F.lds + 32 * WRP * 2);
    LAS float* lgp = (LAS float*)(F.lds + 2 * 32 * WRP * 2);
    LAS int* hist = (LAS int*)(F.lds + 2 * 32 * WRP * 2 + 2 * 64 * 33 * 4);
    const float* X1 = (const float*)(F.ws + WS_X1); bf16_t* XB = (bf16_t*)(F.ws + WS_XN); float* RSTD = (float*)(F.ws + WS_ROUTE + R_RSTD);
    int* TOPI = (int*)(F.ws + WS_ROUTE + R_TOPI); float* TOPG = (float*)(F.ws + WS_ROUTE + R_TOPG); int* HIST = (int*)(F.ws + WS_ROUTE + R_HIST);
    for (int i = F.tid; i < 1024 * 32; i += NTHR) { const int k = i >> 5, e = i & 31; const float wv = F.w_router[i]; const unsigned h = f2bf(wv); const float hf = __builtin_bit_cast(float, h << 16);
        wh[e * WRP + k] = (bf16_t)h; wl[e * WRP + k] = (bf16_t)f2bf(wv - hf); }
    const int lane = F.lane, w = F.wave, fr = lane & 15, fq = lane >> 4, rt = w & 3, kh = w >> 2;
    for (int wg = F.bx; wg < M / 64; wg += F.G) {
        if (F.tid < 32) hist[F.tid] = 0;
        __syncthreads();
        const int m = wg * 64 + rt * 16 + fr;
        const float* xrow = X1 + (size_t)m * D + kh * 512 + 8 * fq;
        bf16_t* orow = XB + (size_t)m * D + kh * 512 + 8 * fq;
        const float* grow = F.g_ffn + kh * 512 + 8 * fq;
        f32x4 c0 = (f32x4){0.f, 0.f, 0.f, 0.f}, c1 = c0; float s2 = 0.f;
#pragma unroll 4
        for (int s = 0; s < 16; ++s) {
            const f32x4 x0 = *(const f32x4*)(xrow + 32 * s), x1v = *(const f32x4*)(xrow + 32 * s + 4);
            const f32x4 g0 = *(const f32x4*)(grow + 32 * s), g1 = *(const f32x4*)(grow + 32 * s + 4);
            s2 += (x0.x * x0.x + x0.y * x0.y) + (x0.z * x0.z + x0.w * x0.w) + (x1v.x * x1v.x + x1v.y * x1v.y) + (x1v.z * x1v.z + x1v.w * x1v.w);
            const float xg[8] = {x0.x * g0.x, x0.y * g0.y, x0.z * g0.z, x0.w * g0.w, x1v.x * g1.x, x1v.y * g1.y, x1v.z * g1.z, x1v.w * g1.w};
            unsigned hw[4], lw[4];
#pragma unroll
            for (int p = 0; p < 4; ++p) { const unsigned h0 = f2bf(xg[2 * p]), h1 = f2bf(xg[2 * p + 1]);
                hw[p] = h0 | (h1 << 16);
                lw[p] = pk2(xg[2 * p] - __builtin_bit_cast(float, h0 << 16), xg[2 * p + 1] - __builtin_bit_cast(float, h1 << 16)); }
            const u32x4 hv = {hw[0], hw[1], hw[2], hw[3]}, lv = {lw[0], lw[1], lw[2], lw[3]};
            *(u32x4*)(orow + 32 * s) = hv;
            const bf16x8 ah = __builtin_bit_cast(bf16x8, hv), al = __builtin_bit_cast(bf16x8, lv);
            const int kk = kh * 512 + 32 * s + 8 * fq;
            const bf16x8 bh0 = *(const LAS bf16x8*)(wh + fr * WRP + kk), bh1 = *(const LAS bf16x8*)(wh + (16 + fr) * WRP + kk);
            const bf16x8 bl0 = *(const LAS bf16x8*)(wl + fr * WRP + kk), bl1 = *(const LAS bf16x8*)(wl + (16 + fr) * WRP + kk);
            c0 = __builtin_amdgcn_mfma_f32_16x16x32_bf16(ah, bh0, c0, 0, 0, 0); c1 = __builtin_amdgcn_mfma_f32_16x16x32_bf16(ah, bh1, c1, 0, 0, 0);
            c0 = __builtin_amdgcn_mfma_f32_16x16x32_bf16(al, bh0, c0, 0, 0, 0); c1 = __builtin_amdgcn_mfma_f32_16x16x32_bf16(al, bh1, c1, 0, 0, 0);
            c0 = __builtin_amdgcn_mfma_f32_16x16x32_bf16(ah, bl0, c0, 0, 0, 0); c1 = __builtin_amdgcn_mfma_f32_16x16x32_bf16(ah, bl1, c1, 0, 0, 0);
        }
        s2 += __shfl_xor(s2, 16); s2 += __shfl_xor(s2, 32);
#pragma unroll
        for (int r = 0; r < 4; ++r) { LAS float* dst = lgp + (kh * 64 + rt * 16 + 4 * fq + r) * 33; dst[fr] = c0[r]; dst[16 + fr] = c1[r]; }
        if (fq == 0) lgp[(kh * 64 + rt * 16 + fr) * 33 + 32] = s2;
        __syncthreads();
        if (F.tid < 64) {
            const int row = F.tid, mm = wg * 64 + row;
            const LAS float* p0 = lgp + row * 33; const LAS float* p1 = lgp + (64 + row) * 33;
            const float rstd = 1.0f / sqrtf((p0[32] + p1[32]) * (1.0f / D) + RMS_EPS);
            float l[32];
#pragma unroll
            for (int e = 0; e < 32; ++e) l[e] = (p0[e] + p1[e]) * rstd + F.b_router[e];
            int bi[4]; float bv[4]; unsigned used = 0u;
#pragma unroll
            for (int k = 0; k < 4; ++k) { float best = -3.0e38f; int be = 0;
#pragma unroll
                for (int e = 0; e < 32; ++e) { const bool ok = !((used >> e) & 1u) && l[e] > best; best = ok ? l[e] : best; be = ok ? e : be; }
                used |= 1u << be; bi[k] = be; bv[k] = best; }
            const float e1 = __expf(bv[1] - bv[0]), e2 = __expf(bv[2] - bv[0]), e3 = __expf(bv[3] - bv[0]); const float inv = 1.0f / (1.0f + e1 + e2 + e3);
            *(int4*)(TOPI + (size_t)mm * 4) = make_int4(bi[0], bi[1], bi[2], bi[3]);
            *(f32x4*)(TOPG + (size_t)mm * 4) = (f32x4){inv, e1 * inv, e2 * inv, e3 * inv};
            RSTD[mm] = rstd;
#pragma unroll
            for (int k = 0; k < 4; ++k) atomicAdd((int*)&hist[bi[k]], 1);
        }
        __syncthreads();
        if (F.tid < 32) HIST[wg * 32 + F.tid] = hist[F.tid];
        __syncthreads();
    }
}

__device__ __forceinline__ void p7_slots(Frame& F) {
    LAS int* part = (LAS int*)F.lds;
    LAS int* cnt = part + 1024;
    LAS int* pre = cnt + 32;
    LAS int* pst = pre + 32;
    LAS int* exa = pst + 64;
    const int* TOPI = (const int*)(F.ws + WS_ROUTE + R_TOPI); const float* TOPG = (const float*)(F.ws + WS_ROUTE + R_TOPG); const int* HIST = (const int*)(F.ws + WS_ROUTE + R_HIST);
    int* POS = (int*)(F.ws + WS_ROUTE + R_POS); int* ROWTOK = (int*)(F.ws + WS_ROUTE + R_ROWTOK); float* ROWGATE = (float*)(F.ws + WS_ROUTE + R_ROWGATE); int* META = (int*)(F.ws + WS_ROUTE + R_META);
    const float* RSTD = (const float*)(F.ws + WS_ROUTE + R_RSTD); float* ROWRSTD = (float*)(F.ws + WS_ROUTE + R_ROWRSTD);
    constexpr int NWG = M / 64;
    for (int wg = F.bx; wg < NWG; wg += F.G) {
        { const int e = F.tid & 31, p = F.tid >> 5; int tot = 0, bef = 0;
          for (int q = p * 16; q < p * 16 + 16; ++q) { const int hv = HIST[q * 32 + e]; tot += hv; bef += (q < wg) ? hv : 0; }
          part[(p * 32 + e) * 2] = tot; part[(p * 32 + e) * 2 + 1] = bef; }
        __syncthreads();
        if (F.tid < 32) { int tot = 0, bef = 0; for (int p = 0; p < 16; ++p) { tot += part[(p * 32 + F.tid) * 2]; bef += part[(p * 32 + F.tid) * 2 + 1]; } cnt[F.tid] = tot; pre[F.tid] = bef; }
        __syncthreads();
        if (F.tid == 0) { int s = 0; for (int e = 0; e < 32; ++e) { pst[e] = s; s += (cnt[e] + 255) & ~255; } pst[32] = s; }
        int my_e = 0, tokn = 0, kk = 0; float my_g = 0.f;
        if (F.tid < 256) { tokn = wg * 64 + (F.tid >> 2); kk = F.tid & 3; my_e = TOPI[(size_t)tokn * 4 + kk]; my_g = TOPG[(size_t)tokn * 4 + kk]; exa[F.tid] = my_e; }
        __syncthreads();
        if (F.tid < 256) { int rank = 0; for (int a = 0; a < F.tid; ++a) rank += (exa[a] == my_e) ? 1 : 0;
            const int slot = pst[my_e] + pre[my_e] + rank;
            ROWTOK[slot] = tokn; ROWGATE[slot] = my_g; ROWRSTD[slot] = RSTD[tokn]; POS[(size_t)tokn * 4 + kk] = slot; }
        if (wg < NE) { const int e = wg, c = cnt[e], s0 = pst[e] + c, s1 = pst[e] + ((c + 255) & ~255);
            for (int s = s0 + F.tid; s < s1; s += NTHR) { ROWTOK[s] = 0; ROWGATE[s] = 0.f; ROWRSTD[s] = 0.f; } }
        if (wg == 0) { if (F.tid == 0) META[0] = pst[32] >> 8;
            for (int t = F.tid; t < NTILES_MAX; t += NTHR) { int e = 0; for (int q = 0; q < 32; ++q) e += (t * 256 >= pst[q + 1]) ? 1 : 0; META[32 + t] = e < 32 ? e : 31; } }
        __syncthreads();
    }
}

__device__ __forceinline__ void p10_combine(Frame& F) {
    const float* X1 = (const float*)(F.ws + WS_X1); const bf16_t* CB = (const bf16_t*)(F.ws + WS_CONTRIB); const int* POS = (const int*)(F.ws + WS_ROUTE + R_POS);
    const int gw = F.bx * NWAVES + F.wave, NGW = F.G * NWAVES;
    for (int m = gw; m < M; m += NGW) {
        const GAS f32x4* xr = (const GAS f32x4*)(X1 + (size_t)m * D) + F.lane;
        f32x4 v[4];
#pragma unroll
        for (int j = 0; j < 4; ++j) v[j] = xr[64 * j];
        const int4 ps = *(const int4*)(POS + (size_t)m * 4); const int pp[4] = {ps.x, ps.y, ps.z, ps.w};
#pragma unroll
        for (int k = 0; k < 4; ++k) { const GAS u32x2* cr = (const GAS u32x2*)(CB + (size_t)pp[k] * D) + F.lane;
#pragma unroll
            for (int j = 0; j < 4; ++j) { const u32x2 c = cr[64 * j]; v[j].x += bflo(c.x); v[j].y += bfhi(c.x); v[j].z += bflo(c.y); v[j].w += bfhi(c.y); } }
        float s2 = 0.f;
#pragma unroll
        for (int j = 0; j < 4; ++j) s2 += (v[j].x * v[j].x + v[j].y * v[j].y) + (v[j].z * v[j].z + v[j].w * v[j].w);
        const float rstd = 1.0f / sqrtf(wave_sum(s2) * (1.0f / D) + RMS_EPS);
        GAS f32x4* orow = (GAS f32x4*)(F.out + (size_t)m * D) + F.lane;
#pragma unroll
        for (int j = 0; j < 4; ++j) { const f32x4 g = *((const GAS f32x4*)F.g_fin + F.lane + 64 * j); orow[64 * j] = v[j] * rstd * g; }
    }
}

__global__ void __launch_bounds__(NTHR, 2) fwd_kernel(Args args) {
    extern __shared__ __attribute__((aligned(16))) unsigned char lds_raw[];
    Frame F;
    F.lds = (LAS unsigned char*)lds_raw;
    F.tid = threadIdx.x; F.lane = F.tid & 63; F.wave = __builtin_amdgcn_readfirstlane(F.tid >> 6); F.G = gridDim.x; F.bx = blockIdx.x;
    F.x = args.in[0]; F.g_mix = args.in[1]; F.w_in = args.in[2]; F.conv_w = args.in[3]; F.w_gk_up = args.in[4]; F.b_gk_up = args.in[5]; F.gla_g = args.in[6]; F.w_out = args.in[7];
    F.g_ffn = args.in[8]; F.w_router = args.in[9]; F.b_router = args.in[10]; F.w_gu = args.in[11]; F.b_gu = args.in[12]; F.w_dn = args.in[13]; F.b_dn = args.in[14]; F.g_fin = args.in[15];
    F.out = args.out; F.ws = args.ws;
    volatile LAS unsigned* MISC = (volatile LAS unsigned*)(F.lds + MISC_OFF);
    for (int u = F.tid; u < 256; u += NTHR) MISC[u] = 0u;
    __syncthreads();
    unsigned* ctl = (unsigned*)(F.ws + WS_CTL);
    XcdBarrier bar; bar.bar = ctl + CW_BAR; bar.x = 0; bar.st = nullptr;
    if (N_LAUNCHES == 1) bar = xcd_barrier_post(ctl + CW_BAR, MISC + 8);
    const int lo = args.ph_lo, hi = args.ph_hi;
#define IN(k) (lo <= (k) && (k) < hi)
#define SEAM(k) do { if (IN(k) && IN((k) + 1)) xcd_barrier(bar); } while (0)
#ifndef REPMASK
#define REPMASK 0
#endif
#define REP(k) for (int rep_ = 0; rep_ < 1 + ((REPMASK >> (k)) & 1); ++rep_)
    const int* META = (const int*)(F.ws + WS_ROUTE + R_META);

    if (IN(0)) REP(0) { p0_prep(F); } SEAM(0);
    if (IN(1)) {
        pg8::StaticOrder S; S.init(M / 256, NPROJ / 256, F.G, F.bx, 1 + ((REPMASK >> 1) & 1));
        pg8::EpiBf16 E{(bf16_t*)(F.ws + WS_PROJ), NPROJ};
        pg8::gemm_phase<pg8::EpiBf16, pg8::StaticOrder, true>(F.lds, (const bf16_t*)(F.ws + WS_XN), (const bf16_t*)(F.ws + WS_W1T), D, nullptr, S, E);
    } SEAM(1);
    if (IN(2)) REP(2) { p2_gla_kv(F); } SEAM(2);
    if (IN(3)) REP(3) { p3_scan(F); } SEAM(3);
    if (IN(4)) REP(4) { p4_gla_out(F); } SEAM(4);
    if (IN(5)) {
        pg8::StaticOrder S; S.init(M / 256, D / 256, F.G, F.bx, 1 + ((REPMASK >> 5) & 1));
        pg8::EpiResF32 E{F.x, (float*)(F.ws + WS_X1), D};
        pg8::gemm_phase<pg8::EpiResF32, pg8::StaticOrder, true>(F.lds, (const bf16_t*)(F.ws + WS_Y), (const bf16_t*)(F.ws + WS_WOT), D, nullptr, S, E);
    } SEAM(5);
    if (IN(6)) REP(6) { p6_router(F); } SEAM(6);
    if (IN(7)) REP(7) { p7_slots(F); } SEAM(7);
    if (IN(8)) {
        const int ntiles = META[0];
        pg8::MoeOrder S; S.so.init(ntiles, 2 * FF / 256, F.G, F.bx, 1 + ((REPMASK >> 8) & 1)); S.tile_expert = META + 32;
        pg8::EpiSwiglu E{(bf16_t*)(F.ws + WS_H), F.b_gu, META + 32, (const float*)(F.ws + WS_ROUTE + R_ROWRSTD)};
        pg8::gemm_phase<pg8::EpiSwiglu, pg8::MoeOrder, true>(F.lds, (const bf16_t*)(F.ws + WS_XN), (const bf16_t*)(F.ws + WS_WGUT), D, (const int*)(F.ws + WS_ROUTE + R_ROWTOK), S, E);
    } SEAM(8);
    if (IN(9)) {
        const int ntiles = META[0];
        pg8::MoeOrder S; S.so.init(ntiles, D / 256, F.G, F.bx, 1 + ((REPMASK >> 9) & 1)); S.tile_expert = META + 32;
        pg8::EpiDown E{(bf16_t*)(F.ws + WS_CONTRIB), F.b_dn, (const float*)(F.ws + WS_ROUTE + R_ROWGATE), META + 32};
        pg8::gemm_phase<pg8::EpiDown, pg8::MoeOrder, true>(F.lds, (const bf16_t*)(F.ws + WS_H), (const bf16_t*)(F.ws + WS_WDT), FF, nullptr, S, E);
    } SEAM(9);
    if (IN(10)) REP(10) { p10_combine(F); }
#undef IN
#undef SEAM
}

extern "C" void kernel_launch(void* const* d_in, const int* in_sizes, int n_in, void* d_out, int out_size, void* d_ws, size_t ws_size, hipStream_t stream) {
    static int grid = 0;
    if (grid == 0) {
        if (n_in != 16 || in_sizes[0] != M * D || out_size != M * D || ws_size < WS_END) { fprintf(stderr, "kernel_launch: unexpected shapes (n_in %d, in0 %d, out %d, ws %zu < %zu)\n", n_in, n_in > 0 ? in_sizes[0] : -1, out_size, ws_size, (size_t)WS_END); grid = -1; return; }
        int dev = 0, cus = 0, per_cu = 0;
        if (hipGetDevice(&dev) != hipSuccess || hipDeviceGetAttribute(&cus, hipDeviceAttributeMultiprocessorCount, dev) != hipSuccess) { grid = -1; return; }
        if (hipFuncSetAttribute((const void*)fwd_kernel, hipFuncAttributeMaxDynamicSharedMemorySize, LDS_BYTES) != hipSuccess) { fprintf(stderr, "kernel_launch: hipFuncSetAttribute failed\n"); grid = -1; return; }
        if (hipOccupancyMaxActiveBlocksPerMultiprocessor(&per_cu, (const void*)fwd_kernel, NTHR, LDS_BYTES) != hipSuccess || per_cu < 1) fprintf(stderr, "kernel_launch: occupancy query reports %d\n", per_cu);
        (void)hipGetLastError();
        grid = cus;
    }
    if (grid < 0) return;
    (void)hipMemsetAsync((char*)d_ws + WS_CTL, 0, CTL_ZERO_BYTES, stream);
    Args a{};
    for (int i = 0; i < 16; ++i) a.in[i] = (const float*)d_in[i];
    a.out = (float*)d_out; a.ws = (unsigned char*)d_ws;
    for (int li = 0; li < N_LAUNCHES; ++li) {
        if (N_LAUNCHES == 1) { a.ph_lo = 0; a.ph_hi = NPHASES; } else { a.ph_lo = li; a.ph_hi = li + 1; }
        a.li = li;
        hipLaunchKernelGGL(fwd_kernel, dim3(grid), dim3(NTHR), LDS_BYTES, stream, a);
    }
}
```

```cpp
#include <hip/hip_runtime.h>
#include <cstdio>
#include <cstdint>

#ifndef MK_N_LAUNCHES
#define MK_N_LAUNCHES 1
#endif

#ifndef MOE_FP8
#define MOE_FP8 1
#endif
#define LAS __attribute__((address_space(3)))
#define GAS __attribute__((address_space(1)))
typedef unsigned short bf16_t;
typedef short bf16x8 __attribute__((ext_vector_type(8)));
typedef float f32x4 __attribute__((ext_vector_type(4)));
typedef float f32x2 __attribute__((ext_vector_type(2)));
typedef unsigned u32x4 __attribute__((ext_vector_type(4)));
typedef unsigned u32x2 __attribute__((ext_vector_type(2)));

constexpr int NWAVES = 8, NTHR = 512;
constexpr int NPHASES = 11;
constexpr int N_LAUNCHES = MK_N_LAUNCHES;
constexpr int BATCH = 4, SEQ = 4096, D = 1024, M = BATCH * SEQ;
constexpr int CONVW = 512, NH = 4, DK = 64, DV = 128, RANK = 16, CHUNK = 64, NCH = SEQ / CHUNK;
constexpr int DIN = 3088, NPROJ = 3072;
constexpr int C_UH = 0, C_GB = 512, C_GC = 1024, C_Q = 1536, C_K = 1792, C_V = 2048, C_G = 2560, C_GKL = 3072;
constexpr int NE = 32, TOPK = 4, FF = 1024;
constexpr int NUNITS_GLA = BATCH * NH * NCH;
constexpr int NROWS_MAX = M * TOPK + NE * 256;
constexpr int NTILES_MAX = NROWS_MAX / 256;
constexpr float RMS_EPS = 1e-5f;

constexpr size_t MiB = 1u << 20;
constexpr size_t WS_CTL = 0, CTL_ZERO_BYTES = 1 * MiB;
constexpr size_t WS_XN = 1 * MiB;
constexpr size_t WS_GKL = WS_XN + 32 * MiB;
constexpr size_t WS_W1T = WS_GKL + 1 * MiB;
constexpr size_t WS_WOT = WS_W1T + 6 * MiB;
constexpr size_t WS_WGUT = WS_WOT + 2 * MiB;
constexpr size_t WS_WDT = WS_WGUT + 128 * MiB;
constexpr size_t WS_PROJ = WS_WDT + 64 * MiB;
constexpr size_t WS_KVT = WS_PROJ + 96 * MiB;
constexpr size_t WS_DEC = WS_KVT + 32 * MiB;
constexpr size_t WS_ST = WS_DEC + 1 * MiB;
constexpr size_t WS_Y = WS_ST + 16 * MiB;
constexpr size_t WS_X1 = WS_Y + 32 * MiB;
constexpr size_t WS_ROUTE = WS_X1 + 64 * MiB;
constexpr size_t WS_H = WS_ROUTE + 2 * MiB;
constexpr size_t WS_CONTRIB = WS_H + 144 * MiB;
constexpr size_t WS_END = WS_CONTRIB + 144 * MiB;
constexpr size_t R_TOPI = 0;
constexpr size_t R_TOPG = 256 * 1024;
constexpr size_t R_POS = 512 * 1024;
constexpr size_t R_ROWTOK = 768 * 1024;
constexpr size_t R_ROWGATE = 1088 * 1024;
constexpr size_t R_HIST = 1408 * 1024;
constexpr size_t R_META = 1472 * 1024;
constexpr size_t R_RSTD = 1536 * 1024;
constexpr size_t R_ROWRSTD = 1664 * 1024;
constexpr int CW_BAR = 4096;

constexpr int LDS_BYTES = 160 * 1024 - 2048;
constexpr int MISC_OFF = LDS_BYTES - 1024;

__device__ __forceinline__ unsigned f2bf(float f) { unsigned u = __builtin_bit_cast(unsigned, f); return (u + 0x7fffu + ((u >> 16) & 1u)) >> 16; }
__device__ __forceinline__ unsigned pk2(float lo, float hi) { return f2bf(lo) | (f2bf(hi) << 16); }
__device__ __forceinline__ float bf2f(unsigned short b) { return __builtin_bit_cast(float, (unsigned)b << 16); }
__device__ __forceinline__ float bflo(unsigned w) { return __builtin_bit_cast(float, w << 16); }
__device__ __forceinline__ float bfhi(unsigned w) { return __builtin_bit_cast(float, w & 0xffff0000u); }
__device__ __forceinline__ unsigned cvt_pk_bf16(float lo, float hi) { unsigned r; asm volatile("v_cvt_pk_bf16_f32 %0, %1, %2" : "=v"(r) : "v"(lo), "v"(hi)); return r; }
__device__ __forceinline__ unsigned pk4_fp8(float a, float b, float c, float d) { int w = 0; w = __builtin_amdgcn_cvt_pk_fp8_f32(a, b, w, false); w = __builtin_amdgcn_cvt_pk_fp8_f32(c, d, w, true); return (unsigned)w; }
__device__ __forceinline__ float wave_sum(float v) {
#pragma unroll
    for (int o = 1; o < 64; o <<= 1) v += __shfl_xor(v, o);
    return v;
}
__device__ __forceinline__ float sigmoidf_(float x) { return 1.0f / (1.0f + __expf(-x)); }
__device__ __forceinline__ float log_sigmoidf_(float x) { return fminf(x, 0.f) - log1pf(__expf(-fabsf(x))); }
#define LDS_WAIT() asm volatile("s_waitcnt lgkmcnt(0)" ::: "memory")
#define VM_WAIT() asm volatile("s_waitcnt vmcnt(0)" ::: "memory")

#define XB_TMO      128
#define XB_XCNT(j)  (256  + 64 * (j))
#define XB_XSUB(j)  (1280 + 64 * (j))
#define XB_XGEN(j)  (2304 + 64 * (j))
#define XB_TOP      3328
#define XB_TOPGEN   3392
#define XCD_BAR_WORDS 3456
#define XB_SPIN_CAP (1u << 18)
__device__ __forceinline__ unsigned xb_ld(unsigned* p)              { return __hip_atomic_load(p, __ATOMIC_RELAXED, __HIP_MEMORY_SCOPE_AGENT); }
__device__ __forceinline__ unsigned xb_add(unsigned* p, unsigned v) { return __hip_atomic_fetch_add(p, v, __ATOMIC_RELAXED, __HIP_MEMORY_SCOPE_AGENT); }
__device__ __forceinline__ unsigned xb_xcc_id() { return (unsigned)__builtin_amdgcn_s_getreg((3 << 11) | 20) & 0xFu; }
#define XB_SPIN(cond, bar) do { unsigned _sp = 0; while (cond) { __builtin_amdgcn_s_sleep(1); \
    if ((++_sp & 255u) == 0u) { if (xb_ld(&(bar)[XB_TMO])) break; if (_sp > XB_SPIN_CAP) { atomicAdd(&(bar)[XB_TMO], 1u); break; } } } } while (0)
struct XcdBarrier { unsigned* bar; unsigned x; volatile LAS unsigned* st; };
__device__ __forceinline__ XcdBarrier xcd_barrier_post(unsigned* bar, volatile LAS unsigned* st) {
    XcdBarrier b; b.bar = bar; b.x = xb_xcc_id(); b.st = st;
    if (threadIdx.x == 0) (void)xb_add(&bar[XB_XCNT(b.x)], 1u);
    return b;
}
__device__ __forceinline__ void xcd_barrier_complete(unsigned* bar, unsigned x, unsigned& nloc, unsigned& nx) {
    const unsigned G = gridDim.x * gridDim.y * gridDim.z;
    unsigned sum, cnt, mine, sp = 0u;
    for (;;) {
        sum = 0u; cnt = 0u; mine = 0u;
#pragma unroll
        for (unsigned j = 0; j < 16; ++j) { const unsigned c = xb_ld(&bar[XB_XCNT(j)]); sum += c; cnt += (c > 0u) ? 1u : 0u; mine = (j == x) ? c : mine; }
        if (sum == G) break;
        __builtin_amdgcn_s_sleep(1);
        if ((++sp & 255u) == 0u) { if (xb_ld(&bar[XB_TMO])) break; if (sp > XB_SPIN_CAP) { atomicAdd(&bar[XB_TMO], 1u); break; } }
    }
    nloc = mine > 0u ? mine : 1u; nx = cnt > 0u ? cnt : 1u;
}
__device__ __forceinline__ void xcd_barrier(const XcdBarrier& b) {
    asm volatile("s_waitcnt vmcnt(0)" ::: "memory");
    __syncthreads();
    if (threadIdx.x == 0) {
        unsigned* bar = b.bar;
        __builtin_amdgcn_s_waitcnt(0);
        unsigned nloc = b.st[0], nx = b.st[1];
        if (nloc == 0u) { xcd_barrier_complete(bar, b.x, nloc, nx); b.st[0] = nloc; b.st[1] = nx; }
        const unsigned old = xb_add(&bar[XB_XSUB(b.x)], 1u);
        const unsigned gen = old / nloc;
        if (old + 1u == (gen + 1u) * nloc) {
            __builtin_amdgcn_fence(__ATOMIC_RELEASE, "agent");
            asm volatile("s_waitcnt vmcnt(0)" ::: "memory");
            const unsigned og = xb_add(&bar[XB_TOP], 1u);
            const unsigned tg = og / nx;
            if (og + 1u == (tg + 1u) * nx) xb_add(&bar[XB_TOPGEN], 1u);
            else XB_SPIN(xb_ld(&bar[XB_TOPGEN]) == tg, bar);
            __builtin_amdgcn_fence(__ATOMIC_ACQUIRE, "agent");
            xb_add(&bar[XB_XGEN(b.x)], 1u);
            asm volatile("s_waitcnt vmcnt(0)" ::: "memory");
        } else {
            XB_SPIN(xb_ld(&bar[XB_XGEN(b.x)]) == gen, bar);
            __builtin_amdgcn_fence(__ATOMIC_ACQUIRE, "agent");
            asm volatile("s_waitcnt vmcnt(0)" ::: "memory");
        }
    }
    __syncthreads();
}

namespace pg8 {
constexpr int BM = 256, BK = 64, HALF = 128, HTB = HALF * BK * 2, STAGE_BYTES = 8 * HTB, NXCD = 8, WGM = 8;
__host__ __device__ __forceinline__ int lds_byte(int r, int c) { const int st = (r >> 4) * 2 + (c >> 5), rr = r & 15, cc = c & 31, ob = rr * 64 + cc * 2; return st * 1024 + (ob ^ (((ob >> 9) & 1) << 5)); }
__host__ __device__ __forceinline__ void stage_rc(int b, int& R, int& C) { const int st = b / 1024, sb = b % 1024, swz = sb ^ (((sb >> 9) & 1) << 5); R = (st >> 1) * 16 + swz / 64; C = (st & 1) * 32 + (swz % 64) / 2; }
__host__ __device__ __forceinline__ int perm32(int rho) { const int n = rho >> 4, i = rho & 15; return 8 * (i >> 2) + 4 * n + (i & 3); }
struct Unit { int pm, pn, pb; };
struct StaticOrder {
    int nM, nN, nwg, G, c, reps;
    __host__ __device__ void init(int nM_, int nN_, int G_, int c_, int reps_ = 1) { nM = nM_; nN = nN_; nwg = nM * nN; G = G_; c = c_; reps = reps_; }
    __host__ __device__ bool next(int i, Unit& u) const {
        const long L = (long)i * G + c; if (L >= (long)nwg * reps) return false;
        int wgid = (int)(L % nwg); { const int q = nwg / NXCD, r = nwg % NXCD, xcd = wgid % NXCD, off = wgid / NXCD; wgid = (xcd < r ? xcd * (q + 1) : r * (q + 1) + (xcd - r) * q) + off; }
        const int nig = WGM * nN, gid = wgid / nig, fm = gid * WGM, gsz = (nM - fm) < WGM ? (nM - fm) : WGM;
        u.pm = fm + ((wgid % nig) % gsz); u.pn = (wgid % nig) / gsz; u.pb = u.pn; return true;
    }
};
struct MoeOrder {
    StaticOrder so; const int* tile_expert;
    __device__ bool next(int i, Unit& u) const { if (!so.next(i, u)) return false; u.pb = tile_expert[u.pm] * so.nN + u.pn; return true; }
};

typedef int i32x8 __attribute__((ext_vector_type(8)));
typedef int i32x4 __attribute__((ext_vector_type(4)));
template <class Epi, class Sched, bool ALIGN_EPI, bool FP8>
__device__ __forceinline__ void gemm_phase(LAS unsigned char* lds, const void* A, const void* Bt, const int ldA, const int ldB, const int nt, const int* rowidx, const Sched& S, const Epi& E) {
    const int tid = threadIdx.x, wid = __builtin_amdgcn_readfirstlane(tid >> 6), lane = tid & 63, wr = wid >> 2, wc = wid & 3, fr = lane & 15, fq = lane >> 4;
    unsigned voffB[2];
#pragma unroll
    for (int i = 0; i < 2; ++i) { int R, C; stage_rc(tid * 16 + i * 8192, R, C); const int Rb = Epi::PERM ? ((R & ~31) + perm32(R & 31)) : R; voffB[i] = (unsigned)(Rb * ldB + C * 2); }
    const size_t kstep = (size_t)(BK * 2);
    const size_t hstep = (size_t)HALF * ldB;
    const size_t tstep = 2 * hstep;
    const unsigned ldsw = (unsigned)wid * 1024u;
    const int aoff = lds_byte(wr * 64 + fr, fq * 8), boff = lds_byte(wc * 32 + fr, fq * 8);
#define PG8_SA(b, h) (((b) * 2 + (h)) * HTB)
#define PG8_SB(b, h) ((4 + (b) * 2 + (h)) * HTB)
#define PG8_STAGE(bufoff, gbase, voff) do { _Pragma("unroll") for (int _i = 0; _i < 2; ++_i) \
        __builtin_amdgcn_global_load_lds((const unsigned*)((const char*)(gbase) + (voff)[_i]), (LAS unsigned*)(lds + (bufoff) + ldsw + _i * 8192), 16, 0, 0); } while (0)
#define PG8_LDA(dst, b, h) do { _Pragma("unroll") for (int m = 0; m < 4; ++m) _Pragma("unroll") for (int k = 0; k < 2; ++k) dst[m][k] = *(const LAS bf16x8*)(lds + PG8_SA(b, h) + aoff + m * 2048 + k * 1024); } while (0)
#define PG8_LDB(dst, b, h) do { _Pragma("unroll") for (int n = 0; n < 2; ++n) _Pragma("unroll") for (int k = 0; k < 2; ++k) dst[n][k] = *(const LAS bf16x8*)(lds + PG8_SB(b, h) + boff + n * 2048 + k * 1024); } while (0)
#define PG8_F8(x) __builtin_shufflevector(__builtin_bit_cast(i32x4, (x)[0]), __builtin_bit_cast(i32x4, (x)[1]), 0, 1, 2, 3, 4, 5, 6, 7)
#define PG8_MMA(ai, bj, At, Bt_) do { __builtin_amdgcn_s_setprio(1); _Pragma("unroll") for (int m = 0; m < 4; ++m) _Pragma("unroll") for (int n = 0; n < 2; ++n) { \
        if constexpr (FP8) { const i32x8 _a = PG8_F8(Bt_[n]), _b = PG8_F8(At[m]); \
            asm volatile("v_mfma_scale_f32_16x16x128_f8f6f4 %0, %1, %2, %0, %3, %4 op_sel_hi:[0,0,0]" : "+v"(acc[ai][bj][m][n]) : "v"(_a), "v"(_b), "v"(sclW), "v"(sclX)); } \
        else { _Pragma("unroll") for (int k = 0; k < 2; ++k) acc[ai][bj][m][n] = __builtin_amdgcn_mfma_f32_16x16x32_bf16(Bt_[n][k], At[m][k], acc[ai][bj][m][n], 0, 0, 0); } } \
        __builtin_amdgcn_s_setprio(0); } while (0)
#define PG8_WAIT_V(n) asm volatile("s_waitcnt vmcnt(" #n ")" ::: "memory")
#define PG8_WAIT_L(n) asm volatile("s_waitcnt lgkmcnt(" #n ")" ::: "memory")
#define PG8_BAR __builtin_amdgcn_s_barrier()
#define PG8_SCHED __builtin_amdgcn_sched_barrier(0)
#define PG8_AOFF(dst, u) do { _Pragma("unroll") for (int _h = 0; _h < 2; ++_h) _Pragma("unroll") for (int _i = 0; _i < 2; ++_i) { int _R, _C; stage_rc(tid * 16 + _i * 8192, _R, _C); \
        const int _r = (u).pm * BM + _h * HALF + _R; const int _src = rowidx ? rowidx[_r] : _r; dst[_h][_i] = (unsigned)(_src * ldA + _C * 2); } } while (0)
    Unit cur, nxt; int ui = 0;
    if (!S.next(0, cur)) return;
    f32x4 acc[2][2][4][2];
#pragma unroll
    for (int a = 0; a < 2; ++a)
#pragma unroll
        for (int b = 0; b < 2; ++b)
#pragma unroll
            for (int m = 0; m < 4; ++m)
#pragma unroll
                for (int n = 0; n < 2; ++n) acc[a][b][m][n] = (f32x4){0.f, 0.f, 0.f, 0.f};
    bf16x8 At[4][2], B0[2][2], B1[2][2];
    int sclW = 0x7A7A7A7A, sclX = 0x7F7F7F7F;
    asm volatile("" : "+v"(sclW), "+v"(sclX));
    unsigned ca[2][2], na[2][2];
    PG8_AOFF(ca, cur);
    if (rowidx) VM_WAIT();
    const char* cA = (const char*)A; const char* cB = (const char*)Bt + (size_t)cur.pb * tstep;
    PG8_STAGE(PG8_SB(0, 0), cB, voffB); PG8_STAGE(PG8_SB(0, 1), cB + hstep, voffB); PG8_STAGE(PG8_SA(0, 0), cA, ca[0]); PG8_STAGE(PG8_SA(0, 1), cA, ca[1]);
    if (wr == 1) PG8_BAR;
    PG8_WAIT_V(2); PG8_BAR;
    PG8_STAGE(PG8_SB(1, 0), cB + kstep, voffB); PG8_STAGE(PG8_SA(1, 0), cA + kstep, ca[0]); PG8_STAGE(PG8_SB(1, 1), cB + hstep + kstep, voffB);
    PG8_WAIT_V(6); PG8_BAR;
    for (;;) {
        const bool has_next = S.next(ui + 1, nxt);
        if (has_next) { PG8_AOFF(na, nxt); }
        else {
#pragma unroll
            for (int h = 0; h < 2; ++h)
#pragma unroll
                for (int i = 0; i < 2; ++i) na[h][i] = ca[h][i];
        }
        const char* nB = has_next ? (const char*)Bt + (size_t)nxt.pb * tstep : cB;
#pragma unroll 1
        for (int t = 0; t < nt; t += 2) {
            const bool last = (t == nt - 2);
            const char* a1 = cA + (size_t)(t + 1) * kstep;
            const char* a2 = last ? cA : cA + (size_t)(t + 2) * kstep; const char* b2 = last ? nB : cB + (size_t)(t + 2) * kstep;
            const char* a3 = a2 + kstep; const char* b3 = b2 + kstep;
            unsigned o2[2][2];
#pragma unroll
            for (int h = 0; h < 2; ++h)
#pragma unroll
                for (int i = 0; i < 2; ++i) o2[h][i] = last ? na[h][i] : ca[h][i];
            PG8_LDB(B0, 0, 0); PG8_LDB(B1, 0, 1); PG8_SCHED; PG8_LDA(At, 0, 0); PG8_STAGE(PG8_SA(1, 1), a1, ca[1]);
            PG8_WAIT_V(8); PG8_WAIT_L(0); PG8_BAR; PG8_MMA(0, 0, At, B0); PG8_MMA(0, 1, At, B1); PG8_BAR; PG8_SCHED;
            PG8_LDA(At, 0, 1); PG8_STAGE(PG8_SB(0, 0), b2, voffB); PG8_STAGE(PG8_SB(0, 1), b2 + hstep, voffB); PG8_STAGE(PG8_SA(0, 0), a2, o2[0]);
            PG8_WAIT_V(8); PG8_WAIT_L(0); PG8_BAR; PG8_MMA(1, 0, At, B0); PG8_MMA(1, 1, At, B1); PG8_BAR; PG8_SCHED;
            PG8_LDB(B0, 1, 0); PG8_LDB(B1, 1, 1); PG8_SCHED; PG8_LDA(At, 1, 0); PG8_STAGE(PG8_SA(0, 1), a2, o2[1]);
            PG8_WAIT_V(8); PG8_WAIT_L(0); PG8_BAR; PG8_MMA(0, 0, At, B0); PG8_MMA(0, 1, At, B1); PG8_BAR; PG8_SCHED;
            PG8_LDA(At, 1, 1); PG8_STAGE(PG8_SB(1, 0), b3, voffB); PG8_STAGE(PG8_SB(1, 1), b3 + hstep, voffB); PG8_STAGE(PG8_SA(1, 0), a3, o2[0]);
            PG8_WAIT_V(8); PG8_WAIT_L(0); PG8_BAR; PG8_MMA(1, 0, At, B0); PG8_MMA(1, 1, At, B1); PG8_BAR; PG8_SCHED;
        }
        if constexpr (ALIGN_EPI) { if (wr == 0) PG8_BAR; }
        if constexpr (FP8) asm volatile("s_nop 15\n\ts_nop 15" ::: "memory");
        E(acc, cur, wr, wc, fr, fq);
        if (!has_next) break;
#pragma unroll
        for (int a = 0; a < 2; ++a)
#pragma unroll
            for (int b = 0; b < 2; ++b)
#pragma unroll
                for (int m = 0; m < 4; ++m)
#pragma unroll
                    for (int n = 0; n < 2; ++n) acc[a][b][m][n] = (f32x4){0.f, 0.f, 0.f, 0.f};
        cur = nxt; cB = nB; ++ui;
#pragma unroll
        for (int h = 0; h < 2; ++h)
#pragma unroll
            for (int i = 0; i < 2; ++i) ca[h][i] = na[h][i];
        if constexpr (ALIGN_EPI) { if (wr == 1) PG8_BAR; }
    }
    PG8_WAIT_V(0);
    if constexpr (!ALIGN_EPI) { if (wr == 0) PG8_BAR; }
    PG8_BAR;
#undef PG8_SA
#undef PG8_SB
#undef PG8_STAGE
#undef PG8_LDA
#undef PG8_LDB
#undef PG8_MMA
#undef PG8_F8
#undef PG8_WAIT_V
#undef PG8_WAIT_L
#undef PG8_BAR
#undef PG8_SCHED
#undef PG8_AOFF
}

struct EpiBf16 {
    static constexpr bool PERM = true;
    bf16_t* O; int ldc;
    __device__ __forceinline__ void operator()(const f32x4 (&acc)[2][2][4][2], const Unit& u, int wr, int wc, int fr, int fq) const {
        const int row0 = u.pm * BM + wr * 64 + fr, col0 = u.pn * BM + wc * 32 + 8 * fq;
#pragma unroll
        for (int ai = 0; ai < 2; ++ai)
#pragma unroll
            for (int m = 0; m < 4; ++m) { bf16_t* rowp = O + (size_t)(row0 + ai * HALF + m * 16) * ldc + col0;
#pragma unroll
                for (int bj = 0; bj < 2; ++bj) { const f32x4 v0 = acc[ai][bj][m][0], v1 = acc[ai][bj][m][1];
                    u32x4 w; w.x = cvt_pk_bf16(v0[0], v0[1]); w.y = cvt_pk_bf16(v0[2], v0[3]); w.z = cvt_pk_bf16(v1[0], v1[1]); w.w = cvt_pk_bf16(v1[2], v1[3]);
                    *(u32x4*)(rowp + bj * HALF) = w; } }
    }
};
struct EpiResF32 {
    static constexpr bool PERM = false;
    const float* base; float* C; int ldc;
    __device__ __forceinline__ void operator()(const f32x4 (&acc)[2][2][4][2], const Unit& u, int wr, int wc, int fr, int fq) const {
        const int row0 = u.pm * BM + wr * 64 + fr, col0 = u.pn * BM + wc * 32 + 4 * fq;
#pragma unroll
        for (int ai = 0; ai < 2; ++ai)
#pragma unroll
            for (int m = 0; m < 4; ++m) { const size_t off = (size_t)(row0 + ai * HALF + m * 16) * ldc + col0;
#pragma unroll
                for (int bj = 0; bj < 2; ++bj)
#pragma unroll
                    for (int n = 0; n < 2; ++n) { const f32x4 bs = *(const f32x4*)(base + off + bj * HALF + n * 16); *(f32x4*)(C + off + bj * HALF + n * 16) = bs + acc[ai][bj][m][n]; }
                asm volatile("" ::: "memory"); }
    }
};
struct EpiSwiglu {
    static constexpr bool PERM = true;
    bf16_t* Hb; const float* bgu; const int* tile_expert; const float* row_rstd;
    __device__ __forceinline__ void operator()(const f32x4 (&acc)[2][2][4][2], const Unit& u, int wr, int wc, int fr, int fq) const {
        const int e = tile_expert[u.pm];
        const int row0 = u.pm * BM + wr * 64 + fr, col0 = u.pn * HALF + wc * 32 + 8 * fq;
        const float* bg = bgu + (size_t)e * 2048 + col0; const float* bu = bg + 1024;
        const f32x4 g0 = *(const f32x4*)bg, g1 = *(const f32x4*)(bg + 4), u0 = *(const f32x4*)bu, u1 = *(const f32x4*)(bu + 4);
#pragma unroll
        for (int ai = 0; ai < 2; ++ai)
#pragma unroll
            for (int m = 0; m < 4; ++m) {
                float r[8]; const float rs = row_rstd[row0 + ai * HALF + m * 16];
#pragma unroll
                for (int n = 0; n < 2; ++n)
#pragma unroll
                    for (int j = 0; j < 4; ++j) {
                        float gt = acc[ai][0][m][n][j] * rs + (n ? g1[j] : g0[j]); float up = acc[ai][1][m][n][j] * rs + (n ? u1[j] : u0[j]);
                        gt = fminf(gt, 7.0f); up = fminf(fmaxf(up, -7.0f), 7.0f);
                        const float glu = gt * sigmoidf_(gt * 1.702f);
                        r[n * 4 + j] = (up + 1.0f) * glu; }
                if constexpr (MOE_FP8) { u32x2 w; w.x = pk4_fp8(r[0], r[1], r[2], r[3]); w.y = pk4_fp8(r[4], r[5], r[6], r[7]);
                    *(u32x2*)((unsigned char*)Hb + (size_t)(row0 + ai * HALF + m * 16) * FF + col0) = w; }
                else { u32x4 w; w.x = cvt_pk_bf16(r[0], r[1]); w.y = cvt_pk_bf16(r[2], r[3]); w.z = cvt_pk_bf16(r[4], r[5]); w.w = cvt_pk_bf16(r[6], r[7]);
                    *(u32x4*)(Hb + (size_t)(row0 + ai * HALF + m * 16) * FF + col0) = w; } }
    }
};
struct EpiDown {
    static constexpr bool PERM = true;
    bf16_t* Cb; const float* bd; const float* row_gate; const int* tile_expert;
    __device__ __forceinline__ void operator()(const f32x4 (&acc)[2][2][4][2], const Unit& u, int wr, int wc, int fr, int fq) const {
        const int e = tile_expert[u.pm];
        const int row0 = u.pm * BM + wr * 64 + fr, col0 = u.pn * BM + wc * 32 + 8 * fq;
        f32x4 bv[2][2];
#pragma unroll
        for (int bj = 0; bj < 2; ++bj)
#pragma unroll
            for (int n = 0; n < 2; ++n) bv[bj][n] = *(const f32x4*)(bd + (size_t)e * D + col0 + bj * HALF + 4 * n);
#pragma unroll
        for (int ai = 0; ai < 2; ++ai)
#pragma unroll
            for (int m = 0; m < 4; ++m) { const int row = row0 + ai * HALF + m * 16; const float gt = row_gate[row]; bf16_t* rowp = Cb + (size_t)row * D + col0;
#pragma unroll
                for (int bj = 0; bj < 2; ++bj) { const f32x4 v0 = (acc[ai][bj][m][0] + bv[bj][0]) * gt, v1 = (acc[ai][bj][m][1] + bv[bj][1]) * gt;
                    u32x4 w; w.x = cvt_pk_bf16(v0[0], v0[1]); w.y = cvt_pk_bf16(v0[2], v0[3]); w.z = cvt_pk_bf16(v1[0], v1[1]); w.w = cvt_pk_bf16(v1[2], v1[3]);
                    *(u32x4*)(rowp + bj * HALF) = w; } }
    }
};
}

struct Args { const float* in[16]; float* out; unsigned char* ws; int ph_lo, ph_hi, li, pad; };
struct Frame {
    LAS unsigned char* lds; int tid, lane, wave, G, bx;
    const float *x, *g_mix, *w_in, *conv_w, *w_gk_up, *b_gk_up, *gla_g, *w_out, *g_ffn, *w_router, *b_router, *w_gu, *b_gu, *w_dn, *b_dn, *g_fin;
    float* out; unsigned char* ws;
};

__device__ __forceinline__ void p0_transpose_item(const float* W, int ldn, int K, int k0, int n0, bf16_t* WT, int drow0, LAS float* scr, int lane) {
#pragma unroll 8
    for (int i = 0; i < 32; ++i) { const int kk = 2 * i + (lane >> 5); scr[kk * 33 + (lane & 31)] = W[(size_t)(k0 + kk) * ldn + n0 + (lane & 31)]; }
    LDS_WAIT(); asm volatile("" ::: "memory");
    const int c = lane & 7;
#pragma unroll
    for (int j = 0; j < 4; ++j) { const int n = (lane >> 3) + 8 * j; const LAS float* s = scr + (8 * c) * 33 + n;
        u32x4 o; o.x = pk2(s[0 * 33], s[1 * 33]); o.y = pk2(s[2 * 33], s[3 * 33]); o.z = pk2(s[4 * 33], s[5 * 33]); o.w = pk2(s[6 * 33], s[7 * 33]);
        *(GAS u32x4*)(WT + (size_t)(drow0 + n) * K + k0 + 8 * c) = o; }
    LDS_WAIT(); asm volatile("" ::: "memory");
}
__device__ __forceinline__ void p0_transpose_item_f8(const float* W, int ldn, int K, int k0, int n0, unsigned char* WT8, int drow0, LAS float* scr, int lane, float scale) {
#pragma unroll 8
    for (int i = 0; i < 32; ++i) { const int kk = 2 * i + (lane >> 5); scr[kk * 33 + (lane & 31)] = W[(size_t)(k0 + kk) * ldn + n0 + (lane & 31)]; }
    LDS_WAIT(); asm volatile("" ::: "memory");
    const int c = lane & 3;
#pragma unroll
    for (int j = 0; j < 2; ++j) { const int n = (lane >> 2) + 16 * j; const LAS float* s = scr + (16 * c) * 33 + n;
        u32x4 o;
        o.x = pk4_fp8(s[0 * 33] * scale, s[1 * 33] * scale, s[2 * 33] * scale, s[3 * 33] * scale); o.y = pk4_fp8(s[4 * 33] * scale, s[5 * 33] * scale, s[6 * 33] * scale, s[7 * 33] * scale);
        o.z = pk4_fp8(s[8 * 33] * scale, s[9 * 33] * scale, s[10 * 33] * scale, s[11 * 33] * scale); o.w = pk4_fp8(s[12 * 33] * scale, s[13 * 33] * scale, s[14 * 33] * scale, s[15 * 33] * scale);
        *(GAS u32x4*)(WT8 + (size_t)(drow0 + n) * K + k0 + 16 * c) = o; }
    LDS_WAIT(); asm volatile("" ::: "memory");
}
__device__ __forceinline__ void p0_prep(Frame& F) {
    LAS float* w16t = (LAS float*)F.lds;
    LAS float* scr = (LAS float*)(F.lds + 65536 + F.wave * 8448);
    for (int i = F.tid; i < 1024 * 16; i += NTHR) { const int k = i >> 4, r = i & 15; w16t[r * 1024 + k] = F.w_in[(size_t)k * DIN + C_GKL + r]; }
    __syncthreads();
    const int gw = F.bx * NWAVES + F.wave, NGW = F.G * NWAVES;
    bf16_t* XN = (bf16_t*)(F.ws + WS_XN); float* GKL = (float*)(F.ws + WS_GKL);
    for (int m = gw; m < M; m += NGW) {
        const GAS f32x4* xr = (const GAS f32x4*)(F.x + (size_t)m * D) + F.lane;
        f32x4 v[4]; float s2 = 0.f;
#pragma unroll
        for (int j = 0; j < 4; ++j) { v[j] = xr[64 * j]; s2 += (v[j].x * v[j].x + v[j].y * v[j].y) + (v[j].z * v[j].z + v[j].w * v[j].w); }
        const float rstd = 1.0f / sqrtf(wave_sum(s2) * (1.0f / D) + RMS_EPS);
        GAS u32x2* o8 = (GAS u32x2*)(XN + (size_t)m * D) + F.lane;
#pragma unroll
        for (int j = 0; j < 4; ++j) { const f32x4 g = *((const GAS f32x4*)F.g_mix + F.lane + 64 * j); v[j] = v[j] * rstd * g;
            u32x2 w; w.x = pk2(v[j].x, v[j].y); w.y = pk2(v[j].z, v[j].w); o8[64 * j] = w; }
        float acc[16];
#pragma unroll
        for (int r = 0; r < 16; ++r) { float a = 0.f;
#pragma unroll
            for (int j = 0; j < 4; ++j) { const f32x4 w = *(const LAS f32x4*)(w16t + r * 1024 + 4 * F.lane + 256 * j); a += (v[j].x * w.x + v[j].y * w.y) + (v[j].z * w.z + v[j].w * w.w); }
            acc[r] = a; if ((r & 3) == 3) asm volatile("" ::: "memory"); }
        float a8[8], a4[4], a2[2], a1;
        { const bool hi = (F.lane & 32) != 0;
#pragma unroll
          for (int i = 0; i < 8; ++i) { const float send = hi ? acc[i] : acc[i + 8]; const float keep = hi ? acc[i + 8] : acc[i]; a8[i] = keep + __shfl_xor(send, 32); } }
        { const bool hi = (F.lane & 16) != 0;
#pragma unroll
          for (int i = 0; i < 4; ++i) { const float send = hi ? a8[i] : a8[i + 4]; const float keep = hi ? a8[i + 4] : a8[i]; a4[i] = keep + __shfl_xor(send, 16); } }
        { const bool hi = (F.lane & 8) != 0;
#pragma unroll
          for (int i = 0; i < 2; ++i) { const float send = hi ? a4[i] : a4[i + 2]; const float keep = hi ? a4[i + 2] : a4[i]; a2[i] = keep + __shfl_xor(send, 8); } }
        { const bool hi = (F.lane & 4) != 0; const float send = hi ? a2[0] : a2[1]; const float keep = hi ? a2[1] : a2[0]; a1 = keep + __shfl_xor(send, 4); }
        a1 += __shfl_xor(a1, 2); a1 += __shfl_xor(a1, 1);
        if ((F.lane & 3) == 0) GKL[(size_t)m * 16 + (F.lane >> 2)] = a1;
    }
    constexpr int I_1 = (D / 64) * (NPROJ / 32), I_O = (D / 64) * (D / 32), I_GU = (D / 64) * (2 * FF / 32), I_DN = (FF / 64) * (D / 32);
    constexpr int NITEMS = I_1 + I_O + NE * (I_GU + I_DN);
    bf16_t* W1T = (bf16_t*)(F.ws + WS_W1T); bf16_t* WOT = (bf16_t*)(F.ws + WS_WOT); bf16_t* WGUT = (bf16_t*)(F.ws + WS_WGUT); bf16_t* WDT = (bf16_t*)(F.ws + WS_WDT);
    for (int it = gw; it < NITEMS; it += NGW) {
        int r = it;
        if (r < I_1) { const int nblk = NPROJ / 32, kb = r / nblk, nb = r % nblk; p0_transpose_item(F.w_in, DIN, D, 64 * kb, 32 * nb, W1T, 32 * nb, scr, F.lane); continue; } r -= I_1;
        if (r < I_O) { const int nblk = D / 32, kb = r / nblk, nb = r % nblk; p0_transpose_item(F.w_out, D, D, 64 * kb, 32 * nb, WOT, 32 * nb, scr, F.lane); continue; } r -= I_O;
        const int e = r / (I_GU + I_DN); r -= e * (I_GU + I_DN);
        if (r < I_GU) { const int nblk = 2 * FF / 32, kb = r / nblk, nb = r % nblk; const int n0 = 32 * nb, half = n0 / FF, j = n0 % FF, pn = j / 128, i0 = j % 128;
            if constexpr (MOE_FP8) p0_transpose_item_f8(F.w_gu + (size_t)e * D * 2 * FF, 2 * FF, D, 64 * kb, n0, (unsigned char*)WGUT + (size_t)e * 2 * FF * D, pn * 256 + half * 128 + i0, scr, F.lane, 32.0f);
            else p0_transpose_item(F.w_gu + (size_t)e * D * 2 * FF, 2 * FF, D, 64 * kb, n0, WGUT + (size_t)e * 2 * FF * D, pn * 256 + half * 128 + i0, scr, F.lane); continue; } r -= I_GU;
        { const int nblk = D / 32, kb = r / nblk, nb = r % nblk;
          if constexpr (MOE_FP8) p0_transpose_item_f8(F.w_dn + (size_t)e * FF * D, D, FF, 64 * kb, 32 * nb, (unsigned char*)WDT + (size_t)e * D * FF, 32 * nb, scr, F.lane, 32.0f);
          else p0_transpose_item(F.w_dn + (size_t)e * FF * D, D, FF, 64 * kb, 32 * nb, WDT + (size_t)e * D * FF, 32 * nb, scr, F.lane); }
    }
}

__device__ __forceinline__ void gla_decay(Frame& F, int tok, int h, float (&bc)[8], float (&blast)[8]) {
    const float* GKL = (const float*)(F.ws + WS_GKL);
    float gl[16];
#pragma unroll
    for (int q = 0; q < 4; ++q) { const f32x4 t = *(const f32x4*)(GKL + (size_t)tok * 16 + 4 * q); gl[4 * q] = t.x; gl[4 * q + 1] = t.y; gl[4 * q + 2] = t.z; gl[4 * q + 3] = t.w; }
    const int dbase = h * DK + 8 * F.wave;
#pragma unroll
    for (int i = 0; i < 8; ++i) {
        float gk = F.b_gk_up[dbase + i];
#pragma unroll
        for (int r = 0; r < 16; ++r) gk += gl[r] * F.w_gk_up[r * (NH * DK) + dbase + i];
        float la = log_sigmoidf_(gk) * (1.0f / 16.0f);
#pragma unroll
        for (int o = 1; o < 64; o <<= 1) { const float t = __shfl_up(la, o); if (F.lane >= o) la += t; }
        bc[i] = la; blast[i] = __shfl(la, 63);
    }
}

constexpr int LP = 72;
__device__ __forceinline__ void p2_gla_kv(Frame& F) {
    const bf16_t* PROJ = (const bf16_t*)(F.ws + WS_PROJ); float* KVT = (float*)(F.ws + WS_KVT); float* DEC = (float*)(F.ws + WS_DEC);
    LAS bf16_t* kremT = (LAS bf16_t*)F.lds;
    LAS bf16_t* vT = (LAS bf16_t*)(F.lds + 64 * LP * 2);
    const int lane = F.lane, w = F.wave;
    for (int u = F.bx; u < NUNITS_GLA; u += F.G) {
        const int b = u / (NH * NCH), h = (u / NCH) % NH, n = u % NCH;
        const int tok = b * SEQ + n * CHUNK + lane;
        float bc[8], blast[8];
        gla_decay(F, tok, h, bc, blast);
        const u32x4 kraw = *(const u32x4*)(PROJ + (size_t)tok * NPROJ + C_K + h * DK + 8 * w);
        const unsigned kw[4] = {kraw.x, kraw.y, kraw.z, kraw.w};
#pragma unroll
        for (int i = 0; i < 8; ++i) { const float kv = (i & 1) ? bfhi(kw[i >> 1]) : bflo(kw[i >> 1]);
            kremT[(8 * w + i) * LP + lane] = (bf16_t)f2bf(kv * __expf(blast[i] - bc[i])); }
        if (lane == 0) {
#pragma unroll
            for (int i = 0; i < 8; ++i) DEC[(size_t)u * DK + 8 * w + i] = __expf(blast[i]);
        }
#pragma unroll
        for (int q = 0; q < 2; ++q) { const u32x4 vraw = *(const u32x4*)(PROJ + (size_t)tok * NPROJ + C_V + h * DV + 16 * w + 8 * q);
            const unsigned vw[4] = {vraw.x, vraw.y, vraw.z, vraw.w};
#pragma unroll
            for (int i = 0; i < 8; ++i) vT[(16 * w + 8 * q + i) * LP + lane] = (bf16_t)((i & 1) ? (vw[i >> 1] >> 16) : (vw[i >> 1] & 0xffffu)); }
        __syncthreads();
        const int fr = lane & 15, fq = lane >> 4;
        bf16x8 a[2];
#pragma unroll
        for (int s = 0; s < 2; ++s) a[s] = *(const LAS bf16x8*)(vT + (16 * w + fr) * LP + 8 * fq + 32 * s);
#pragma unroll
        for (int dt = 0; dt < 4; ++dt) {
            f32x4 c = (f32x4){0.f, 0.f, 0.f, 0.f};
#pragma unroll
            for (int s = 0; s < 2; ++s) { const bf16x8 bb = *(const LAS bf16x8*)(kremT + (16 * dt + fr) * LP + 8 * fq + 32 * s); c = __builtin_amdgcn_mfma_f32_16x16x32_bf16(a[s], bb, c, 0, 0, 0); }
#pragma unroll
            for (int r = 0; r < 4; ++r) KVT[((size_t)u * DV + 16 * w + 4 * fq + r) * DK + 16 * dt + fr] = c[r];
        }
        __syncthreads();
    }
}

__device__ __forceinline__ void p3_scan(Frame& F) {
    const float* KVT = (const float*)(F.ws + WS_KVT); const float* DEC = (const float*)(F.ws + WS_DEC); bf16_t* ST = (bf16_t*)(F.ws + WS_ST);
    for (int gid = F.bx * NTHR + F.tid; gid < BATCH * NH * DV * DK; gid += F.G * NTHR) {
        const int bh = gid >> 13, vd = gid & 8191, d = gid & 63;
        float S = 0.f;
#pragma unroll 8
        for (int n = 0; n < NCH; ++n) { const size_t u = (size_t)bh * NCH + n;
            ST[u * (DV * DK) + vd] = (bf16_t)f2bf(S);
            S = DEC[u * DK + d] * S + KVT[u * (DV * DK) + vd]; }
    }
}

__device__ __forceinline__ void p4_gla_out(Frame& F) {
    const bf16_t* PROJ = (const bf16_t*)(F.ws + WS_PROJ); const bf16_t* ST = (const bf16_t*)(F.ws + WS_ST); bf16_t* Y = (bf16_t*)(F.ws + WS_Y);
    LAS bf16_t* qd = (LAS bf16_t*)F.lds;
    LAS bf16_t* kd = (LAS bf16_t*)(F.lds + 64 * LP * 2);
    LAS bf16_t* vT = (LAS bf16_t*)(F.lds + 2 * 64 * LP * 2);
    LAS bf16_t* pm = (LAS bf16_t*)(F.lds + 4 * 64 * LP * 2);
    LAS float* red = (LAS float*)(F.lds + 5 * 64 * LP * 2);
    const int lane = F.lane, w = F.wave, fr = lane & 15, fq = lane >> 4;
    for (int u = F.bx; u < NUNITS_GLA; u += F.G) {
        const int b = u / (NH * NCH), h = (u / NCH) % NH, n = u % NCH;
        const int tok0 = b * SEQ + n * CHUNK, tok = tok0 + lane;
        float bc[8], blast[8];
        gla_decay(F, tok, h, bc, blast);
        { const u32x4 qraw = *(const u32x4*)(PROJ + (size_t)tok * NPROJ + C_Q + h * DK + 8 * w);
          const u32x4 kraw = *(const u32x4*)(PROJ + (size_t)tok * NPROJ + C_K + h * DK + 8 * w);
          const unsigned qw[4] = {qraw.x, qraw.y, qraw.z, qraw.w}, kw[4] = {kraw.x, kraw.y, kraw.z, kraw.w};
          u32x4 qo, ko; unsigned qq[4], kk[4];
#pragma unroll
          for (int p = 0; p < 4; ++p) { const float e0 = __expf(bc[2 * p]), e1 = __expf(bc[2 * p + 1]);
              qq[p] = pk2(bflo(qw[p]) * 0.125f * e0, bfhi(qw[p]) * 0.125f * e1);
              kk[p] = pk2(bflo(kw[p]) * __expf(-bc[2 * p]), bfhi(kw[p]) * __expf(-bc[2 * p + 1])); }
          qo.x = qq[0]; qo.y = qq[1]; qo.z = qq[2]; qo.w = qq[3]; ko.x = kk[0]; ko.y = kk[1]; ko.z = kk[2]; ko.w = kk[3];
          *(LAS u32x4*)(qd + lane * LP + 8 * w) = qo; *(LAS u32x4*)(kd + lane * LP + 8 * w) = ko; }
#pragma unroll
        for (int q = 0; q < 2; ++q) { const u32x4 vraw = *(const u32x4*)(PROJ + (size_t)tok * NPROJ + C_V + h * DV + 16 * w + 8 * q);
            const unsigned vw[4] = {vraw.x, vraw.y, vraw.z, vraw.w};
#pragma unroll
            for (int i = 0; i < 8; ++i) vT[(16 * w + 8 * q + i) * LP + lane] = (bf16_t)((i & 1) ? (vw[i >> 1] >> 16) : (vw[i >> 1] & 0xffffu)); }
        __syncthreads();
        { const int ct = w >> 1;
          bf16x8 a[2];
#pragma unroll
          for (int s = 0; s < 2; ++s) a[s] = *(const LAS bf16x8*)(qd + (16 * ct + fr) * LP + 8 * fq + 32 * s);
#pragma unroll
          for (int jj = 0; jj < 2; ++jj) { const int jt = 2 * (w & 1) + jj;
              f32x4 c = (f32x4){0.f, 0.f, 0.f, 0.f};
#pragma unroll
              for (int s = 0; s < 2; ++s) { const bf16x8 bb = *(const LAS bf16x8*)(kd + (16 * jt + fr) * LP + 8 * fq + 32 * s); c = __builtin_amdgcn_mfma_f32_16x16x32_bf16(a[s], bb, c, 0, 0, 0); }
#pragma unroll
              for (int r = 0; r < 4; ++r) { const int cc = 16 * ct + 4 * fq + r, jcol = 16 * jt + fr; pm[cc * LP + jcol] = (bf16_t)f2bf(jcol <= cc ? c[r] : 0.f); } } }
        __syncthreads();
        const int ct = w & 3, vt0 = 4 * (w >> 2);
        bf16x8 ap[2], aq[2];
#pragma unroll
        for (int s = 0; s < 2; ++s) { ap[s] = *(const LAS bf16x8*)(pm + (16 * ct + fr) * LP + 8 * fq + 32 * s); aq[s] = *(const LAS bf16x8*)(qd + (16 * ct + fr) * LP + 8 * fq + 32 * s); }
        f32x4 o[4]; float ss[4] = {0.f, 0.f, 0.f, 0.f};
#pragma unroll
        for (int vi = 0; vi < 4; ++vi) { const int vt = vt0 + vi;
            f32x4 c = (f32x4){0.f, 0.f, 0.f, 0.f};
#pragma unroll
            for (int s = 0; s < 2; ++s) { const bf16x8 bb = *(const LAS bf16x8*)(vT + (16 * vt + fr) * LP + 8 * fq + 32 * s); c = __builtin_amdgcn_mfma_f32_16x16x32_bf16(ap[s], bb, c, 0, 0, 0); }
#pragma unroll
            for (int s = 0; s < 2; ++s) { const bf16x8 bb = *(const bf16x8*)(ST + ((size_t)u * DV + 16 * vt + fr) * DK + 8 * fq + 32 * s); c = __builtin_amdgcn_mfma_f32_16x16x32_bf16(aq[s], bb, c, 0, 0, 0); }
            o[vi] = c;
#pragma unroll
            for (int r = 0; r < 4; ++r) ss[r] += c[r] * c[r]; }
#pragma unroll
        for (int r = 0; r < 4; ++r) { float t = ss[r]; t += __shfl_xor(t, 1); t += __shfl_xor(t, 2); t += __shfl_xor(t, 4); t += __shfl_xor(t, 8); ss[r] = t; }
        if (fr == 0) {
#pragma unroll
            for (int r = 0; r < 4; ++r) red[w * 16 + 4 * fq + r] = ss[r];
        }
        __syncthreads();
#pragma unroll
        for (int r = 0; r < 4; ++r) { const float tot = red[ct * 16 + 4 * fq + r] + red[(ct + 4) * 16 + 4 * fq + r]; const float rstd = 1.0f / sqrtf(tot * (1.0f / DV) + RMS_EPS);
            const int trow = tok0 + 16 * ct + 4 * fq + r;
#pragma unroll
            for (int vi = 0; vi < 4; ++vi) { const int v = 16 * (vt0 + vi) + fr;
                const float g = bf2f(PROJ[(size_t)trow * NPROJ + C_G + h * DV + v]);
                const float val = o[vi][r] * rstd * F.gla_g[v] * (g * sigmoidf_(g));
                Y[(size_t)trow * D + CONVW + h * DV + v] = (bf16_t)f2bf(val); } }
        __syncthreads();
    }
    for (int it = F.bx * NTHR + F.tid; it < M * (CONVW / 8); it += F.G * NTHR) {
        const int t = it >> 6, c8 = (it & 63) * 8, s = t & (SEQ - 1);
        float acc[8];
#pragma unroll
        for (int j = 0; j < 8; ++j) acc[j] = 0.f;
#pragma unroll
        for (int i = 0; i < 3; ++i) { const int sp = s - 2 + i; if (sp < 0) continue;
            const size_t ro = (size_t)(t - 2 + i) * NPROJ;
            const u32x4 uh = *(const u32x4*)(PROJ + ro + C_UH + c8), gc = *(const u32x4*)(PROJ + ro + C_GC + c8);
            const unsigned uw[4] = {uh.x, uh.y, uh.z, uh.w}, gw[4] = {gc.x, gc.y, gc.z, gc.w};
            const f32x4 w0 = *(const f32x4*)(F.conv_w + i * CONVW + c8), w1 = *(const f32x4*)(F.conv_w + i * CONVW + c8 + 4);
            const float ww[8] = {w0.x, w0.y, w0.z, w0.w, w1.x, w1.y, w1.z, w1.w};
#pragma unroll
            for (int p = 0; p < 4; ++p) { acc[2 * p] += ww[2 * p] * (bflo(uw[p]) * bflo(gw[p])); acc[2 * p + 1] += ww[2 * p + 1] * (bfhi(uw[p]) * bfhi(gw[p])); } }
        const u32x4 gb = *(const u32x4*)(PROJ + (size_t)t * NPROJ + C_GB + c8); const unsigned bw[4] = {gb.x, gb.y, gb.z, gb.w};
        u32x4 o;
        o.x = pk2(bflo(bw[0]) * acc[0], bfhi(bw[0]) * acc[1]); o.y = pk2(bflo(bw[1]) * acc[2], bfhi(bw[1]) * acc[3]);
        o.z = pk2(bflo(bw[2]) * acc[4], bfhi(bw[2]) * acc[5]); o.w = pk2(bflo(bw[3]) * acc[6], bfhi(bw[3]) * acc[7]);
        *(u32x4*)(Y + (size_t)t * D + c8) = o;
    }
}

constexpr int WRP = 1032;
__device__ __forceinline__ void p6_router(Frame& F) {
    LAS bf16_t* wh = (LAS bf16_t*)F.lds;
    LAS bf16_t* wl = (LAS bf16_t*)(F.lds + 32 * WRP * 2);
    LAS float* lgp = (LAS float*)(F.lds + 2 * 32 * WRP * 2);
    LAS int* hist = (LAS int*)(F.lds + 2 * 32 * WRP * 2 + 2 * 64 * 33 * 4);
    const float* X1 = (const float*)(F.ws + WS_X1); bf16_t* XB = (bf16_t*)(F.ws + WS_XN); float* RSTD = (float*)(F.ws + WS_ROUTE + R_RSTD);
    int* TOPI = (int*)(F.ws + WS_ROUTE + R_TOPI); float* TOPG = (float*)(F.ws + WS_ROUTE + R_TOPG); int* HIST = (int*)(F.ws + WS_ROUTE + R_HIST);
    for (int i = F.tid; i < 1024 * 32; i += NTHR) { const int k = i >> 5, e = i & 31; const float wv = F.w_router[i]; const unsigned h = f2bf(wv); const float hf = __builtin_bit_cast(float, h << 16);
        wh[e * WRP + k] = (bf16_t)h; wl[e * WRP + k] = (bf16_t)f2bf(wv - hf); }
    const int lane = F.lane, w = F.wave, fr = lane & 15, fq = lane >> 4, rt = w & 3, kh = w >> 2;
    for (int wg = F.bx; wg < M / 64; wg += F.G) {
        if (F.tid < 32) hist[F.tid] = 0;
        __syncthreads();
        const int m = wg * 64 + rt * 16 + fr;
        const float* xrow = X1 + (size_t)m * D + kh * 512 + 8 * fq;
        bf16_t* orow = XB + (size_t)m * D + kh * 512 + 8 * fq;
        const float* grow = F.g_ffn + kh * 512 + 8 * fq;
        f32x4 c0 = (f32x4){0.f, 0.f, 0.f, 0.f}, c1 = c0; float s2 = 0.f;
#pragma unroll 4
        for (int s = 0; s < 16; ++s) {
            const f32x4 x0 = *(const f32x4*)(xrow + 32 * s), x1v = *(const f32x4*)(xrow + 32 * s + 4);
            const f32x4 g0 = *(const f32x4*)(grow + 32 * s), g1 = *(const f32x4*)(grow + 32 * s + 4);
            s2 += (x0.x * x0.x + x0.y * x0.y) + (x0.z * x0.z + x0.w * x0.w) + (x1v.x * x1v.x + x1v.y * x1v.y) + (x1v.z * x1v.z + x1v.w * x1v.w);
            const float xg[8] = {x0.x * g0.x, x0.y * g0.y, x0.z * g0.z, x0.w * g0.w, x1v.x * g1.x, x1v.y * g1.y, x1v.z * g1.z, x1v.w * g1.w};
            unsigned hw[4], lw[4];
#pragma unroll
            for (int p = 0; p < 4; ++p) { const unsigned h0 = f2bf(xg[2 * p]), h1 = f2bf(xg[2 * p + 1]);
                hw[p] = h0 | (h1 << 16);
                lw[p] = pk2(xg[2 * p] - __builtin_bit_cast(float, h0 << 16), xg[2 * p + 1] - __builtin_bit_cast(float, h1 << 16)); }
            const u32x4 hv = {hw[0], hw[1], hw[2], hw[3]}, lv = {lw[0], lw[1], lw[2], lw[3]};
            if constexpr (MOE_FP8) { u32x2 f8; f8.x = pk4_fp8(xg[0], xg[1], xg[2], xg[3]); f8.y = pk4_fp8(xg[4], xg[5], xg[6], xg[7]); *(u32x2*)((unsigned char*)XB + (size_t)m * D + kh * 512 + 8 * fq + 32 * s) = f8; }
            else *(u32x4*)(orow + 32 * s) = hv;
            const bf16x8 ah = __builtin_bit_cast(bf16x8, hv), al = __builtin_bit_cast(bf16x8, lv);
            const int kk = kh * 512 + 32 * s + 8 * fq;
            const bf16x8 bh0 = *(const LAS bf16x8*)(wh + fr * WRP + kk), bh1 = *(const LAS bf16x8*)(wh + (16 + fr) * WRP + kk);
            const bf16x8 bl0 = *(const LAS bf16x8*)(wl + fr * WRP + kk), bl1 = *(const LAS bf16x8*)(wl + (16 + fr) * WRP + kk);
            c0 = __builtin_amdgcn_mfma_f32_16x16x32_bf16(ah, bh0, c0, 0, 0, 0); c1 = __builtin_amdgcn_mfma_f32_16x16x32_bf16(ah, bh1, c1, 0, 0, 0);
            c0 = __builtin_amdgcn_mfma_f32_16x16x32_bf16(al, bh0, c0, 0, 0, 0); c1 = __builtin_amdgcn_mfma_f32_16x16x32_bf16(al, bh1, c1, 0, 0, 0);
            c0 = __builtin_amdgcn_mfma_f32_16x16x32_bf16(ah, bl0, c0, 0, 0, 0); c1 = __builtin_amdgcn_mfma_f32_16x16x32_bf16(ah, bl1, c1, 0, 0, 0);
        }
        s2 += __shfl_xor(s2, 16); s2 += __shfl_xor(s2, 32);
#pragma unroll
        for (int r = 0; r < 4; ++r) { LAS float* dst = lgp + (kh * 64 + rt * 16 + 4 * fq + r) * 33; dst[fr] = c0[r]; dst[16 + fr] = c1[r]; }
        if (fq == 0) lgp[(kh * 64 + rt * 16 + fr) * 33 + 32] = s2;
        __syncthreads();
        if (F.tid < 64) {
            const int row = F.tid, mm = wg * 64 + row;
            const LAS float* p0 = lgp + row * 33; const LAS float* p1 = lgp + (64 + row) * 33;
            const float rstd = 1.0f / sqrtf((p0[32] + p1[32]) * (1.0f / D) + RMS_EPS);
            float l[32];
#pragma unroll
            for (int e = 0; e < 32; ++e) l[e] = (p0[e] + p1[e]) * rstd + F.b_router[e];
            int bi[4]; float bv[4]; unsigned used = 0u;
#pragma unroll
            for (int k = 0; k < 4; ++k) { float best = -3.0e38f; int be = 0;
#pragma unroll
                for (int e = 0; e < 32; ++e) { const bool ok = !((used >> e) & 1u) && l[e] > best; best = ok ? l[e] : best; be = ok ? e : be; }
                used |= 1u << be; bi[k] = be; bv[k] = best; }
            const float e1 = __expf(bv[1] - bv[0]), e2 = __expf(bv[2] - bv[0]), e3 = __expf(bv[3] - bv[0]); const float inv = 1.0f / (1.0f + e1 + e2 + e3);
            *(int4*)(TOPI + (size_t)mm * 4) = make_int4(bi[0], bi[1], bi[2], bi[3]);
            *(f32x4*)(TOPG + (size_t)mm * 4) = (f32x4){inv, e1 * inv, e2 * inv, e3 * inv};
            RSTD[mm] = rstd;
#pragma unroll
            for (int k = 0; k < 4; ++k) atomicAdd((int*)&hist[bi[k]], 1);
        }
        __syncthreads();
        if (F.tid < 32) HIST[wg * 32 + F.tid] = hist[F.tid];
        __syncthreads();
    }
}

__device__ __forceinline__ void p7_slots(Frame& F) {
    LAS int* part = (LAS int*)F.lds;
    LAS int* cnt = part + 1024;
    LAS int* pre = cnt + 32;
    LAS int* pst = pre + 32;
    LAS int* exa = pst + 64;
    const int* TOPI = (const int*)(F.ws + WS_ROUTE + R_TOPI); const float* TOPG = (const float*)(F.ws + WS_ROUTE + R_TOPG); const int* HIST = (const int*)(F.ws + WS_ROUTE + R_HIST);
    int* POS = (int*)(F.ws + WS_ROUTE + R_POS); int* ROWTOK = (int*)(F.ws + WS_ROUTE + R_ROWTOK); float* ROWGATE = (float*)(F.ws + WS_ROUTE + R_ROWGATE); int* META = (int*)(F.ws + WS_ROUTE + R_META);
    const float* RSTD = (const float*)(F.ws + WS_ROUTE + R_RSTD); float* ROWRSTD = (float*)(F.ws + WS_ROUTE + R_ROWRSTD);
    constexpr int NWG = M / 64;
    for (int wg = F.bx; wg < NWG; wg += F.G) {
        { const int e = F.tid & 31, p = F.tid >> 5; int tot = 0, bef = 0;
          for (int q = p * 16; q < p * 16 + 16; ++q) { const int hv = HIST[q * 32 + e]; tot += hv; bef += (q < wg) ? hv : 0; }
          part[(p * 32 + e) * 2] = tot; part[(p * 32 + e) * 2 + 1] = bef; }
        __syncthreads();
        if (F.tid < 32) { int tot = 0, bef = 0; for (int p = 0; p < 16; ++p) { tot += part[(p * 32 + F.tid) * 2]; bef += part[(p * 32 + F.tid) * 2 + 1]; } cnt[F.tid] = tot; pre[F.tid] = bef; }
        __syncthreads();
        if (F.tid == 0) { int s = 0; for (int e = 0; e < 32; ++e) { pst[e] = s; s += (cnt[e] + 255) & ~255; } pst[32] = s; }
        int my_e = 0, tokn = 0, kk = 0; float my_g = 0.f;
        if (F.tid < 256) { tokn = wg * 64 + (F.tid >> 2); kk = F.tid & 3; my_e = TOPI[(size_t)tokn * 4 + kk]; my_g = TOPG[(size_t)tokn * 4 + kk]; exa[F.tid] = my_e; }
        __syncthreads();
        if (F.tid < 256) { int rank = 0; for (int a = 0; a < F.tid; ++a) rank += (exa[a] == my_e) ? 1 : 0;
            const int slot = pst[my_e] + pre[my_e] + rank;
            ROWTOK[slot] = tokn; ROWGATE[slot] = my_g; ROWRSTD[slot] = RSTD[tokn]; POS[(size_t)tokn * 4 + kk] = slot; }
        if (wg < NE) { const int e = wg, c = cnt[e], s0 = pst[e] + c, s1 = pst[e] + ((c + 255) & ~255);
            for (int s = s0 + F.tid; s < s1; s += NTHR) { ROWTOK[s] = 0; ROWGATE[s] = 0.f; ROWRSTD[s] = 0.f; } }
        if (wg == 0) { if (F.tid == 0) META[0] = pst[32] >> 8;
            for (int t = F.tid; t < NTILES_MAX; t += NTHR) { int e = 0; for (int q = 0; q < 32; ++q) e += (t * 256 >= pst[q + 1]) ? 1 : 0; META[32 + t] = e < 32 ? e : 31; } }
        __syncthreads();
    }
}

__device__ __forceinline__ void p10_combine(Frame& F) {
    const float* X1 = (const float*)(F.ws + WS_X1); const bf16_t* CB = (const bf16_t*)(F.ws + WS_CONTRIB); const int* POS = (const int*)(F.ws + WS_ROUTE + R_POS);
    const int gw = F.bx * NWAVES + F.wave, NGW = F.G * NWAVES;
    for (int m = gw; m < M; m += NGW) {
        const GAS f32x4* xr = (const GAS f32x4*)(X1 + (size_t)m * D) + F.lane;
        f32x4 v[4];
#pragma unroll
        for (int j = 0; j < 4; ++j) v[j] = xr[64 * j];
        const int4 ps = *(const int4*)(POS + (size_t)m * 4); const int pp[4] = {ps.x, ps.y, ps.z, ps.w};
#pragma unroll
        for (int k = 0; k < 4; ++k) { const GAS u32x2* cr = (const GAS u32x2*)(CB + (size_t)pp[k] * D) + F.lane;
#pragma unroll
            for (int j = 0; j < 4; ++j) { const u32x2 c = cr[64 * j]; v[j].x += bflo(c.x); v[j].y += bfhi(c.x); v[j].z += bflo(c.y); v[j].w += bfhi(c.y); } }
        float s2 = 0.f;
#pragma unroll
        for (int j = 0; j < 4; ++j) s2 += (v[j].x * v[j].x + v[j].y * v[j].y) + (v[j].z * v[j].z + v[j].w * v[j].w);
        const float rstd = 1.0f / sqrtf(wave_sum(s2) * (1.0f / D) + RMS_EPS);
        GAS f32x4* orow = (GAS f32x4*)(F.out + (size_t)m * D) + F.lane;
#pragma unroll
        for (int j = 0; j < 4; ++j) { const f32x4 g = *((const GAS f32x4*)F.g_fin + F.lane + 64 * j); orow[64 * j] = v[j] * rstd * g; }
    }
}

__global__ void __launch_bounds__(NTHR, 2) fwd_kernel(Args args) {
    extern __shared__ __attribute__((aligned(16))) unsigned char lds_raw[];
    Frame F;
    F.lds = (LAS unsigned char*)lds_raw;
    F.tid = threadIdx.x; F.lane = F.tid & 63; F.wave = __builtin_amdgcn_readfirstlane(F.tid >> 6); F.G = gridDim.x; F.bx = blockIdx.x;
    F.x = args.in[0]; F.g_mix = args.in[1]; F.w_in = args.in[2]; F.conv_w = args.in[3]; F.w_gk_up = args.in[4]; F.b_gk_up = args.in[5]; F.gla_g = args.in[6]; F.w_out = args.in[7];
    F.g_ffn = args.in[8]; F.w_router = args.in[9]; F.b_router = args.in[10]; F.w_gu = args.in[11]; F.b_gu = args.in[12]; F.w_dn = args.in[13]; F.b_dn = args.in[14]; F.g_fin = args.in[15];
    F.out = args.out; F.ws = args.ws;
    volatile LAS unsigned* MISC = (volatile LAS unsigned*)(F.lds + MISC_OFF);
    for (int u = F.tid; u < 256; u += NTHR) MISC[u] = 0u;
    __syncthreads();
    unsigned* ctl = (unsigned*)(F.ws + WS_CTL);
    XcdBarrier bar; bar.bar = ctl + CW_BAR; bar.x = 0; bar.st = nullptr;
    if (N_LAUNCHES == 1) bar = xcd_barrier_post(ctl + CW_BAR, MISC + 8);
    const int lo = args.ph_lo, hi = args.ph_hi;
#define IN(k) (lo <= (k) && (k) < hi)
#define SEAM(k) do { if (IN(k) && IN((k) + 1)) xcd_barrier(bar); } while (0)
#ifndef REPMASK
#define REPMASK 0
#endif
#define REP(k) for (int rep_ = 0; rep_ < 1 + ((REPMASK >> (k)) & 1); ++rep_)
    const int* META = (const int*)(F.ws + WS_ROUTE + R_META);

    if (IN(0)) REP(0) { p0_prep(F); } SEAM(0);
    if (IN(1)) {
        pg8::StaticOrder S; S.init(M / 256, NPROJ / 256, F.G, F.bx, 1 + ((REPMASK >> 1) & 1));
        pg8::EpiBf16 E{(bf16_t*)(F.ws + WS_PROJ), NPROJ};
        pg8::gemm_phase<pg8::EpiBf16, pg8::StaticOrder, true, false>(F.lds, F.ws + WS_XN, F.ws + WS_W1T, D * 2, D * 2, D / 64, nullptr, S, E);
    } SEAM(1);
    if (IN(2)) REP(2) { p2_gla_kv(F); } SEAM(2);
    if (IN(3)) REP(3) { p3_scan(F); } SEAM(3);
    if (IN(4)) REP(4) { p4_gla_out(F); } SEAM(4);
    if (IN(5)) {
        pg8::StaticOrder S; S.init(M / 256, D / 256, F.G, F.bx, 1 + ((REPMASK >> 5) & 1));
        pg8::EpiResF32 E{F.x, (float*)(F.ws + WS_X1), D};
        pg8::gemm_phase<pg8::EpiResF32, pg8::StaticOrder, true, false>(F.lds, F.ws + WS_Y, F.ws + WS_WOT, D * 2, D * 2, D / 64, nullptr, S, E);
    } SEAM(5);
    if (IN(6)) REP(6) { p6_router(F); } SEAM(6);
    if (IN(7)) REP(7) { p7_slots(F); } SEAM(7);
    if (IN(8)) {
        const int ntiles = META[0];
        pg8::MoeOrder S; S.so.init(ntiles, 2 * FF / 256, F.G, F.bx, 1 + ((REPMASK >> 8) & 1)); S.tile_expert = META + 32;
        pg8::EpiSwiglu E{(bf16_t*)(F.ws + WS_H), F.b_gu, META + 32, (const float*)(F.ws + WS_ROUTE + R_ROWRSTD)};
        constexpr int ES = MOE_FP8 ? 1 : 2;
        pg8::gemm_phase<pg8::EpiSwiglu, pg8::MoeOrder, true, MOE_FP8 != 0>(F.lds, F.ws + WS_XN, F.ws + WS_WGUT, D * ES, D * ES, D * ES / 128, (const int*)(F.ws + WS_ROUTE + R_ROWTOK), S, E);
    } SEAM(8);
    if (IN(9)) {
        const int ntiles = META[0];
        pg8::MoeOrder S; S.so.init(ntiles, D / 256, F.G, F.bx, 1 + ((REPMASK >> 9) & 1)); S.tile_expert = META + 32;
        pg8::EpiDown E{(bf16_t*)(F.ws + WS_CONTRIB), F.b_dn, (const float*)(F.ws + WS_ROUTE + R_ROWGATE), META + 32};
        constexpr int ES = MOE_FP8 ? 1 : 2;
        pg8::gemm_phase<pg8::EpiDown, pg8::MoeOrder, true, MOE_FP8 != 0>(F.lds, F.ws + WS_H, F.ws + WS_WDT, FF * ES, FF * ES, FF * ES / 128, nullptr, S, E);
    } SEAM(9);
    if (IN(10)) REP(10) { p10_combine(F); }
#undef IN
#undef SEAM
}

extern "C" void kernel_launch(void* const* d_in, const int* in_sizes, int n_in, void* d_out, int out_size, void* d_ws, size_t ws_size, hipStream_t stream) {
    static int grid = 0;
    if (grid == 0) {
        if (n_in != 16 || in_sizes[0] != M * D || out_size != M * D || ws_size < WS_END) { fprintf(stderr, "kernel_launch: unexpected shapes (n_in %d, in0 %d, out %d, ws %zu < %zu)\n", n_in, n_in > 0 ? in_sizes[0] : -1, out_size, ws_size, (size_t)WS_END); grid = -1; return; }
        int dev = 0, cus = 0, per_cu = 0;
        if (hipGetDevice(&dev) != hipSuccess || hipDeviceGetAttribute(&cus, hipDeviceAttributeMultiprocessorCount, dev) != hipSuccess) { grid = -1; return; }
        if (hipFuncSetAttribute((const void*)fwd_kernel, hipFuncAttributeMaxDynamicSharedMemorySize, LDS_BYTES) != hipSuccess) { fprintf(stderr, "kernel_launch: hipFuncSetAttribute failed\n"); grid = -1; return; }
        if (hipOccupancyMaxActiveBlocksPerMultiprocessor(&per_cu, (const void*)fwd_kernel, NTHR, LDS_BYTES) != hipSuccess || per_cu < 1) fprintf(stderr, "kernel_launch: occupancy query reports %d\n", per_cu);
        (void)hipGetLastError();
        grid = cus;
    }
    if (grid < 0) return;
    (void)hipMemsetAsync((char*)d_ws + WS_CTL, 0, CTL_ZERO_BYTES, stream);
    Args a{};
    for (int i = 0; i < 16; ++i) a.in[i] = (const float*)d_in[i];
    a.out = (float*)d_out; a.ws = (unsigned char*)d_ws;
    for (int li = 0; li < N_LAUNCHES; ++li) {
        if (N_LAUNCHES == 1) { a.ph_lo = 0; a.ph_hi = NPHASES; } else { a.ph_lo = li; a.ph_hi = li + 1; }
        a.li = li;
        hipLaunchKernelGGL(fwd_kernel, dim3(grid), dim3(NTHR), LDS_BYTES, stream, a);
    }
}
```

```cpp
#include <hip/hip_runtime.h>
#include <cstdio>
#include <cstdint>

#ifndef MK_N_LAUNCHES
#define MK_N_LAUNCHES 1
#endif

#ifndef MOE_FP8
#define MOE_FP8 1
#endif
#ifndef REPMASK
#define REPMASK 0
#endif
#define LAS __attribute__((address_space(3)))
#define GAS __attribute__((address_space(1)))
typedef unsigned short bf16_t;
typedef short bf16x8 __attribute__((ext_vector_type(8)));
typedef float f32x4 __attribute__((ext_vector_type(4)));
typedef float f32x2 __attribute__((ext_vector_type(2)));
typedef unsigned u32x4 __attribute__((ext_vector_type(4)));
typedef unsigned u32x2 __attribute__((ext_vector_type(2)));

constexpr int NWAVES = 8, NTHR = 512;
constexpr int NPHASES = 11;
constexpr int N_LAUNCHES = MK_N_LAUNCHES;
constexpr int BATCH = 4, SEQ = 4096, D = 1024, M = BATCH * SEQ;
constexpr int CONVW = 512, NH = 4, DK = 64, DV = 128, RANK = 16, CHUNK = 64, NCH = SEQ / CHUNK;
constexpr int DIN = 3088, NPROJ = 3072;
constexpr int C_UH = 0, C_GB = 512, C_GC = 1024, C_Q = 1536, C_K = 1792, C_V = 2048, C_G = 2560, C_GKL = 3072;
constexpr int NE = 32, TOPK = 4, FF = 1024;
constexpr int NUNITS_GLA = BATCH * NH * NCH;
constexpr int NROWS_MAX = M * TOPK + NE * 256;
constexpr int NTILES_MAX = NROWS_MAX / 256;
constexpr float RMS_EPS = 1e-5f;

constexpr size_t MiB = 1u << 20;
constexpr size_t WS_CTL = 0, CTL_ZERO_BYTES = 1 * MiB;
constexpr size_t WS_XN = 1 * MiB;
constexpr size_t WS_GKL = WS_XN + 32 * MiB;
constexpr size_t WS_W1T = WS_GKL + 1 * MiB;
constexpr size_t WS_WOT = WS_W1T + 6 * MiB;
constexpr size_t WS_WGUT = WS_WOT + 2 * MiB;
constexpr size_t WS_WDT = WS_WGUT + 128 * MiB;
constexpr size_t WS_PROJ = WS_WDT + 64 * MiB;
constexpr size_t WS_KVT = WS_PROJ + 96 * MiB;
constexpr size_t WS_DEC = WS_KVT + 32 * MiB;
constexpr size_t WS_ST = WS_DEC + 1 * MiB;
constexpr size_t WS_Y = WS_ST + 16 * MiB;
constexpr size_t WS_X1 = WS_Y + 32 * MiB;
constexpr size_t WS_ROUTE = WS_X1 + 64 * MiB;
constexpr size_t WS_H = WS_ROUTE + 2 * MiB;
constexpr size_t WS_CONTRIB = WS_H + 144 * MiB;
constexpr size_t WS_END = WS_CONTRIB + 144 * MiB;
constexpr size_t R_TOPI = 0;
constexpr size_t R_TOPG = 256 * 1024;
constexpr size_t R_POS = 512 * 1024;
constexpr size_t R_ROWTOK = 768 * 1024;
constexpr size_t R_ROWGATE = 1088 * 1024;
constexpr size_t R_HIST = 1408 * 1024;
constexpr size_t R_META = 1472 * 1024;
constexpr size_t R_RSTD = 1536 * 1024;
constexpr size_t R_ROWRSTD = 1664 * 1024;
constexpr int CW_BAR = 4096;

constexpr int LDS_BYTES = 160 * 1024 - 2048;
constexpr int MISC_OFF = LDS_BYTES - 1024;
constexpr int TE_OFF = 131072;

__device__ __forceinline__ unsigned f2bf(float f) { unsigned u = __builtin_bit_cast(unsigned, f); return (u + 0x7fffu + ((u >> 16) & 1u)) >> 16; }
__device__ __forceinline__ unsigned pk2(float lo, float hi) { typedef __bf16 bf2_ __attribute__((ext_vector_type(2))); const f32x2 v = {lo, hi}; return __builtin_bit_cast(unsigned, __builtin_convertvector(v, bf2_)); }
__device__ __forceinline__ float bf2f(unsigned short b) { return __builtin_bit_cast(float, (unsigned)b << 16); }
__device__ __forceinline__ float bflo(unsigned w) { return __builtin_bit_cast(float, w << 16); }
__device__ __forceinline__ float bfhi(unsigned w) { return __builtin_bit_cast(float, w & 0xffff0000u); }
__device__ __forceinline__ unsigned cvt_pk_bf16(float lo, float hi) { unsigned r; asm volatile("v_cvt_pk_bf16_f32 %0, %1, %2" : "=v"(r) : "v"(lo), "v"(hi)); return r; }
__device__ __forceinline__ unsigned pk4_fp8(float a, float b, float c, float d) { int w = 0; w = __builtin_amdgcn_cvt_pk_fp8_f32(a, b, w, false); w = __builtin_amdgcn_cvt_pk_fp8_f32(c, d, w, true); return (unsigned)w; }
__device__ __forceinline__ float wave_sum(float v) {
#pragma unroll
    for (int o = 1; o < 64; o <<= 1) v += __shfl_xor(v, o);
    return v;
}
__device__ __forceinline__ float sigmoidf_(float x) { return __builtin_amdgcn_rcpf(1.0f + __expf(-x)); }
__device__ __forceinline__ float log_sigmoidf_(float x) { return fminf(x, 0.f) - __logf(1.0f + __expf(-fabsf(x))); }
#define DPPF_(x, ctrl, rm) __builtin_bit_cast(float, __builtin_amdgcn_update_dpp(0, __builtin_bit_cast(int, (x)), (ctrl), (rm), 0xf, false))
__device__ __forceinline__ float wave_incl_scan(float v) {
    v += DPPF_(v, 0x111, 0xf); v += DPPF_(v, 0x112, 0xf); v += DPPF_(v, 0x114, 0xf); v += DPPF_(v, 0x118, 0xf);
    v += DPPF_(v, 0x142, 0xa); v += DPPF_(v, 0x143, 0xc);
    return v;
}
__host__ __device__ __forceinline__ size_t tiled_off(int row, int cbyte, int nt) { return ((size_t)((row >> 8) * nt + (cbyte >> 7)) << 15) + (size_t)(((row & 255) << 7) + (cbyte & 127)); }
#define LDS_WAIT() asm volatile("s_waitcnt lgkmcnt(0)" ::: "memory")
#define VM_WAIT() asm volatile("s_waitcnt vmcnt(0)" ::: "memory")

#define XB_TMO      128
#define XB_XCNT(j)  (256  + 64 * (j))
#define XB_XSUB(j)  (1280 + 64 * (j))
#define XB_XGEN(j)  (2304 + 64 * (j))
#define XB_TOP      3328
#define XB_TOPGEN   3392
#define XCD_BAR_WORDS 3456
#define XB_SPIN_CAP (1u << 18)
__device__ __forceinline__ unsigned xb_ld(unsigned* p)              { return __hip_atomic_load(p, __ATOMIC_RELAXED, __HIP_MEMORY_SCOPE_AGENT); }
__device__ __forceinline__ unsigned xb_add(unsigned* p, unsigned v) { return __hip_atomic_fetch_add(p, v, __ATOMIC_RELAXED, __HIP_MEMORY_SCOPE_AGENT); }
__device__ __forceinline__ unsigned xb_xcc_id() { return (unsigned)__builtin_amdgcn_s_getreg((3 << 11) | 20) & 0xFu; }
#define XB_SPIN(cond, bar) do { unsigned _sp = 0; while (cond) { __builtin_amdgcn_s_sleep(1); \
    if ((++_sp & 255u) == 0u) { if (xb_ld(&(bar)[XB_TMO])) break; if (_sp > XB_SPIN_CAP) { atomicAdd(&(bar)[XB_TMO], 1u); break; } } } } while (0)
struct XcdBarrier { unsigned* bar; unsigned x; volatile LAS unsigned* st; };
__device__ __forceinline__ XcdBarrier xcd_barrier_post(unsigned* bar, volatile LAS unsigned* st) {
    XcdBarrier b; b.bar = bar; b.x = xb_xcc_id(); b.st = st;
    if (threadIdx.x == 0) (void)xb_add(&bar[XB_XCNT(b.x)], 1u);
    return b;
}
__device__ __forceinline__ void xcd_barrier_complete(unsigned* bar, unsigned x, unsigned& nloc, unsigned& nx) {
    const unsigned G = gridDim.x * gridDim.y * gridDim.z;
    unsigned sum, cnt, mine, sp = 0u;
    for (;;) {
        sum = 0u; cnt = 0u; mine = 0u;
#pragma unroll
        for (unsigned j = 0; j < 16; ++j) { const unsigned c = xb_ld(&bar[XB_XCNT(j)]); sum += c; cnt += (c > 0u) ? 1u : 0u; mine = (j == x) ? c : mine; }
        if (sum == G) break;
        __builtin_amdgcn_s_sleep(1);
        if ((++sp & 255u) == 0u) { if (xb_ld(&bar[XB_TMO])) break; if (sp > XB_SPIN_CAP) { atomicAdd(&bar[XB_TMO], 1u); break; } }
    }
    nloc = mine > 0u ? mine : 1u; nx = cnt > 0u ? cnt : 1u;
}
__device__ __forceinline__ void xcd_barrier(const XcdBarrier& b) {
    asm volatile("s_waitcnt vmcnt(0)" ::: "memory");
    __syncthreads();
    if (threadIdx.x == 0) {
        unsigned* bar = b.bar;
        __builtin_amdgcn_s_waitcnt(0);
        unsigned nloc = b.st[0], nx = b.st[1];
        if (nloc == 0u) { xcd_barrier_complete(bar, b.x, nloc, nx); b.st[0] = nloc; b.st[1] = nx; }
        const unsigned old = xb_add(&bar[XB_XSUB(b.x)], 1u);
        const unsigned gen = old / nloc;
        if (old + 1u == (gen + 1u) * nloc) {
            __builtin_amdgcn_fence(__ATOMIC_RELEASE, "agent");
            asm volatile("s_waitcnt vmcnt(0)" ::: "memory");
            const unsigned og = xb_add(&bar[XB_TOP], 1u);
            const unsigned tg = og / nx;
            if (og + 1u == (tg + 1u) * nx) xb_add(&bar[XB_TOPGEN], 1u);
            else XB_SPIN(xb_ld(&bar[XB_TOPGEN]) == tg, bar);
            __builtin_amdgcn_fence(__ATOMIC_ACQUIRE, "agent");
            xb_add(&bar[XB_XGEN(b.x)], 1u);
            asm volatile("s_waitcnt vmcnt(0)" ::: "memory");
        } else {
            XB_SPIN(xb_ld(&bar[XB_XGEN(b.x)]) == gen, bar);
            __builtin_amdgcn_fence(__ATOMIC_ACQUIRE, "agent");
            asm volatile("s_waitcnt vmcnt(0)" ::: "memory");
        }
    }
    __syncthreads();
}

namespace pg8 {
constexpr int BM = 256, BK = 64, HALF = 128, HTB = HALF * BK * 2, STAGE_BYTES = 8 * HTB, NXCD = 8, WGM = 8;
__host__ __device__ __forceinline__ int lds_byte(int r, int c) { const int st = (r >> 4) * 2 + (c >> 5), rr = r & 15, cc = c & 31, ob = rr * 64 + cc * 2; return st * 1024 + (ob ^ (((ob >> 9) & 1) << 5)); }
__host__ __device__ __forceinline__ void stage_rc(int b, int& R, int& C) { const int st = b / 1024, sb = b % 1024, swz = sb ^ (((sb >> 9) & 1) << 5); R = (st >> 1) * 16 + swz / 64; C = (st & 1) * 32 + (swz % 64) / 2; }
__host__ __device__ __forceinline__ int perm32(int rho) { const int n = rho >> 4, i = rho & 15; return 8 * (i >> 2) + 4 * n + (i & 3); }
struct Unit { int pm, pn, pb, e, i; };
struct StaticOrder {
    int nM, nN, nwg, G, c, reps;
    __host__ __device__ void init(int nM_, int nN_, int G_, int c_, int reps_ = 1) { nM = nM_; nN = nN_; nwg = nM * nN; G = G_; c = c_; reps = reps_; }
    __host__ __device__ bool next(int i, Unit& u) const {
        const long L = (long)i * G + c; if (L >= (long)nwg * reps) return false;
        int wgid = (int)(L % nwg); { const int q = nwg / NXCD, r = nwg % NXCD, xcd = wgid % NXCD, off = wgid / NXCD; wgid = (xcd < r ? xcd * (q + 1) : r * (q + 1) + (xcd - r) * q) + off; }
        const int nig = WGM * nN, gid = wgid / nig, fm = gid * WGM, gsz = (nM - fm) < WGM ? (nM - fm) : WGM;
        u.pm = fm + ((wgid % nig) % gsz); u.pn = (wgid % nig) / gsz; u.pb = u.pn; u.e = 0; u.i = i; return true;
    }
};
struct MoeOrder {
    StaticOrder so; const LAS int* tile_expert;
    __device__ bool next(int i, Unit& u) const { if (!so.next(i, u)) return false; u.e = __builtin_amdgcn_readfirstlane(tile_expert[u.pm]); u.pb = u.e * so.nN + u.pn; return true; }
};
struct TabOrder {
    const LAS int* tab; int n; int dup;
    __device__ bool next(int i, Unit& u) const { if (i >= (n << dup)) return false; const LAS int* p = tab + 4 * (i >> dup);
        u.pm = __builtin_amdgcn_readfirstlane(p[0]); u.pn = __builtin_amdgcn_readfirstlane(p[1]); u.pb = __builtin_amdgcn_readfirstlane(p[2]); u.e = __builtin_amdgcn_readfirstlane(p[3]); u.i = i >> dup; return true; }
};
constexpr int UCAP = 10;
typedef int i32x8 __attribute__((ext_vector_type(8)));
typedef int i32x4 __attribute__((ext_vector_type(4)));
template <class Epi, class Sched, bool ALIGN_EPI, bool FP8, int NPASS = 1>
__device__ __forceinline__ void gemm_phase(LAS unsigned char* lds, const void* A, const void* Bt, const int ldA, const int nt, const LAS unsigned short* rowidx, const Sched& S, const Epi& E) {
    const int tid = threadIdx.x, wid = __builtin_amdgcn_readfirstlane(tid >> 6), lane = tid & 63, wr = wid >> 2, wc = wid & 3, fr = lane & 15, fq = lane >> 4;
    unsigned voffB[2];
#pragma unroll
    for (int i = 0; i < 2; ++i) { int R, C; stage_rc(tid * 16 + i * 8192, R, C); const int Rb = Epi::PERM ? ((R & ~31) + perm32(R & 31)) : R; voffB[i] = (unsigned)(Rb * 128 + C * 2); }
    const size_t kstep = 32768, kstepA = rowidx ? (size_t)128 : (size_t)32768;
    const size_t hstep = 16384;
    const size_t tstep = (size_t)nt * 32768;
    const unsigned ldsw = (unsigned)wid * 1024u;
    const int aoff = lds_byte(wr * 64 + fr, fq * 8), boff = lds_byte(wc * 32 + fr, fq * 8);
#define PG8_SA(b, h) (((b) * 2 + (h)) * HTB)
#define PG8_SB(b, h) ((4 + (b) * 2 + (h)) * HTB)
#define PG8_STAGE(bufoff, gbase, voff) do { _Pragma("unroll") for (int _i = 0; _i < 2; ++_i) \
        __builtin_amdgcn_global_load_lds((const unsigned*)((const char*)(gbase) + (voff)[_i]), (LAS unsigned*)(lds + (bufoff) + ldsw + _i * 8192), 16, 0, 0); } while (0)
#define PG8_LDA(dst, b, h) do { _Pragma("unroll") for (int m = 0; m < 4; ++m) _Pragma("unroll") for (int k = 0; k < 2; ++k) dst[m][k] = *(const LAS bf16x8*)(lds + PG8_SA(b, h) + aoff + m * 2048 + k * 1024); } while (0)
#define PG8_LDB(dst, b, h) do { _Pragma("unroll") for (int n = 0; n < 2; ++n) _Pragma("unroll") for (int k = 0; k < 2; ++k) dst[n][k] = *(const LAS bf16x8*)(lds + PG8_SB(b, h) + boff + n * 2048 + k * 1024); } while (0)
#define PG8_F8(x) __builtin_shufflevector(__builtin_bit_cast(i32x4, (x)[0]), __builtin_bit_cast(i32x4, (x)[1]), 0, 1, 2, 3, 4, 5, 6, 7)
#define PG8_MMA(ai, bj, At, Bt_) do { __builtin_amdgcn_s_setprio(1); _Pragma("unroll") for (int m = 0; m < 4; ++m) _Pragma("unroll") for (int n = 0; n < 2; ++n) { \
        if constexpr (FP8) { const i32x8 _a = PG8_F8(Bt_[n]), _b = PG8_F8(At[m]); \
            asm volatile("v_mfma_scale_f32_16x16x128_f8f6f4 %0, %1, %2, %0, %3, %4 op_sel_hi:[0,0,0]" : "+v"(acc[ai][bj][m][n]) : "v"(_a), "v"(_b), "v"(sclW), "v"(sclX)); } \
        else { _Pragma("unroll") for (int k = 0; k < 2; ++k) acc[ai][bj][m][n] = __builtin_amdgcn_mfma_f32_16x16x32_bf16(Bt_[n][k], At[m][k], acc[ai][bj][m][n], 0, 0, 0); } } \
        __builtin_amdgcn_s_setprio(0); } while (0)
#define PG8_WAIT_V(n) asm volatile("s_waitcnt vmcnt(" #n ")" ::: "memory")
#define PG8_WAIT_L(n) asm volatile("s_waitcnt lgkmcnt(" #n ")" ::: "memory")
#define PG8_WAIT_VR(rx) do { if (rx) { if constexpr (Epi::NST == 16) PG8_WAIT_V(24); else if constexpr (Epi::NST == 8) PG8_WAIT_V(16); else PG8_WAIT_V(8); } else PG8_WAIT_V(8); } while (0)
#define PG8_BAR __builtin_amdgcn_s_barrier()
#define PG8_SCHED __builtin_amdgcn_sched_barrier(0)
#define PG8_AOFF(dst, u, uo) do { _Pragma("unroll") for (int _h = 0; _h < 2; ++_h) _Pragma("unroll") for (int _i = 0; _i < 2; ++_i) { int _R, _C; stage_rc(tid * 16 + _i * 8192, _R, _C); \
        dst[_h][_i] = rowidx ? (unsigned)((int)rowidx[(u).i * BM + _h * HALF + _R] * ldA + _C * 2) : (unsigned)(((u).pm * nt << 15) + ((_h * HALF + _R) << 7) + _C * 2); } } while (0)
    Unit cur, nxt; int ui = 0;
    if (!S.next(0, cur)) return;
    f32x4 acc[2][2][4][2];
#pragma unroll
    for (int a = 0; a < 2; ++a)
#pragma unroll
        for (int b = 0; b < 2; ++b)
#pragma unroll
            for (int m = 0; m < 4; ++m)
#pragma unroll
                for (int n = 0; n < 2; ++n) acc[a][b][m][n] = (f32x4){0.f, 0.f, 0.f, 0.f};
    bf16x8 At[4][2], B0[2][2], B1[2][2];
    int sclW = 0x7A7A7A7A, sclX = 0x7F7F7F7F;
    asm volatile("" : "+v"(sclW), "+v"(sclX));
    unsigned ca[2][2], na[2][2];
    PG8_AOFF(ca, cur, 0);
    const char* cA = (const char*)A; const char* cB = (const char*)Bt + (size_t)cur.pb * tstep;
    PG8_STAGE(PG8_SB(0, 0), cB, voffB); PG8_STAGE(PG8_SB(0, 1), cB + hstep, voffB); PG8_STAGE(PG8_SA(0, 0), cA, ca[0]); PG8_STAGE(PG8_SA(0, 1), cA, ca[1]);
    if (wr == 1) PG8_BAR;
    PG8_WAIT_V(2); PG8_BAR;
    PG8_STAGE(PG8_SB(1, 0), cB + kstep, voffB); PG8_STAGE(PG8_SA(1, 0), cA + kstepA, ca[0]); PG8_STAGE(PG8_SB(1, 1), cB + hstep + kstep, voffB);
    PG8_WAIT_V(6); PG8_BAR;
    for (;;) {
        const bool has_next = S.next(ui + 1, nxt);
        if (has_next) { PG8_AOFF(na, nxt, ui + 1); }
        else {
#pragma unroll
            for (int h = 0; h < 2; ++h)
#pragma unroll
                for (int i = 0; i < 2; ++i) na[h][i] = ca[h][i];
        }
        const char* nB = has_next ? (const char*)Bt + (size_t)nxt.pb * tstep : cB;
#pragma unroll 1
        for (int pass = 0; pass < NPASS; ++pass)
#pragma unroll 1
        for (int t = 0; t < nt; t += 2) {
            const bool lastp = (pass == NPASS - 1);
            const bool last = (t == nt - 2);
            const char* a1 = cA + (size_t)(t + 1) * kstepA;
            const char* a2 = last ? cA : cA + (size_t)(t + 2) * kstepA; const char* b2 = last ? (lastp ? nB : cB) : cB + (size_t)(t + 2) * kstep;
            const char* a3 = a2 + kstepA; const char* b3 = b2 + kstep;
            unsigned o2[2][2];
#pragma unroll
            for (int h = 0; h < 2; ++h)
#pragma unroll
                for (int i = 0; i < 2; ++i) o2[h][i] = (last && lastp) ? na[h][i] : ca[h][i];
            const bool relax = (Epi::NST > 0) && (t == 0) && (ui > 0) && (pass == 0);
            PG8_LDB(B0, 0, 0); PG8_LDB(B1, 0, 1); PG8_SCHED; PG8_LDA(At, 0, 0); PG8_STAGE(PG8_SA(1, 1), a1, ca[1]);
            PG8_WAIT_VR(relax); PG8_WAIT_L(0); PG8_BAR; PG8_MMA(0, 0, At, B0); PG8_MMA(0, 1, At, B1); PG8_BAR; PG8_SCHED;
            PG8_LDA(At, 0, 1); PG8_STAGE(PG8_SB(0, 0), b2, voffB); PG8_STAGE(PG8_SB(0, 1), b2 + hstep, voffB); PG8_STAGE(PG8_SA(0, 0), a2, o2[0]);
            PG8_WAIT_VR(relax); PG8_WAIT_L(0); PG8_BAR; PG8_MMA(1, 0, At, B0); PG8_MMA(1, 1, At, B1); PG8_BAR; PG8_SCHED;
            PG8_LDB(B0, 1, 0); PG8_LDB(B1, 1, 1); PG8_SCHED; PG8_LDA(At, 1, 0); PG8_STAGE(PG8_SA(0, 1), a2, o2[1]);
            PG8_WAIT_V(8); PG8_WAIT_L(0); PG8_BAR; PG8_MMA(0, 0, At, B0); PG8_MMA(0, 1, At, B1); PG8_BAR; PG8_SCHED;
            PG8_LDA(At, 1, 1); PG8_STAGE(PG8_SB(1, 0), b3, voffB); PG8_STAGE(PG8_SB(1, 1), b3 + hstep, voffB); PG8_STAGE(PG8_SA(1, 0), a3, o2[0]);
            PG8_WAIT_V(8); PG8_WAIT_L(0); PG8_BAR; PG8_MMA(1, 0, At, B0); PG8_MMA(1, 1, At, B1); PG8_BAR; PG8_SCHED;
        }
        if constexpr (ALIGN_EPI) { if (wr == 0) PG8_BAR; }
        if constexpr (FP8) asm volatile("s_nop 15\n\ts_nop 15" ::: "memory");
        if constexpr (NPASS > 1) {
#pragma unroll
            for (int a = 0; a < 2; ++a)
#pragma unroll
                for (int b = 0; b < 2; ++b)
#pragma unroll
                    for (int m = 0; m < 4; ++m)
#pragma unroll
                        for (int n = 0; n < 2; ++n) acc[a][b][m][n] *= (1.0f / NPASS);
        }
        E(acc, cur, wr, wc, fr, fq);
        if constexpr (((REPMASK >> 13) & 1) != 0) { asm volatile("" ::: "memory"); E(acc, cur, wr, wc, fr, fq); }
        if (!has_next) break;
#pragma unroll
        for (int a = 0; a < 2; ++a)
#pragma unroll
            for (int b = 0; b < 2; ++b)
#pragma unroll
                for (int m = 0; m < 4; ++m)
#pragma unroll
                    for (int n = 0; n < 2; ++n) acc[a][b][m][n] = (f32x4){0.f, 0.f, 0.f, 0.f};
        cur = nxt; cB = nB; ++ui;
#pragma unroll
        for (int h = 0; h < 2; ++h)
#pragma unroll
            for (int i = 0; i < 2; ++i) ca[h][i] = na[h][i];
        if constexpr (ALIGN_EPI) { if (wr == 1) PG8_BAR; }
    }
    PG8_WAIT_V(0);
    if constexpr (!ALIGN_EPI) { if (wr == 0) PG8_BAR; }
    PG8_BAR;
#undef PG8_SA
#undef PG8_SB
#undef PG8_STAGE
#undef PG8_LDA
#undef PG8_LDB
#undef PG8_MMA
#undef PG8_F8
#undef PG8_WAIT_V
#undef PG8_WAIT_L
#undef PG8_WAIT_VR
#undef PG8_BAR
#undef PG8_SCHED
#undef PG8_AOFF
}

struct EpiBf16 {
    static constexpr bool PERM = true; static constexpr int NST = 16;
    bf16_t* O; int ldc;
    __device__ __forceinline__ void operator()(const f32x4 (&acc)[2][2][4][2], const Unit& u, int wr, int wc, int fr, int fq) const {
        const int row0 = u.pm * BM + wr * 64 + fr, col0 = u.pn * BM + wc * 32 + 8 * fq;
#pragma unroll
        for (int ai = 0; ai < 2; ++ai)
#pragma unroll
            for (int m = 0; m < 4; ++m) { bf16_t* rowp = O + (size_t)(row0 + ai * HALF + m * 16) * ldc + col0;
#pragma unroll
                for (int bj = 0; bj < 2; ++bj) { const f32x4 v0 = acc[ai][bj][m][0], v1 = acc[ai][bj][m][1];
                    u32x4 w; w.x = cvt_pk_bf16(v0[0], v0[1]); w.y = cvt_pk_bf16(v0[2], v0[3]); w.z = cvt_pk_bf16(v1[0], v1[1]); w.w = cvt_pk_bf16(v1[2], v1[3]);
                    *(u32x4*)(rowp + bj * HALF) = w; } }
    }
};
struct EpiResF32 {
    static constexpr bool PERM = false; static constexpr int NST = 0;
    const float* base; float* C; int ldc;
    __device__ __forceinline__ void operator()(const f32x4 (&acc)[2][2][4][2], const Unit& u, int wr, int wc, int fr, int fq) const {
        const int row0 = u.pm * BM + wr * 64 + fr, col0 = u.pn * BM + wc * 32 + 4 * fq;
#pragma unroll
        for (int ai = 0; ai < 2; ++ai)
#pragma unroll
            for (int m = 0; m < 4; ++m) { const size_t off = (size_t)(row0 + ai * HALF + m * 16) * ldc + col0;
#pragma unroll
                for (int bj = 0; bj < 2; ++bj)
#pragma unroll
                    for (int n = 0; n < 2; ++n) { const f32x4 bs = *(const f32x4*)(base + off + bj * HALF + n * 16); *(f32x4*)(C + off + bj * HALF + n * 16) = bs + acc[ai][bj][m][n]; }
                asm volatile("" ::: "memory"); }
    }
};
struct EpiSwiglu {
    static constexpr bool PERM = true; static constexpr int NST = 8;
    bf16_t* Hb; const LAS float* bias; const LAS float* rstd;
    __device__ __forceinline__ void operator()(const f32x4 (&acc)[2][2][4][2], const Unit& u, int wr, int wc, int fr, int fq) const {
        const int row0 = u.pm * BM + wr * 64 + fr, col0 = u.pn * HALF + wc * 32 + 8 * fq;
        const LAS float* bg = bias + u.i * 256 + wc * 32 + 8 * fq; const LAS float* bu = bg + 128;
        const f32x4 g0 = *(const LAS f32x4*)bg, g1 = *(const LAS f32x4*)(bg + 4), u0 = *(const LAS f32x4*)bu, u1 = *(const LAS f32x4*)(bu + 4);
        float rsv[2][4];
#pragma unroll
        for (int ai = 0; ai < 2; ++ai)
#pragma unroll
            for (int m = 0; m < 4; ++m) rsv[ai][m] = rstd[u.i * 256 + wr * 64 + fr + ai * HALF + m * 16];
#pragma unroll
        for (int ai = 0; ai < 2; ++ai)
#pragma unroll
            for (int m = 0; m < 4; ++m) {
                float r[8]; const float rs = rsv[ai][m];
#pragma unroll
                for (int n = 0; n < 2; ++n)
#pragma unroll
                    for (int j = 0; j < 4; ++j) {
                        float gt = acc[ai][0][m][n][j] * rs + (n ? g1[j] : g0[j]); float up = acc[ai][1][m][n][j] * rs + (n ? u1[j] : u0[j]);
                        gt = fminf(gt, 7.0f); up = fminf(fmaxf(up, -7.0f), 7.0f);
                        const float glu = gt * __builtin_amdgcn_rcpf(1.0f + __expf(-1.702f * gt));
                        r[n * 4 + j] = (up + 1.0f) * glu; }
                if constexpr (MOE_FP8) { u32x2 w; w.x = pk4_fp8(r[0], r[1], r[2], r[3]); w.y = pk4_fp8(r[4], r[5], r[6], r[7]);
                    *(u32x2*)((unsigned char*)Hb + tiled_off(row0 + ai * HALF + m * 16, col0, FF / 128)) = w; }
                else { u32x4 w; w.x = cvt_pk_bf16(r[0], r[1]); w.y = cvt_pk_bf16(r[2], r[3]); w.z = cvt_pk_bf16(r[4], r[5]); w.w = cvt_pk_bf16(r[6], r[7]);
                    *(u32x4*)((unsigned char*)Hb + tiled_off(row0 + ai * HALF + m * 16, 2 * col0, FF / 64)) = w; } }
    }
};
struct EpiDown {
    static constexpr bool PERM = true; static constexpr int NST = 16;
    bf16_t* Cb; const LAS float* bias; const LAS float* gate;
    __device__ __forceinline__ void operator()(const f32x4 (&acc)[2][2][4][2], const Unit& u, int wr, int wc, int fr, int fq) const {
        const int row0 = u.pm * BM + wr * 64 + fr, col0 = u.pn * BM + wc * 32 + 8 * fq;
        f32x4 bv[2][2]; float gtv[2][4];
#pragma unroll
        for (int bj = 0; bj < 2; ++bj)
#pragma unroll
            for (int n = 0; n < 2; ++n) bv[bj][n] = *(const LAS f32x4*)(bias + u.i * 256 + wc * 32 + 8 * fq + bj * HALF + 4 * n);
#pragma unroll
        for (int ai = 0; ai < 2; ++ai)
#pragma unroll
            for (int m = 0; m < 4; ++m) gtv[ai][m] = gate[u.i * 256 + wr * 64 + fr + ai * HALF + m * 16];
#pragma unroll
        for (int ai = 0; ai < 2; ++ai)
#pragma unroll
            for (int m = 0; m < 4; ++m) { const int row = row0 + ai * HALF + m * 16; const float gt = gtv[ai][m]; bf16_t* rowp = Cb + (size_t)row * D + col0;
#pragma unroll
                for (int bj = 0; bj < 2; ++bj) { const f32x4 v0 = (acc[ai][bj][m][0] + bv[bj][0]) * gt, v1 = (acc[ai][bj][m][1] + bv[bj][1]) * gt;
                    u32x4 w; w.x = cvt_pk_bf16(v0[0], v0[1]); w.y = cvt_pk_bf16(v0[2], v0[3]); w.z = cvt_pk_bf16(v1[0], v1[1]); w.w = cvt_pk_bf16(v1[2], v1[3]);
                    *(u32x4*)(rowp + bj * HALF) = w; } }
    }
};
}

struct Args { const float* in[16]; float* out; unsigned char* ws; int ph_lo, ph_hi, li, pad; };
struct Frame {
    LAS unsigned char* lds; int tid, lane, wave, G, bx;
    const float *x, *g_mix, *w_in, *conv_w, *w_gk_up, *b_gk_up, *gla_g, *w_out, *g_ffn, *w_router, *b_router, *w_gu, *b_gu, *w_dn, *b_dn, *g_fin;
    float* out; unsigned char* ws;
};

constexpr int TP = 68;
template <bool F8>
__device__ __forceinline__ void p0_tile(const float* W, int ldn, int K, int k0, int n0, void* WT, int drow0, LAS float* scr, int lane, float scale) {
    const float* src = W + (size_t)(k0 + (lane >> 4)) * ldn + n0 + 4 * (lane & 15);
    f32x4 v[16];
#pragma unroll
    for (int i = 0; i < 16; ++i) v[i] = *(const GAS f32x4*)(src + (size_t)(4 * i) * ldn);
#pragma unroll
    for (int i = 0; i < 16; ++i) *(LAS f32x4*)(scr + (4 * i + (lane >> 4)) * TP + 4 * (lane & 15)) = v[i];
    LDS_WAIT(); asm volatile("" ::: "memory");
    const LAS float* col = scr + lane;
    if constexpr (F8) {
        unsigned char* dst = (unsigned char*)WT + tiled_off(drow0 + lane, k0, K / 128);
#pragma unroll
        for (int q = 0; q < 4; ++q) { u32x4 o; unsigned w[4];
#pragma unroll
            for (int p = 0; p < 4; ++p) { const int kk = 16 * q + 4 * p; w[p] = pk4_fp8(col[kk * TP] * scale, col[(kk + 1) * TP] * scale, col[(kk + 2) * TP] * scale, col[(kk + 3) * TP] * scale); }
            o.x = w[0]; o.y = w[1]; o.z = w[2]; o.w = w[3]; *(GAS u32x4*)(dst + 16 * q) = o; }
    } else {
        bf16_t* dst = (bf16_t*)((unsigned char*)WT + tiled_off(drow0 + lane, 2 * k0, K / 64));
#pragma unroll
        for (int q = 0; q < 8; ++q) { u32x4 o; unsigned w[4];
#pragma unroll
            for (int p = 0; p < 4; ++p) { const int kk = 8 * q + 2 * p; w[p] = pk2(col[kk * TP], col[(kk + 1) * TP]); }
            o.x = w[0]; o.y = w[1]; o.z = w[2]; o.w = w[3]; *(GAS u32x4*)(dst + 8 * q) = o; }
    }
    LDS_WAIT(); asm volatile("" ::: "memory");
}
__device__ __forceinline__ void p0_prep(Frame& F) {
    LAS float* w16t = (LAS float*)F.lds;
    for (int i = F.tid; i < 1024 * 16; i += NTHR) { const int k = i >> 4, r = i & 15; w16t[r * 1024 + k] = F.w_in[(size_t)k * DIN + C_GKL + r]; }
    __syncthreads();
    const int gw = F.bx * NWAVES + F.wave, NGW = F.G * NWAVES;
    bf16_t* XN = (bf16_t*)(F.ws + WS_XN); float* GKL = (float*)(F.ws + WS_GKL);
    for (int rep_a = 0; rep_a < 1 + ((REPMASK >> 11) & 1); ++rep_a)
    for (int m = gw; m < M; m += NGW) {
        const GAS f32x4* xr = (const GAS f32x4*)(F.x + (size_t)m * D) + F.lane;
        f32x4 v[4]; float s2 = 0.f;
#pragma unroll
        for (int j = 0; j < 4; ++j) { v[j] = xr[64 * j]; s2 += (v[j].x * v[j].x + v[j].y * v[j].y) + (v[j].z * v[j].z + v[j].w * v[j].w); }
        const float rstd = 1.0f / sqrtf(wave_sum(s2) * (1.0f / D) + RMS_EPS);
#pragma unroll
        for (int j = 0; j < 4; ++j) { const f32x4 g = *((const GAS f32x4*)F.g_mix + F.lane + 64 * j); v[j] = v[j] * rstd * g;
            u32x2 w; w.x = pk2(v[j].x, v[j].y); w.y = pk2(v[j].z, v[j].w); *(GAS u32x2*)((unsigned char*)XN + tiled_off(m, 8 * F.lane + 512 * j, D / 64)) = w; }
        float acc[16];
#pragma unroll
        for (int r = 0; r < 16; ++r) { float a = 0.f;
#pragma unroll
            for (int j = 0; j < 4; ++j) { const f32x4 w = *(const LAS f32x4*)(w16t + r * 1024 + 4 * F.lane + 256 * j); a += (v[j].x * w.x + v[j].y * w.y) + (v[j].z * w.z + v[j].w * w.w); }
            acc[r] = a; if ((r & 3) == 3) asm volatile("" ::: "memory"); }
        float a8[8], a4[4], a2[2], a1;
        { const bool hi = (F.lane & 32) != 0;
#pragma unroll
          for (int i = 0; i < 8; ++i) { const float send = hi ? acc[i] : acc[i + 8]; const float keep = hi ? acc[i + 8] : acc[i]; a8[i] = keep + __shfl_xor(send, 32); } }
        { const bool hi = (F.lane & 16) != 0;
#pragma unroll
          for (int i = 0; i < 4; ++i) { const float send = hi ? a8[i] : a8[i + 4]; const float keep = hi ? a8[i + 4] : a8[i]; a4[i] = keep + __shfl_xor(send, 16); } }
        { const bool hi = (F.lane & 8) != 0;
#pragma unroll
          for (int i = 0; i < 2; ++i) { const float send = hi ? a4[i] : a4[i + 2]; const float keep = hi ? a4[i + 2] : a4[i]; a2[i] = keep + __shfl_xor(send, 8); } }
        { const bool hi = (F.lane & 4) != 0; const float send = hi ? a2[0] : a2[1]; const float keep = hi ? a2[1] : a2[0]; a1 = keep + __shfl_xor(send, 4); }
        a1 += __shfl_xor(a1, 2); a1 += __shfl_xor(a1, 1);
        if ((F.lane & 3) == 0) GKL[(size_t)m * 16 + (F.lane >> 2)] = a1;
    }
    __syncthreads();
    LAS float* scr = (LAS float*)(F.lds + F.wave * (64 * TP * 4));
    constexpr int I_1 = (D / 64) * (NPROJ / 64), I_O = (D / 64) * (D / 64), I_GU = (D / 64) * (2 * FF / 64), I_DN = (FF / 64) * (D / 64);
    constexpr int NITEMS = I_1 + I_O + NE * (I_GU + I_DN);
    bf16_t* W1T = (bf16_t*)(F.ws + WS_W1T); bf16_t* WOT = (bf16_t*)(F.ws + WS_WOT); unsigned char* WGUT = F.ws + WS_WGUT; unsigned char* WDT = F.ws + WS_WDT;
    constexpr int ES = MOE_FP8 ? 1 : 2;
    for (int rep_b = 0; rep_b < 1 + ((REPMASK >> 12) & 1); ++rep_b)
    for (int it = gw; it < NITEMS; it += NGW) {
        int r = it;
        if (r < I_1) { const int nblk = NPROJ / 64, kb = r / nblk, nb = r % nblk; p0_tile<false>(F.w_in, DIN, D, 64 * kb, 64 * nb, W1T, 64 * nb, scr, F.lane, 1.0f); continue; } r -= I_1;
        if (r < I_O) { const int nblk = D / 64, kb = r / nblk, nb = r % nblk; p0_tile<false>(F.w_out, D, D, 64 * kb, 64 * nb, WOT, 64 * nb, scr, F.lane, 1.0f); continue; } r -= I_O;
        const int e = r / (I_GU + I_DN); r -= e * (I_GU + I_DN);
        if (r < I_GU) { const int nblk = 2 * FF / 64, kb = r / nblk, nb = r % nblk; const int n0 = 64 * nb, half = n0 / FF, j = n0 % FF, pn = j / 128, i0 = j % 128;
            p0_tile<MOE_FP8 != 0>(F.w_gu + (size_t)e * D * 2 * FF, 2 * FF, D, 64 * kb, n0, WGUT + (size_t)e * 2 * FF * D * ES, pn * 256 + half * 128 + i0, scr, F.lane, MOE_FP8 ? 32.0f : 1.0f); continue; } r -= I_GU;
        { const int nblk = D / 64, kb = r / nblk, nb = r % nblk;
          p0_tile<MOE_FP8 != 0>(F.w_dn + (size_t)e * FF * D, D, FF, 64 * kb, 64 * nb, WDT + (size_t)e * D * FF * ES, 64 * nb, scr, F.lane, MOE_FP8 ? 32.0f : 1.0f); }
    }
}

struct GlaIn { f32x4 gl[4]; u32x4 q, k, v0, v1, g0, g1; };
template <bool OUT>
__device__ __forceinline__ void gla_load(Frame& F, int u, GlaIn& L) {
    const bf16_t* PROJ = (const bf16_t*)(F.ws + WS_PROJ); const float* GKL = (const float*)(F.ws + WS_GKL);
    const int b = u / (NH * NCH), h = (u / NCH) % NH, n = u % NCH, tok0 = b * SEQ + n * CHUNK, tok = tok0 + F.lane, w = F.wave;
#pragma unroll
    for (int q = 0; q < 4; ++q) L.gl[q] = *(const f32x4*)(GKL + (size_t)tok * 16 + 4 * q);
    L.k = *(const u32x4*)(PROJ + (size_t)tok * NPROJ + C_K + h * DK + 8 * w);
    L.v0 = *(const u32x4*)(PROJ + (size_t)tok * NPROJ + C_V + h * DV + 16 * w); L.v1 = *(const u32x4*)(PROJ + (size_t)tok * NPROJ + C_V + h * DV + 16 * w + 8);
    if constexpr (OUT) {
        L.q = *(const u32x4*)(PROJ + (size_t)tok * NPROJ + C_Q + h * DK + 8 * w);
        const bf16_t* gp = PROJ + (size_t)(tok0 + (F.tid >> 3)) * NPROJ + C_G + h * DV + 16 * (F.tid & 7);
        L.g0 = *(const u32x4*)gp; L.g1 = *(const u32x4*)(gp + 8);
    }
}
constexpr int WGK_OFF = 81920;
__device__ __forceinline__ void gla_stage_wgk(Frame& F) {
    LAS float* wgk = (LAS float*)(F.lds + WGK_OFF);
    for (int i = F.tid; i < 17 * 256; i += NTHR) wgk[i] = i < 16 * 256 ? F.w_gk_up[i] : F.b_gk_up[i - 16 * 256];
    __syncthreads();
}
__device__ __forceinline__ void gla_decay(Frame& F, const GlaIn& L, int h, float (&bc)[8], float (&blast)[8]) {
    const LAS float* wgk = (const LAS float*)(F.lds + WGK_OFF);
    const float gl[16] = {L.gl[0].x, L.gl[0].y, L.gl[0].z, L.gl[0].w, L.gl[1].x, L.gl[1].y, L.gl[1].z, L.gl[1].w, L.gl[2].x, L.gl[2].y, L.gl[2].z, L.gl[2].w, L.gl[3].x, L.gl[3].y, L.gl[3].z, L.gl[3].w};
    const int dbase = h * DK + 8 * F.wave;
#pragma unroll
    for (int i = 0; i < 8; ++i) {
        float gk = wgk[16 * 256 + dbase + i];
#pragma unroll
        for (int r = 0; r < 16; ++r) gk += gl[r] * wgk[r * (NH * DK) + dbase + i];
        float la = log_sigmoidf_(gk) * (1.0f / 16.0f);
        la = wave_incl_scan(la);
        bc[i] = la; blast[i] = __builtin_bit_cast(float, __builtin_amdgcn_readlane(__builtin_bit_cast(int, la), 63));
        asm volatile("" ::: "memory");
    }
}

constexpr int LP = 72;
__device__ __forceinline__ void p2_gla_kv(Frame& F) {
    float* KVT = (float*)(F.ws + WS_KVT); float* DEC = (float*)(F.ws + WS_DEC);
    LAS bf16_t* kremT = (LAS bf16_t*)F.lds;
    LAS bf16_t* vT = (LAS bf16_t*)(F.lds + 64 * LP * 2);
    const int lane = F.lane, w = F.wave;
    gla_stage_wgk(F);
    GlaIn cur, nxt;
    if (F.bx < NUNITS_GLA) gla_load<false>(F, F.bx, cur);
    for (int u = F.bx; u < NUNITS_GLA; u += F.G) {
        if (u + F.G < NUNITS_GLA) gla_load<false>(F, u + F.G, nxt);
        const int h = (u / NCH) % NH;
        float bc[8], blast[8];
        gla_decay(F, cur, h, bc, blast);
        const unsigned kw[4] = {cur.k.x, cur.k.y, cur.k.z, cur.k.w};
#pragma unroll
        for (int i = 0; i < 8; ++i) { const float kv = (i & 1) ? bfhi(kw[i >> 1]) : bflo(kw[i >> 1]);
            kremT[(8 * w + i) * LP + lane] = (bf16_t)f2bf(kv * __expf(blast[i] - bc[i])); }
        if (lane == 0) {
#pragma unroll
            for (int i = 0; i < 8; ++i) DEC[(size_t)u * DK + 8 * w + i] = __expf(blast[i]);
        }
        { const unsigned vw[8] = {cur.v0.x, cur.v0.y, cur.v0.z, cur.v0.w, cur.v1.x, cur.v1.y, cur.v1.z, cur.v1.w};
#pragma unroll
          for (int i = 0; i < 16; ++i) vT[(16 * w + i) * LP + lane] = (bf16_t)((i & 1) ? (vw[i >> 1] >> 16) : (vw[i >> 1] & 0xffffu)); }
        __syncthreads();
        const int fr = lane & 15, fq = lane >> 4;
        bf16x8 a[2];
#pragma unroll
        for (int s = 0; s < 2; ++s) a[s] = *(const LAS bf16x8*)(vT + (16 * w + fr) * LP + 8 * fq + 32 * s);
#pragma unroll
        for (int dt = 0; dt < 4; ++dt) {
            f32x4 c = (f32x4){0.f, 0.f, 0.f, 0.f};
#pragma unroll
            for (int s = 0; s < 2; ++s) { const bf16x8 bb = *(const LAS bf16x8*)(kremT + (16 * dt + fr) * LP + 8 * fq + 32 * s); c = __builtin_amdgcn_mfma_f32_16x16x32_bf16(a[s], bb, c, 0, 0, 0); }
#pragma unroll
            for (int r = 0; r < 4; ++r) KVT[((size_t)u * DV + 16 * w + 4 * fq + r) * DK + 16 * dt + fr] = c[r];
        }
        __syncthreads();
        cur.gl[0] = nxt.gl[0]; cur.gl[1] = nxt.gl[1]; cur.gl[2] = nxt.gl[2]; cur.gl[3] = nxt.gl[3]; cur.k = nxt.k; cur.v0 = nxt.v0; cur.v1 = nxt.v1;
    }
}

__device__ __forceinline__ void p3_scan(Frame& F) {
    const float* KVT = (const float*)(F.ws + WS_KVT); const float* DEC = (const float*)(F.ws + WS_DEC); bf16_t* ST = (bf16_t*)(F.ws + WS_ST);
    for (int gid = F.bx * NTHR + F.tid; gid < BATCH * NH * DV * DK; gid += F.G * NTHR) {
        const int bh = gid >> 13, vd = gid & 8191, d = gid & 63;
        float S = 0.f;
#pragma unroll 8
        for (int n = 0; n < NCH; ++n) { const size_t u = (size_t)bh * NCH + n;
            ST[u * (DV * DK) + vd] = (bf16_t)f2bf(S);
            S = DEC[u * DK + d] * S + KVT[u * (DV * DK) + vd]; }
    }
}

constexpr int OTP = 132;
__device__ __forceinline__ void p4_gla_out(Frame& F) {
    const bf16_t* PROJ = (const bf16_t*)(F.ws + WS_PROJ); bf16_t* Y = (bf16_t*)(F.ws + WS_Y);
    LAS bf16_t* qd = (LAS bf16_t*)F.lds;
    LAS bf16_t* kd = (LAS bf16_t*)(F.lds + 64 * LP * 2);
    LAS bf16_t* vT = (LAS bf16_t*)(F.lds + 2 * 64 * LP * 2);
    LAS bf16_t* pm = (LAS bf16_t*)(F.lds + 4 * 64 * LP * 2);
    LAS float* red = (LAS float*)(F.lds + 5 * 64 * LP * 2);
    LAS float* ot = (LAS float*)(F.lds + 5 * 64 * LP * 2 + 512);
    const int lane = F.lane, w = F.wave, fr = lane & 15, fq = lane >> 4;
    const int ct = w & 3, vt0 = 4 * (w >> 2);
    float gng[4];
#pragma unroll
    for (int vi = 0; vi < 4; ++vi) gng[vi] = F.gla_g[16 * (vt0 + vi) + fr];
    gla_stage_wgk(F);
    GlaIn cur, nxt;
    for (int rep_g = 0; rep_g < 1 + ((REPMASK >> 20) & 1); ++rep_g) {
    if (F.bx < NUNITS_GLA) gla_load<true>(F, F.bx, cur);
    for (int u = F.bx; u < NUNITS_GLA; u += F.G) {
        if (u + F.G < NUNITS_GLA) gla_load<true>(F, u + F.G, nxt);
        const int b = u / (NH * NCH), h = (u / NCH) % NH, n = u % NCH;
        const int tok0 = b * SEQ + n * CHUNK;
        bf16x8 stf[4][2];
        { const bf16_t* ST = (const bf16_t*)(F.ws + WS_ST);
#pragma unroll
          for (int vi = 0; vi < 4; ++vi)
#pragma unroll
              for (int s = 0; s < 2; ++s) stf[vi][s] = *(const bf16x8*)(ST + ((size_t)u * DV + 16 * (vt0 + vi) + fr) * DK + 8 * fq + 32 * s); }
        float bc[8], blast[8];
        gla_decay(F, cur, h, bc, blast);
        { const unsigned qw[4] = {cur.q.x, cur.q.y, cur.q.z, cur.q.w}, kw[4] = {cur.k.x, cur.k.y, cur.k.z, cur.k.w};
          u32x4 qo, ko; unsigned qq[4], kk[4];
#pragma unroll
          for (int p = 0; p < 4; ++p) { const float e0 = __expf(bc[2 * p]), e1 = __expf(bc[2 * p + 1]);
              qq[p] = pk2(bflo(qw[p]) * 0.125f * e0, bfhi(qw[p]) * 0.125f * e1);
              kk[p] = pk2(bflo(kw[p]) * __expf(-bc[2 * p]), bfhi(kw[p]) * __expf(-bc[2 * p + 1])); }
          qo.x = qq[0]; qo.y = qq[1]; qo.z = qq[2]; qo.w = qq[3]; ko.x = kk[0]; ko.y = kk[1]; ko.z = kk[2]; ko.w = kk[3];
          *(LAS u32x4*)(qd + lane * LP + 8 * w) = qo; *(LAS u32x4*)(kd + lane * LP + 8 * w) = ko; }
        { const unsigned vw[8] = {cur.v0.x, cur.v0.y, cur.v0.z, cur.v0.w, cur.v1.x, cur.v1.y, cur.v1.z, cur.v1.w};
#pragma unroll
          for (int i = 0; i < 16; ++i) vT[(16 * w + i) * LP + lane] = (bf16_t)((i & 1) ? (vw[i >> 1] >> 16) : (vw[i >> 1] & 0xffffu)); }
        __syncthreads();
        { const int cts = w >> 1;
          bf16x8 a[2];
#pragma unroll
          for (int s = 0; s < 2; ++s) a[s] = *(const LAS bf16x8*)(qd + (16 * cts + fr) * LP + 8 * fq + 32 * s);
#pragma unroll
          for (int jj = 0; jj < 2; ++jj) { const int jt = 2 * (w & 1) + jj;
              f32x4 c = (f32x4){0.f, 0.f, 0.f, 0.f};
#pragma unroll
              for (int s = 0; s < 2; ++s) { const bf16x8 bb = *(const LAS bf16x8*)(kd + (16 * jt + fr) * LP + 8 * fq + 32 * s); c = __builtin_amdgcn_mfma_f32_16x16x32_bf16(a[s], bb, c, 0, 0, 0); }
#pragma unroll
              for (int r = 0; r < 4; ++r) { const int cc = 16 * cts + 4 * fq + r, jcol = 16 * jt + fr; pm[cc * LP + jcol] = (bf16_t)f2bf(jcol <= cc ? c[r] : 0.f); } } }
        __syncthreads();
        bf16x8 ap[2], aq[2];
#pragma unroll
        for (int s = 0; s < 2; ++s) { ap[s] = *(const LAS bf16x8*)(pm + (16 * ct + fr) * LP + 8 * fq + 32 * s); aq[s] = *(const LAS bf16x8*)(qd + (16 * ct + fr) * LP + 8 * fq + 32 * s); }
        f32x4 o[4]; float ss[4] = {0.f, 0.f, 0.f, 0.f};
#pragma unroll
        for (int vi = 0; vi < 4; ++vi) { const int vt = vt0 + vi;
            f32x4 c = (f32x4){0.f, 0.f, 0.f, 0.f};
#pragma unroll
            for (int s = 0; s < 2; ++s) { const bf16x8 bb = *(const LAS bf16x8*)(vT + (16 * vt + fr) * LP + 8 * fq + 32 * s); c = __builtin_amdgcn_mfma_f32_16x16x32_bf16(ap[s], bb, c, 0, 0, 0); }
#pragma unroll
            for (int s = 0; s < 2; ++s) c = __builtin_amdgcn_mfma_f32_16x16x32_bf16(aq[s], stf[vi][s], c, 0, 0, 0);
            o[vi] = c;
#pragma unroll
            for (int r = 0; r < 4; ++r) ss[r] += c[r] * c[r]; }
#pragma unroll
        for (int r = 0; r < 4; ++r) { float t = ss[r]; t += __shfl_xor(t, 1); t += __shfl_xor(t, 2); t += __shfl_xor(t, 4); t += __shfl_xor(t, 8); ss[r] = t; }
        if (fr == 0) {
#pragma unroll
            for (int r = 0; r < 4; ++r) red[w * 16 + 4 * fq + r] = ss[r];
        }
        __syncthreads();
#pragma unroll
        for (int r = 0; r < 4; ++r) { const float tot = red[ct * 16 + 4 * fq + r] + red[(ct + 4) * 16 + 4 * fq + r]; const float rstd = __builtin_amdgcn_rsqf(tot * (1.0f / DV) + RMS_EPS);
#pragma unroll
            for (int vi = 0; vi < 4; ++vi) ot[(16 * ct + 4 * fq + r) * OTP + 16 * (vt0 + vi) + fr] = o[vi][r] * rstd * gng[vi]; }
        __syncthreads();
        { const int c = F.tid >> 3, sg = F.tid & 7; const LAS float* op = ot + c * OTP + 16 * sg;
          const unsigned gw[8] = {cur.g0.x, cur.g0.y, cur.g0.z, cur.g0.w, cur.g1.x, cur.g1.y, cur.g1.z, cur.g1.w};
          unsigned ow[8];
#pragma unroll
          for (int q = 0; q < 4; ++q) { const f32x4 ov = *(const LAS f32x4*)(op + 4 * q);
              const float ga = bflo(gw[2 * q]), gb = bfhi(gw[2 * q]), gc = bflo(gw[2 * q + 1]), gd = bfhi(gw[2 * q + 1]);
              ow[2 * q] = pk2(ov.x * (ga * sigmoidf_(ga)), ov.y * (gb * sigmoidf_(gb))); ow[2 * q + 1] = pk2(ov.z * (gc * sigmoidf_(gc)), ov.w * (gd * sigmoidf_(gd))); }
          unsigned char* yp = (unsigned char*)Y + tiled_off(tok0 + c, 2 * (CONVW + h * DV + 16 * sg), D / 64);
          *(u32x4*)yp = (u32x4){ow[0], ow[1], ow[2], ow[3]}; *(u32x4*)(yp + 16) = (u32x4){ow[4], ow[5], ow[6], ow[7]}; }
        __syncthreads();
        cur = nxt;
    }
    }
    for (int rep_c = 0; rep_c < 1 + ((REPMASK >> 21) & 1); ++rep_c)
    for (int it = F.bx * NTHR + F.tid; it < M * (CONVW / 8); it += F.G * NTHR) {
        const int t = it >> 6, c8 = (it & 63) * 8, s = t & (SEQ - 1);
        float acc[8];
#pragma unroll
        for (int j = 0; j < 8; ++j) acc[j] = 0.f;
#pragma unroll
        for (int i = 0; i < 3; ++i) { const int sp = s - 2 + i; if (sp < 0) continue;
            const size_t ro = (size_t)(t - 2 + i) * NPROJ;
            const u32x4 uh = *(const u32x4*)(PROJ + ro + C_UH + c8), gc = *(const u32x4*)(PROJ + ro + C_GC + c8);
            const unsigned uw[4] = {uh.x, uh.y, uh.z, uh.w}, gw[4] = {gc.x, gc.y, gc.z, gc.w};
            const f32x4 w0 = *(const f32x4*)(F.conv_w + i * CONVW + c8), w1 = *(const f32x4*)(F.conv_w + i * CONVW + c8 + 4);
            const float ww[8] = {w0.x, w0.y, w0.z, w0.w, w1.x, w1.y, w1.z, w1.w};
#pragma unroll
            for (int p = 0; p < 4; ++p) { acc[2 * p] += ww[2 * p] * (bflo(uw[p]) * bflo(gw[p])); acc[2 * p + 1] += ww[2 * p + 1] * (bfhi(uw[p]) * bfhi(gw[p])); } }
        const u32x4 gb = *(const u32x4*)(PROJ + (size_t)t * NPROJ + C_GB + c8); const unsigned bw[4] = {gb.x, gb.y, gb.z, gb.w};
        u32x4 o;
        o.x = pk2(bflo(bw[0]) * acc[0], bfhi(bw[0]) * acc[1]); o.y = pk2(bflo(bw[1]) * acc[2], bfhi(bw[1]) * acc[3]);
        o.z = pk2(bflo(bw[2]) * acc[4], bfhi(bw[2]) * acc[5]); o.w = pk2(bflo(bw[3]) * acc[6], bfhi(bw[3]) * acc[7]);
        *(u32x4*)((unsigned char*)Y + tiled_off(t, 2 * c8, D / 64)) = o;
    }
}

constexpr int WRP = 1032;
__device__ __forceinline__ void p6_router(Frame& F) {
    LAS bf16_t* wh = (LAS bf16_t*)F.lds;
    LAS bf16_t* wl = (LAS bf16_t*)(F.lds + 32 * WRP * 2);
    LAS float* lgp = (LAS float*)(F.lds + 2 * 32 * WRP * 2);
    LAS int* hist = (LAS int*)(F.lds + 2 * 32 * WRP * 2 + 2 * 64 * 33 * 4);
    const float* X1 = (const float*)(F.ws + WS_X1); bf16_t* XB = (bf16_t*)(F.ws + WS_XN); float* RSTD = (float*)(F.ws + WS_ROUTE + R_RSTD);
    int* TOPI = (int*)(F.ws + WS_ROUTE + R_TOPI); float* TOPG = (float*)(F.ws + WS_ROUTE + R_TOPG); int* HIST = (int*)(F.ws + WS_ROUTE + R_HIST);
    for (int i = F.tid; i < 1024 * 32; i += NTHR) { const int k = i >> 5, e = i & 31; const float wv = F.w_router[i]; const unsigned h = f2bf(wv); const float hf = __builtin_bit_cast(float, h << 16);
        wh[e * WRP + k] = (bf16_t)h; wl[e * WRP + k] = (bf16_t)f2bf(wv - hf); }
    const int lane = F.lane, w = F.wave, fr = lane & 15, fq = lane >> 4, rt = w & 3, kh = w >> 2;
    for (int wg = F.bx; wg < M / 64; wg += F.G) {
        if (F.tid < 32) hist[F.tid] = 0;
        __syncthreads();
        const int m = wg * 64 + rt * 16 + fr;
        const float* xrow = X1 + (size_t)m * D + kh * 512 + 8 * fq;
        bf16_t* orow = XB + (size_t)m * D + kh * 512 + 8 * fq;
        const float* grow = F.g_ffn + kh * 512 + 8 * fq;
        f32x4 c0 = (f32x4){0.f, 0.f, 0.f, 0.f}, c1 = c0; float s2 = 0.f;
#pragma unroll 4
        for (int s = 0; s < 16; ++s) {
            const f32x4 x0 = *(const f32x4*)(xrow + 32 * s), x1v = *(const f32x4*)(xrow + 32 * s + 4);
            const f32x4 g0 = *(const f32x4*)(grow + 32 * s), g1 = *(const f32x4*)(grow + 32 * s + 4);
            s2 += (x0.x * x0.x + x0.y * x0.y) + (x0.z * x0.z + x0.w * x0.w) + (x1v.x * x1v.x + x1v.y * x1v.y) + (x1v.z * x1v.z + x1v.w * x1v.w);
            const float xg[8] = {x0.x * g0.x, x0.y * g0.y, x0.z * g0.z, x0.w * g0.w, x1v.x * g1.x, x1v.y * g1.y, x1v.z * g1.z, x1v.w * g1.w};
            unsigned hw[4], lw[4];
#pragma unroll
            for (int p = 0; p < 4; ++p) { const unsigned h0 = f2bf(xg[2 * p]), h1 = f2bf(xg[2 * p + 1]);
                hw[p] = h0 | (h1 << 16);
                lw[p] = pk2(xg[2 * p] - __builtin_bit_cast(float, h0 << 16), xg[2 * p + 1] - __builtin_bit_cast(float, h1 << 16)); }
            const u32x4 hv = {hw[0], hw[1], hw[2], hw[3]}, lv = {lw[0], lw[1], lw[2], lw[3]};
            if constexpr (MOE_FP8) { u32x2 f8; f8.x = pk4_fp8(xg[0], xg[1], xg[2], xg[3]); f8.y = pk4_fp8(xg[4], xg[5], xg[6], xg[7]); *(u32x2*)((unsigned char*)XB + (size_t)m * D + kh * 512 + 8 * fq + 32 * s) = f8; }
            else *(u32x4*)(orow + 32 * s) = hv;
            const bf16x8 ah = __builtin_bit_cast(bf16x8, hv), al = __builtin_bit_cast(bf16x8, lv);
            const int kk = kh * 512 + 32 * s + 8 * fq;
            const bf16x8 bh0 = *(const LAS bf16x8*)(wh + fr * WRP + kk), bh1 = *(const LAS bf16x8*)(wh + (16 + fr) * WRP + kk);
            const bf16x8 bl0 = *(const LAS bf16x8*)(wl + fr * WRP + kk), bl1 = *(const LAS bf16x8*)(wl + (16 + fr) * WRP + kk);
            c0 = __builtin_amdgcn_mfma_f32_16x16x32_bf16(ah, bh0, c0, 0, 0, 0); c1 = __builtin_amdgcn_mfma_f32_16x16x32_bf16(ah, bh1, c1, 0, 0, 0);
            c0 = __builtin_amdgcn_mfma_f32_16x16x32_bf16(al, bh0, c0, 0, 0, 0); c1 = __builtin_amdgcn_mfma_f32_16x16x32_bf16(al, bh1, c1, 0, 0, 0);
            c0 = __builtin_amdgcn_mfma_f32_16x16x32_bf16(ah, bl0, c0, 0, 0, 0); c1 = __builtin_amdgcn_mfma_f32_16x16x32_bf16(ah, bl1, c1, 0, 0, 0);
        }
        s2 += __shfl_xor(s2, 16); s2 += __shfl_xor(s2, 32);
#pragma unroll
        for (int r = 0; r < 4; ++r) { LAS float* dst = lgp + (kh * 64 + rt * 16 + 4 * fq + r) * 33; dst[fr] = c0[r]; dst[16 + fr] = c1[r]; }
        if (fq == 0) lgp[(kh * 64 + rt * 16 + fr) * 33 + 32] = s2;
        __syncthreads();
        if (F.tid < 64) {
            const int row = F.tid, mm = wg * 64 + row;
            const LAS float* p0 = lgp + row * 33; const LAS float* p1 = lgp + (64 + row) * 33;
            const float rstd = 1.0f / sqrtf((p0[32] + p1[32]) * (1.0f / D) + RMS_EPS);
            float l[32];
#pragma unroll
            for (int e = 0; e < 32; ++e) l[e] = (p0[e] + p1[e]) * rstd + F.b_router[e];
            int bi[4]; float bv[4]; unsigned used = 0u;
#pragma unroll
            for (int k = 0; k < 4; ++k) { float best = -3.0e38f; int be = 0;
#pragma unroll
                for (int e = 0; e < 32; ++e) { const bool ok = !((used >> e) & 1u) && l[e] > best; best = ok ? l[e] : best; be = ok ? e : be; }
                used |= 1u << be; bi[k] = be; bv[k] = best; }
            const float e1 = __expf(bv[1] - bv[0]), e2 = __expf(bv[2] - bv[0]), e3 = __expf(bv[3] - bv[0]); const float inv = 1.0f / (1.0f + e1 + e2 + e3);
            *(int4*)(TOPI + (size_t)mm * 4) = make_int4(bi[0], bi[1], bi[2], bi[3]);
            *(f32x4*)(TOPG + (size_t)mm * 4) = (f32x4){inv, e1 * inv, e2 * inv, e3 * inv};
            RSTD[mm] = rstd;
#pragma unroll
            for (int k = 0; k < 4; ++k) atomicAdd((int*)&hist[bi[k]], 1);
        }
        __syncthreads();
        if (F.tid < 32) HIST[wg * 32 + F.tid] = hist[F.tid];
        __syncthreads();
    }
}

__device__ __forceinline__ void p7_slots(Frame& F) {
    LAS int* part = (LAS int*)F.lds;
    LAS int* cnt = part + 1024;
    LAS int* pre = cnt + 32;
    LAS int* pst = pre + 32;
    LAS int* exa = pst + 64;
    const int* TOPI = (const int*)(F.ws + WS_ROUTE + R_TOPI); const float* TOPG = (const float*)(F.ws + WS_ROUTE + R_TOPG); const int* HIST = (const int*)(F.ws + WS_ROUTE + R_HIST);
    int* POS = (int*)(F.ws + WS_ROUTE + R_POS); int* ROWTOK = (int*)(F.ws + WS_ROUTE + R_ROWTOK); float* ROWGATE = (float*)(F.ws + WS_ROUTE + R_ROWGATE); int* META = (int*)(F.ws + WS_ROUTE + R_META);
    const float* RSTD = (const float*)(F.ws + WS_ROUTE + R_RSTD); float* ROWRSTD = (float*)(F.ws + WS_ROUTE + R_ROWRSTD);
    constexpr int NWG = M / 64;
    for (int wg = F.bx; wg < NWG; wg += F.G) {
        { const int e = F.tid & 31, p = F.tid >> 5; int tot = 0, bef = 0;
          for (int q = p * 16; q < p * 16 + 16; ++q) { const int hv = HIST[q * 32 + e]; tot += hv; bef += (q < wg) ? hv : 0; }
          part[(p * 32 + e) * 2] = tot; part[(p * 32 + e) * 2 + 1] = bef; }
        __syncthreads();
        if (F.tid < 32) { int tot = 0, bef = 0; for (int p = 0; p < 16; ++p) { tot += part[(p * 32 + F.tid) * 2]; bef += part[(p * 32 + F.tid) * 2 + 1]; } cnt[F.tid] = tot; pre[F.tid] = bef; }
        __syncthreads();
        if (F.tid == 0) { int s = 0; for (int e = 0; e < 32; ++e) { pst[e] = s; s += (cnt[e] + 255) & ~255; } pst[32] = s; }
        int my_e = 0, tokn = 0, kk = 0; float my_g = 0.f;
        if (F.tid < 256) { tokn = wg * 64 + (F.tid >> 2); kk = F.tid & 3; my_e = TOPI[(size_t)tokn * 4 + kk]; my_g = TOPG[(size_t)tokn * 4 + kk]; exa[F.tid] = my_e; }
        __syncthreads();
        if (F.tid < 256) { int rank = 0; for (int a = 0; a < F.tid; ++a) rank += (exa[a] == my_e) ? 1 : 0;
            const int slot = pst[my_e] + pre[my_e] + rank;
            ROWTOK[slot] = tokn; ROWGATE[slot] = my_g; ROWRSTD[slot] = RSTD[tokn]; POS[(size_t)tokn * 4 + kk] = slot; }
        if (wg < NE) { const int e = wg, c = cnt[e], s0 = pst[e] + c, s1 = pst[e] + ((c + 255) & ~255);
            for (int s = s0 + F.tid; s < s1; s += NTHR) { ROWTOK[s] = 0; ROWGATE[s] = 0.f; ROWRSTD[s] = 0.f; } }
        if (wg == 0) { if (F.tid == 0) META[0] = pst[32] >> 8;
            for (int t = F.tid; t < NTILES_MAX; t += NTHR) { int e = 0; for (int q = 0; q < 32; ++q) e += (t * 256 >= pst[q + 1]) ? 1 : 0; META[32 + t] = e < 32 ? e : 31; } }
        __syncthreads();
    }
}

__device__ __forceinline__ void p10_combine(Frame& F) {
    const float* X1 = (const float*)(F.ws + WS_X1); const bf16_t* CB = (const bf16_t*)(F.ws + WS_CONTRIB); const int* POS = (const int*)(F.ws + WS_ROUTE + R_POS);
    const int gw = F.bx * NWAVES + F.wave, NGW = F.G * NWAVES;
    for (int m = gw; m < M; m += NGW) {
        const GAS f32x4* xr = (const GAS f32x4*)(X1 + (size_t)m * D) + F.lane;
        f32x4 v[4];
#pragma unroll
        for (int j = 0; j < 4; ++j) v[j] = xr[64 * j];
        const int4 ps = *(const int4*)(POS + (size_t)m * 4); const int pp[4] = {ps.x, ps.y, ps.z, ps.w};
#pragma unroll
        for (int k = 0; k < 4; ++k) { const GAS u32x2* cr = (const GAS u32x2*)(CB + (size_t)pp[k] * D) + F.lane;
#pragma unroll
            for (int j = 0; j < 4; ++j) { const u32x2 c = cr[64 * j]; v[j].x += bflo(c.x); v[j].y += bfhi(c.x); v[j].z += bflo(c.y); v[j].w += bfhi(c.y); } }
        float s2 = 0.f;
#pragma unroll
        for (int j = 0; j < 4; ++j) s2 += (v[j].x * v[j].x + v[j].y * v[j].y) + (v[j].z * v[j].z + v[j].w * v[j].w);
        const float rstd = 1.0f / sqrtf(wave_sum(s2) * (1.0f / D) + RMS_EPS);
        GAS f32x4* orow = (GAS f32x4*)(F.out + (size_t)m * D) + F.lane;
#pragma unroll
        for (int j = 0; j < 4; ++j) { const f32x4 g = *((const GAS f32x4*)F.g_fin + F.lane + 64 * j); orow[64 * j] = v[j] * rstd * g; }
    }
}

__global__ void __launch_bounds__(NTHR, 2) fwd_kernel(Args args) {
    extern __shared__ __attribute__((aligned(16))) unsigned char lds_raw[];
    Frame F;
    F.lds = (LAS unsigned char*)lds_raw;
    F.tid = threadIdx.x; F.lane = F.tid & 63; F.wave = __builtin_amdgcn_readfirstlane(F.tid >> 6); F.G = gridDim.x; F.bx = blockIdx.x;
    F.x = args.in[0]; F.g_mix = args.in[1]; F.w_in = args.in[2]; F.conv_w = args.in[3]; F.w_gk_up = args.in[4]; F.b_gk_up = args.in[5]; F.gla_g = args.in[6]; F.w_out = args.in[7];
    F.g_ffn = args.in[8]; F.w_router = args.in[9]; F.b_router = args.in[10]; F.w_gu = args.in[11]; F.b_gu = args.in[12]; F.w_dn = args.in[13]; F.b_dn = args.in[14]; F.g_fin = args.in[15];
    F.out = args.out; F.ws = args.ws;
    volatile LAS unsigned* MISC = (volatile LAS unsigned*)(F.lds + MISC_OFF);
    for (int u = F.tid; u < 256; u += NTHR) MISC[u] = 0u;
    __syncthreads();
    unsigned* ctl = (unsigned*)(F.ws + WS_CTL);
    XcdBarrier bar; bar.bar = ctl + CW_BAR; bar.x = 0; bar.st = nullptr;
    if (N_LAUNCHES == 1) bar = xcd_barrier_post(ctl + CW_BAR, MISC + 8);
    const int lo = args.ph_lo, hi = args.ph_hi;
#define IN(k) (lo <= (k) && (k) < hi)
#define SEAM(k) do { if (IN(k) && IN((k) + 1)) xcd_barrier(bar); } while (0)
#define REP(k) for (int rep_ = 0; rep_ < 1 + ((REPMASK >> (k)) & 1); ++rep_)
    const int* META = (const int*)(F.ws + WS_ROUTE + R_META);

    if (IN(0)) REP(0) { p0_prep(F); } SEAM(0);
    if (IN(1)) {
        pg8::StaticOrder S; S.init(M / 256, NPROJ / 256, F.G, F.bx, 1 + ((REPMASK >> 1) & 1));
        pg8::EpiBf16 E{(bf16_t*)(F.ws + WS_PROJ), NPROJ};
        pg8::gemm_phase<pg8::EpiBf16, pg8::StaticOrder, true, false, 1 + ((REPMASK >> 14) & 1)>(F.lds, F.ws + WS_XN, F.ws + WS_W1T, 0, D / 64, nullptr, S, E);
    } SEAM(1);
    if (IN(2)) REP(2) { p2_gla_kv(F); } SEAM(2);
    if (IN(3)) REP(3) { p3_scan(F); } SEAM(3);
    if (IN(4)) REP(4) { p4_gla_out(F); } SEAM(4);
    if (IN(5)) {
        pg8::StaticOrder S; S.init(M / 256, D / 256, F.G, F.bx, 1 + ((REPMASK >> 5) & 1));
        pg8::EpiResF32 E{F.x, (float*)(F.ws + WS_X1), D};
        pg8::gemm_phase<pg8::EpiResF32, pg8::StaticOrder, true, false, 1 + ((REPMASK >> 15) & 1)>(F.lds, F.ws + WS_Y, F.ws + WS_WOT, 0, D / 64, nullptr, S, E);
    } SEAM(5);
    if (IN(6)) REP(6) { p6_router(F); } SEAM(6);
    if (IN(7)) REP(7) { p7_slots(F); } SEAM(7);
    if (IN(8)) {
        const int ntiles = META[0];
        LAS int* te = (LAS int*)(F.lds + TE_OFF); LAS int* utab = te + NTILES_MAX;
        LAS unsigned short* ridx = (LAS unsigned short*)(F.lds + TE_OFF + 2048); LAS float* rstd = (LAS float*)(F.lds + TE_OFF + 2048 + pg8::UCAP * 512); LAS float* bias = rstd + pg8::UCAP * 256;
        for (int i = F.tid; i < NTILES_MAX; i += NTHR) te[i] = META[32 + i];
        __syncthreads();
        pg8::MoeOrder S0; S0.so.init(ntiles, 2 * FF / 256, F.G, F.bx); S0.tile_expert = te;
        int nun = 0;
        { const int* ROWTOK = (const int*)(F.ws + WS_ROUTE + R_ROWTOK); const float* ROWRSTD = (const float*)(F.ws + WS_ROUTE + R_ROWRSTD); pg8::Unit uu;
          for (; nun < pg8::UCAP && S0.next(nun, uu); ++nun) {
              if (F.tid == 0) { utab[4 * nun] = uu.pm; utab[4 * nun + 1] = uu.pn; utab[4 * nun + 2] = uu.pb; utab[4 * nun + 3] = uu.e; }
              if (F.tid < 256) { ridx[nun * 256 + F.tid] = (unsigned short)ROWTOK[uu.pm * 256 + F.tid]; rstd[nun * 256 + F.tid] = ROWRSTD[uu.pm * 256 + F.tid];
                  bias[nun * 256 + F.tid] = F.b_gu[(size_t)uu.e * 2048 + (F.tid >> 7) * 1024 + uu.pn * 128 + (F.tid & 127)]; } }
          __syncthreads(); }
        pg8::TabOrder S{utab, nun, (REPMASK >> 18) & 1};
        pg8::EpiSwiglu E{(bf16_t*)(F.ws + WS_H), bias, rstd};
        constexpr int ES = MOE_FP8 ? 1 : 2;
        pg8::gemm_phase<pg8::EpiSwiglu, pg8::TabOrder, true, MOE_FP8 != 0, 1 + ((REPMASK >> 16) & 1)>(F.lds, F.ws + WS_XN, F.ws + WS_WGUT, D * ES, D * ES / 128, ridx, S, E);
    } SEAM(8);
    if (IN(9)) {
        const int ntiles = META[0];
        LAS int* te = (LAS int*)(F.lds + TE_OFF); LAS int* utab = te + NTILES_MAX;
        LAS float* gate = (LAS float*)(F.lds + TE_OFF + 2048); LAS float* bias = gate + pg8::UCAP * 256;
        for (int i = F.tid; i < NTILES_MAX; i += NTHR) te[i] = META[32 + i];
        __syncthreads();
        pg8::MoeOrder S0; S0.so.init(ntiles, D / 256, F.G, F.bx); S0.tile_expert = te;
        int nun = 0;
        { const float* ROWGATE = (const float*)(F.ws + WS_ROUTE + R_ROWGATE); pg8::Unit uu;
          for (; nun < pg8::UCAP && S0.next(nun, uu); ++nun) {
              if (F.tid == 0) { utab[4 * nun] = uu.pm; utab[4 * nun + 1] = uu.pn; utab[4 * nun + 2] = uu.pb; utab[4 * nun + 3] = uu.e; }
              if (F.tid < 256) { gate[nun * 256 + F.tid] = ROWGATE[uu.pm * 256 + F.tid]; bias[nun * 256 + F.tid] = F.b_dn[(size_t)uu.e * D + uu.pn * 256 + F.tid]; } }
          __syncthreads(); }
        pg8::TabOrder S{utab, nun, (REPMASK >> 19) & 1};
        pg8::EpiDown E{(bf16_t*)(F.ws + WS_CONTRIB), bias, gate};
        constexpr int ES = MOE_FP8 ? 1 : 2;
        pg8::gemm_phase<pg8::EpiDown, pg8::TabOrder, true, MOE_FP8 != 0, 1 + ((REPMASK >> 17) & 1)>(F.lds, F.ws + WS_H, F.ws + WS_WDT, 0, FF * ES / 128, nullptr, S, E);
    } SEAM(9);
    if (IN(10)) REP(10) { p10_combine(F); }
#undef IN
#undef SEAM
}

extern "C" void kernel_launch(void* const* d_in, const int* in_sizes, int n_in, void* d_out, int out_size, void* d_ws, size_t ws_size, hipStream_t stream) {
    static int grid = 0;
    if (grid == 0) {
        if (n_in != 16 || in_sizes[0] != M * D || out_size != M * D || ws_size < WS_END) { fprintf(stderr, "kernel_launch: unexpected shapes (n_in %d, in0 %d, out %d, ws %zu < %zu)\n", n_in, n_in > 0 ? in_sizes[0] : -1, out_size, ws_size, (size_t)WS_END); grid = -1; return; }
        int dev = 0, cus = 0, per_cu = 0;
        if (hipGetDevice(&dev) != hipSuccess || hipDeviceGetAttribute(&cus, hipDeviceAttributeMultiprocessorCount, dev) != hipSuccess) { grid = -1; return; }
        if (hipFuncSetAttribute((const void*)fwd_kernel, hipFuncAttributeMaxDynamicSharedMemorySize, LDS_BYTES) != hipSuccess) { fprintf(stderr, "kernel_launch: hipFuncSetAttribute failed\n"); grid = -1; return; }
        if (hipOccupancyMaxActiveBlocksPerMultiprocessor(&per_cu, (const void*)fwd_kernel, NTHR, LDS_BYTES) != hipSuccess || per_cu < 1) fprintf(stderr, "kernel_launch: occupancy query reports %d\n", per_cu);
        (void)hipGetLastError();
        grid = cus;
    }
    if (grid < 0) return;
    (void)hipMemsetAsync((char*)d_ws + WS_CTL, 0, CTL_ZERO_BYTES, stream);
    Args a{};
    for (int i = 0; i < 16; ++i) a.in[i] = (const float*)d_in[i];
    a.out = (float*)d_out; a.ws = (unsigned char*)d_ws;
    for (int li = 0; li < N_LAUNCHES; ++li) {
        if (N_LAUNCHES == 1) { a.ph_lo = 0; a.ph_hi = NPHASES; } else { a.ph_lo = li; a.ph_hi = li + 1; }
        a.li = li;
        hipLaunchKernelGGL(fwd_kernel, dim3(grid), dim3(NTHR), LDS_BYTES, stream, a);
    }
}
```

```cpp
#include <hip/hip_runtime.h>
#include <cstdio>
#include <cstdint>

#ifndef MK_N_LAUNCHES
#define MK_N_LAUNCHES 1
#endif

#ifndef MOE_FP8
#define MOE_FP8 1
#endif
#ifndef REPMASK
#define REPMASK 0
#endif
#define LAS __attribute__((address_space(3)))
#define GAS __attribute__((address_space(1)))
typedef unsigned short bf16_t;
typedef short bf16x8 __attribute__((ext_vector_type(8)));
typedef float f32x4 __attribute__((ext_vector_type(4)));
typedef float f32x2 __attribute__((ext_vector_type(2)));
typedef unsigned u32x4 __attribute__((ext_vector_type(4)));
typedef unsigned u32x2 __attribute__((ext_vector_type(2)));

constexpr int NWAVES = 8, NTHR = 512;
constexpr int NPHASES = 11;
constexpr int N_LAUNCHES = MK_N_LAUNCHES;
constexpr int BATCH = 4, SEQ = 4096, D = 1024, M = BATCH * SEQ;
constexpr int CONVW = 512, NH = 4, DK = 64, DV = 128, RANK = 16, CHUNK = 64, NCH = SEQ / CHUNK;
constexpr int DIN = 3088, NPROJ = 3072;
constexpr int C_UH = 0, C_GB = 512, C_GC = 1024, C_Q = 1536, C_K = 1792, C_V = 2048, C_G = 2560, C_GKL = 3072;
constexpr int NE = 32, TOPK = 4, FF = 1024;
constexpr int NUNITS_GLA = BATCH * NH * NCH;
constexpr int NROWS_MAX = M * TOPK + NE * 256;
constexpr int NTILES_MAX = NROWS_MAX / 256;
constexpr float RMS_EPS = 1e-5f;

constexpr size_t MiB = 1u << 20;
constexpr size_t WS_CTL = 0, CTL_ZERO_BYTES = 1 * MiB;
constexpr size_t WS_XN = 1 * MiB;
constexpr size_t WS_GKL = WS_XN + 32 * MiB;
constexpr size_t WS_W1T = WS_GKL + 1 * MiB;
constexpr size_t WS_WOT = WS_W1T + 6 * MiB;
constexpr size_t WS_WGUT = WS_WOT + 2 * MiB;
constexpr size_t WS_WDT = WS_WGUT + 128 * MiB;
constexpr size_t WS_PROJ = WS_WDT + 64 * MiB;
constexpr size_t WS_KVT = WS_PROJ + 96 * MiB;
constexpr size_t WS_DEC = WS_KVT + 32 * MiB;
constexpr size_t WS_ST = WS_DEC + 1 * MiB;
constexpr size_t WS_Y = WS_ST + 16 * MiB;
constexpr size_t WS_X1 = WS_Y + 32 * MiB;
constexpr size_t WS_ROUTE = WS_X1 + 64 * MiB;
constexpr size_t WS_H = WS_ROUTE + 2 * MiB;
constexpr size_t WS_CONTRIB = WS_H + 144 * MiB;
constexpr size_t WS_END = WS_CONTRIB + 144 * MiB;
constexpr size_t R_TOPI = 0;
constexpr size_t R_TOPG = 256 * 1024;
constexpr size_t R_POS = 512 * 1024;
constexpr size_t R_ROWTOK = 768 * 1024;
constexpr size_t R_ROWGATE = 1088 * 1024;
constexpr size_t R_HIST = 1408 * 1024;
constexpr size_t R_META = 1472 * 1024;
constexpr size_t R_RSTD = 1536 * 1024;
constexpr size_t R_ROWRSTD = 1664 * 1024;
constexpr int CW_BAR = 4096;

constexpr int LDS_BYTES = 160 * 1024 - 2048;
constexpr int MISC_OFF = LDS_BYTES - 1024;
constexpr int TE_OFF = 131072;

__device__ __forceinline__ unsigned f2bf(float f) { unsigned u = __builtin_bit_cast(unsigned, f); return (u + 0x7fffu + ((u >> 16) & 1u)) >> 16; }
__device__ __forceinline__ unsigned pk2(float lo, float hi) { typedef __bf16 bf2_ __attribute__((ext_vector_type(2))); const f32x2 v = {lo, hi}; return __builtin_bit_cast(unsigned, __builtin_convertvector(v, bf2_)); }
__device__ __forceinline__ float bf2f(unsigned short b) { return __builtin_bit_cast(float, (unsigned)b << 16); }
__device__ __forceinline__ float bflo(unsigned w) { return __builtin_bit_cast(float, w << 16); }
__device__ __forceinline__ float bfhi(unsigned w) { return __builtin_bit_cast(float, w & 0xffff0000u); }
__device__ __forceinline__ unsigned cvt_pk_bf16(float lo, float hi) { unsigned r; asm volatile("v_cvt_pk_bf16_f32 %0, %1, %2" : "=v"(r) : "v"(lo), "v"(hi)); return r; }
__device__ __forceinline__ unsigned pk4_fp8(float a, float b, float c, float d) { int w = 0; w = __builtin_amdgcn_cvt_pk_fp8_f32(a, b, w, false); w = __builtin_amdgcn_cvt_pk_fp8_f32(c, d, w, true); return (unsigned)w; }

__device__ __forceinline__ float sigmoidf_(float x) { return __builtin_amdgcn_rcpf(1.0f + __expf(-x)); }
__device__ __forceinline__ float log_sigmoidf_(float x) { return fminf(x, 0.f) - __logf(1.0f + __expf(-fabsf(x))); }
#define DPPF_(x, ctrl, rm) __builtin_bit_cast(float, __builtin_amdgcn_update_dpp(0, __builtin_bit_cast(int, (x)), (ctrl), (rm), 0xf, false))
__device__ __forceinline__ float row16_sum(float t) { t += DPPF_(t, 0xb1, 0xf); t += DPPF_(t, 0x4e, 0xf); t += DPPF_(t, 0x141, 0xf); t += DPPF_(t, 0x140, 0xf); return t; }
__device__ __forceinline__ float wave_incl_scan(float v) {
    v += DPPF_(v, 0x111, 0xf); v += DPPF_(v, 0x112, 0xf); v += DPPF_(v, 0x114, 0xf); v += DPPF_(v, 0x118, 0xf);
    v += DPPF_(v, 0x142, 0xa); v += DPPF_(v, 0x143, 0xc);
    return v;
}
__device__ __forceinline__ float wave_sum(float v) { const float t = wave_incl_scan(v); return __builtin_bit_cast(float, __builtin_amdgcn_readlane(__builtin_bit_cast(int, t), 63)); }
__host__ __device__ __forceinline__ size_t tiled_off(int row, int cbyte, int nt) { return ((size_t)((row >> 8) * nt + (cbyte >> 7)) << 15) + (size_t)(((row & 255) << 7) + (cbyte & 127)); }
#define LDS_WAIT() asm volatile("s_waitcnt lgkmcnt(0)" ::: "memory")
#define VM_WAIT() asm volatile("s_waitcnt vmcnt(0)" ::: "memory")

#define XB_TMO      128
#define XB_XCNT(j)  (256  + 64 * (j))
#define XB_XSUB(j)  (1280 + 64 * (j))
#define XB_XGEN(j)  (2304 + 64 * (j))
#define XB_TOP      3328
#define XB_TOPGEN   3392
#define XCD_BAR_WORDS 3456
#define XB_SPIN_CAP (1u << 18)
__device__ __forceinline__ unsigned xb_ld(unsigned* p)              { return __hip_atomic_load(p, __ATOMIC_RELAXED, __HIP_MEMORY_SCOPE_AGENT); }
__device__ __forceinline__ unsigned xb_add(unsigned* p, unsigned v) { return __hip_atomic_fetch_add(p, v, __ATOMIC_RELAXED, __HIP_MEMORY_SCOPE_AGENT); }
__device__ __forceinline__ unsigned xb_xcc_id() { return (unsigned)__builtin_amdgcn_s_getreg((3 << 11) | 20) & 0xFu; }
#define XB_SPIN(cond, bar) do { unsigned _sp = 0; while (cond) { __builtin_amdgcn_s_sleep(1); \
    if ((++_sp & 255u) == 0u) { if (xb_ld(&(bar)[XB_TMO])) break; if (_sp > XB_SPIN_CAP) { atomicAdd(&(bar)[XB_TMO], 1u); break; } } } } while (0)
struct XcdBarrier { unsigned* bar; unsigned x; volatile LAS unsigned* st; };
__device__ __forceinline__ XcdBarrier xcd_barrier_post(unsigned* bar, volatile LAS unsigned* st) {
    XcdBarrier b; b.bar = bar; b.x = xb_xcc_id(); b.st = st;
    if (threadIdx.x == 0) (void)xb_add(&bar[XB_XCNT(b.x)], 1u);
    return b;
}
__device__ __forceinline__ void xcd_barrier_complete(unsigned* bar, unsigned x, unsigned& nloc, unsigned& nx) {
    const unsigned G = gridDim.x * gridDim.y * gridDim.z;
    unsigned sum, cnt, mine, sp = 0u;
    for (;;) {
        sum = 0u; cnt = 0u; mine = 0u;
#pragma unroll
        for (unsigned j = 0; j < 16; ++j) { const unsigned c = xb_ld(&bar[XB_XCNT(j)]); sum += c; cnt += (c > 0u) ? 1u : 0u; mine = (j == x) ? c : mine; }
        if (sum == G) break;
        __builtin_amdgcn_s_sleep(1);
        if ((++sp & 255u) == 0u) { if (xb_ld(&bar[XB_TMO])) break; if (sp > XB_SPIN_CAP) { atomicAdd(&bar[XB_TMO], 1u); break; } }
    }
    nloc = mine > 0u ? mine : 1u; nx = cnt > 0u ? cnt : 1u;
}
__device__ __forceinline__ void xcd_barrier(const XcdBarrier& b) {
    asm volatile("s_waitcnt vmcnt(0)" ::: "memory");
    __syncthreads();
    if (threadIdx.x == 0) {
        unsigned* bar = b.bar;
        __builtin_amdgcn_s_waitcnt(0);
        unsigned nloc = b.st[0], nx = b.st[1];
        if (nloc == 0u) { xcd_barrier_complete(bar, b.x, nloc, nx); b.st[0] = nloc; b.st[1] = nx; }
        const unsigned old = xb_add(&bar[XB_XSUB(b.x)], 1u);
        const unsigned gen = old / nloc;
        if (old + 1u == (gen + 1u) * nloc) {
            __builtin_amdgcn_fence(__ATOMIC_RELEASE, "agent");
            asm volatile("s_waitcnt vmcnt(0)" ::: "memory");
            const unsigned og = xb_add(&bar[XB_TOP], 1u);
            const unsigned tg = og / nx;
            if (og + 1u == (tg + 1u) * nx) xb_add(&bar[XB_TOPGEN], 1u);
            else XB_SPIN(xb_ld(&bar[XB_TOPGEN]) == tg, bar);
            __builtin_amdgcn_fence(__ATOMIC_ACQUIRE, "agent");
            xb_add(&bar[XB_XGEN(b.x)], 1u);
            asm volatile("s_waitcnt vmcnt(0)" ::: "memory");
        } else {
            XB_SPIN(xb_ld(&bar[XB_XGEN(b.x)]) == gen, bar);
            __builtin_amdgcn_fence(__ATOMIC_ACQUIRE, "agent");
            asm volatile("s_waitcnt vmcnt(0)" ::: "memory");
        }
    }
    __syncthreads();
}

namespace pg8 {
constexpr int BM = 256, BK = 64, HALF = 128, HTB = HALF * BK * 2, STAGE_BYTES = 8 * HTB, NXCD = 8, WGM = 8;
__host__ __device__ __forceinline__ int lds_byte(int r, int c) { const int st = (r >> 4) * 2 + (c >> 5), rr = r & 15, cc = c & 31, ob = rr * 64 + cc * 2; return st * 1024 + (ob ^ (((ob >> 9) & 1) << 5)); }
__host__ __device__ __forceinline__ void stage_rc(int b, int& R, int& C) { const int st = b / 1024, sb = b % 1024, swz = sb ^ (((sb >> 9) & 1) << 5); R = (st >> 1) * 16 + swz / 64; C = (st & 1) * 32 + (swz % 64) / 2; }
__host__ __device__ __forceinline__ int perm32(int rho) { const int n = rho >> 4, i = rho & 15; return 8 * (i >> 2) + 4 * n + (i & 3); }
struct Unit { int pm, pn, pb, e, i; };
struct StaticOrder {
    int nM, nN, nwg, G, c, reps;
    __host__ __device__ void init(int nM_, int nN_, int G_, int c_, int reps_ = 1) { nM = nM_; nN = nN_; nwg = nM * nN; G = G_; c = c_; reps = reps_; }
    __host__ __device__ bool next(int i, Unit& u) const {
        const long L = (long)i * G + c; if (L >= (long)nwg * reps) return false;
        int wgid = (int)(L % nwg); { const int q = nwg / NXCD, r = nwg % NXCD, xcd = wgid % NXCD, off = wgid / NXCD; wgid = (xcd < r ? xcd * (q + 1) : r * (q + 1) + (xcd - r) * q) + off; }
        const int nig = WGM * nN, gid = wgid / nig, fm = gid * WGM, gsz = (nM - fm) < WGM ? (nM - fm) : WGM;
        u.pm = fm + ((wgid % nig) % gsz); u.pn = (wgid % nig) / gsz; u.pb = u.pn; u.e = 0; u.i = i; return true;
    }
};
struct MoeOrder {
    StaticOrder so; const LAS int* tile_expert;
    __device__ bool next(int i, Unit& u) const { if (!so.next(i, u)) return false; u.e = __builtin_amdgcn_readfirstlane(tile_expert[u.pm]); u.pb = u.e * so.nN + u.pn; return true; }
};
struct TabOrder {
    const LAS int* tab; int n; int dup;
    __device__ bool next(int i, Unit& u) const { if (i >= (n << dup)) return false; const LAS int* p = tab + 4 * (i >> dup);
        u.pm = __builtin_amdgcn_readfirstlane(p[0]); u.pn = __builtin_amdgcn_readfirstlane(p[1]); u.pb = __builtin_amdgcn_readfirstlane(p[2]); u.e = __builtin_amdgcn_readfirstlane(p[3]); u.i = i >> dup; return true; }
};
constexpr int UCAP = 10;
typedef int i32x8 __attribute__((ext_vector_type(8)));
typedef int i32x4 __attribute__((ext_vector_type(4)));
template <class Epi, class Sched, bool ALIGN_EPI, bool FP8, int NPASS = 1>
__device__ __forceinline__ void gemm_phase(LAS unsigned char* lds, const void* A, const void* Bt, const int ldA, const int nt, const LAS unsigned short* rowidx, const Sched& S, const Epi& E) {
    const int tid = threadIdx.x, wid = __builtin_amdgcn_readfirstlane(tid >> 6), lane = tid & 63, wr = wid >> 2, wc = wid & 3, fr = lane & 15, fq = lane >> 4;
    unsigned voffB[2];
#pragma unroll
    for (int i = 0; i < 2; ++i) { int R, C; stage_rc(tid * 16 + i * 8192, R, C); const int Rb = Epi::PERM ? ((R & ~31) + perm32(R & 31)) : R; voffB[i] = (unsigned)(Rb * 128 + C * 2); }
    const size_t kstep = 32768, kstepA = rowidx ? (size_t)128 : (size_t)32768;
    const size_t hstep = 16384;
    const size_t tstep = (size_t)nt * 32768;
    const unsigned ldsw = (unsigned)wid * 1024u;
    const int aoff = lds_byte(wr * 64 + fr, fq * 8), boff = lds_byte(wc * 32 + fr, fq * 8);
#define PG8_SA(b, h) (((b) * 2 + (h)) * HTB)
#define PG8_SB(b, h) ((4 + (b) * 2 + (h)) * HTB)
#define PG8_STAGE(bufoff, gbase, voff) do { _Pragma("unroll") for (int _i = 0; _i < 2; ++_i) \
        __builtin_amdgcn_global_load_lds((const unsigned*)((const char*)(gbase) + (voff)[_i]), (LAS unsigned*)(lds + (bufoff) + ldsw + _i * 8192), 16, 0, 0); } while (0)
#define PG8_LDA(dst, b, h) do { _Pragma("unroll") for (int m = 0; m < 4; ++m) _Pragma("unroll") for (int k = 0; k < 2; ++k) dst[m][k] = *(const LAS bf16x8*)(lds + PG8_SA(b, h) + aoff + m * 2048 + k * 1024); } while (0)
#define PG8_LDB(dst, b, h) do { _Pragma("unroll") for (int n = 0; n < 2; ++n) _Pragma("unroll") for (int k = 0; k < 2; ++k) dst[n][k] = *(const LAS bf16x8*)(lds + PG8_SB(b, h) + boff + n * 2048 + k * 1024); } while (0)
#define PG8_F8(x) __builtin_shufflevector(__builtin_bit_cast(i32x4, (x)[0]), __builtin_bit_cast(i32x4, (x)[1]), 0, 1, 2, 3, 4, 5, 6, 7)
#define PG8_MMA(ai, bj, At, Bt_) do { __builtin_amdgcn_s_setprio(1); _Pragma("unroll") for (int m = 0; m < 4; ++m) _Pragma("unroll") for (int n = 0; n < 2; ++n) { \
        if constexpr (FP8) { const i32x8 _a = PG8_F8(Bt_[n]), _b = PG8_F8(At[m]); \
            asm volatile("v_mfma_scale_f32_16x16x128_f8f6f4 %0, %1, %2, %0, %3, %4 op_sel_hi:[0,0,0]" : "+v"(acc[ai][bj][m][n]) : "v"(_a), "v"(_b), "v"(sclW), "v"(sclX)); } \
        else { _Pragma("unroll") for (int k = 0; k < 2; ++k) acc[ai][bj][m][n] = __builtin_amdgcn_mfma_f32_16x16x32_bf16(Bt_[n][k], At[m][k], acc[ai][bj][m][n], 0, 0, 0); } } \
        __builtin_amdgcn_s_setprio(0); } while (0)
#define PG8_WAIT_V(n) asm volatile("s_waitcnt vmcnt(" #n ")" ::: "memory")
#define PG8_WAIT_L(n) asm volatile("s_waitcnt lgkmcnt(" #n ")" ::: "memory")
#define PG8_WAIT_VR(rx) do { if (rx) { if constexpr (Epi::NST == 16) PG8_WAIT_V(24); else if constexpr (Epi::NST == 8) PG8_WAIT_V(16); else PG8_WAIT_V(8); } else PG8_WAIT_V(8); } while (0)
#define PG8_BAR __builtin_amdgcn_s_barrier()
#define PG8_SCHED __builtin_amdgcn_sched_barrier(0)
#define PG8_AOFF(dst, u, uo) do { _Pragma("unroll") for (int _h = 0; _h < 2; ++_h) _Pragma("unroll") for (int _i = 0; _i < 2; ++_i) { int _R, _C; stage_rc(tid * 16 + _i * 8192, _R, _C); \
        dst[_h][_i] = rowidx ? (unsigned)((int)rowidx[(u).i * BM + _h * HALF + _R] * ldA + _C * 2) : (unsigned)(((u).pm * nt << 15) + ((_h * HALF + _R) << 7) + _C * 2); } } while (0)
    Unit cur, nxt; int ui = 0;
    if (!S.next(0, cur)) return;
    f32x4 acc[2][2][4][2];
#pragma unroll
    for (int a = 0; a < 2; ++a)
#pragma unroll
        for (int b = 0; b < 2; ++b)
#pragma unroll
            for (int m = 0; m < 4; ++m)
#pragma unroll
                for (int n = 0; n < 2; ++n) acc[a][b][m][n] = (f32x4){0.f, 0.f, 0.f, 0.f};
    bf16x8 At[4][2], B0[2][2], B1[2][2];
    int sclW = 0x7A7A7A7A, sclX = 0x7F7F7F7F;
    asm volatile("" : "+v"(sclW), "+v"(sclX));
    unsigned ca[2][2], na[2][2];
    PG8_AOFF(ca, cur, 0);
    const char* cA = (const char*)A; const char* cB = (const char*)Bt + (size_t)cur.pb * tstep;
    PG8_STAGE(PG8_SB(0, 0), cB, voffB); PG8_STAGE(PG8_SB(0, 1), cB + hstep, voffB); PG8_STAGE(PG8_SA(0, 0), cA, ca[0]); PG8_STAGE(PG8_SA(0, 1), cA, ca[1]);
    if (wr == 1) PG8_BAR;
    PG8_WAIT_V(2); PG8_BAR;
    PG8_STAGE(PG8_SB(1, 0), cB + kstep, voffB); PG8_STAGE(PG8_SA(1, 0), cA + kstepA, ca[0]); PG8_STAGE(PG8_SB(1, 1), cB + hstep + kstep, voffB);
    PG8_WAIT_V(6); PG8_BAR;
    for (;;) {
        const bool has_next = S.next(ui + 1, nxt);
        if (has_next) { PG8_AOFF(na, nxt, ui + 1); }
        else {
#pragma unroll
            for (int h = 0; h < 2; ++h)
#pragma unroll
                for (int i = 0; i < 2; ++i) na[h][i] = ca[h][i];
        }
        const char* nB = has_next ? (const char*)Bt + (size_t)nxt.pb * tstep : cB;
#pragma unroll 1
        for (int pass = 0; pass < NPASS; ++pass)
#pragma unroll 1
        for (int t = 0; t < nt; t += 2) {
            const bool lastp = (pass == NPASS - 1);
            const bool last = (t == nt - 2);
            const char* a1 = cA + (size_t)(t + 1) * kstepA;
            const char* a2 = last ? cA : cA + (size_t)(t + 2) * kstepA; const char* b2 = last ? (lastp ? nB : cB) : cB + (size_t)(t + 2) * kstep;
            const char* a3 = a2 + kstepA; const char* b3 = b2 + kstep;
            unsigned o2[2][2];
#pragma unroll
            for (int h = 0; h < 2; ++h)
#pragma unroll
                for (int i = 0; i < 2; ++i) o2[h][i] = (last && lastp) ? na[h][i] : ca[h][i];
            const bool relax = (Epi::NST > 0) && (t == 0) && (ui > 0) && (pass == 0);
            PG8_LDB(B0, 0, 0); PG8_LDB(B1, 0, 1); PG8_SCHED; PG8_LDA(At, 0, 0); PG8_STAGE(PG8_SA(1, 1), a1, ca[1]);
            PG8_WAIT_VR(relax); PG8_WAIT_L(0); PG8_BAR; PG8_MMA(0, 0, At, B0); PG8_MMA(0, 1, At, B1); PG8_BAR; PG8_SCHED;
            PG8_LDA(At, 0, 1); PG8_STAGE(PG8_SB(0, 0), b2, voffB); PG8_STAGE(PG8_SB(0, 1), b2 + hstep, voffB); PG8_STAGE(PG8_SA(0, 0), a2, o2[0]);
            PG8_WAIT_VR(relax); PG8_WAIT_L(0); PG8_BAR; PG8_MMA(1, 0, At, B0); PG8_MMA(1, 1, At, B1); PG8_BAR; PG8_SCHED;
            PG8_LDB(B0, 1, 0); PG8_LDB(B1, 1, 1); PG8_SCHED; PG8_LDA(At, 1, 0); PG8_STAGE(PG8_SA(0, 1), a2, o2[1]);
            PG8_WAIT_V(8); PG8_WAIT_L(0); PG8_BAR; PG8_MMA(0, 0, At, B0); PG8_MMA(0, 1, At, B1); PG8_BAR; PG8_SCHED;
            PG8_LDA(At, 1, 1); PG8_STAGE(PG8_SB(1, 0), b3, voffB); PG8_STAGE(PG8_SB(1, 1), b3 + hstep, voffB); PG8_STAGE(PG8_SA(1, 0), a3, o2[0]);
            PG8_WAIT_V(8); PG8_WAIT_L(0); PG8_BAR; PG8_MMA(1, 0, At, B0); PG8_MMA(1, 1, At, B1); PG8_BAR; PG8_SCHED;
        }
        if constexpr (ALIGN_EPI) { if (wr == 0) PG8_BAR; }
        if constexpr (FP8) asm volatile("s_nop 15\n\ts_nop 15" ::: "memory");
        if constexpr (NPASS > 1) {
#pragma unroll
            for (int a = 0; a < 2; ++a)
#pragma unroll
                for (int b = 0; b < 2; ++b)
#pragma unroll
                    for (int m = 0; m < 4; ++m)
#pragma unroll
                        for (int n = 0; n < 2; ++n) acc[a][b][m][n] *= (1.0f / NPASS);
        }
        E(acc, cur, wr, wc, fr, fq);
        if constexpr (((REPMASK >> 13) & 1) != 0) { asm volatile("" ::: "memory"); E(acc, cur, wr, wc, fr, fq); }
        if (!has_next) break;
#pragma unroll
        for (int a = 0; a < 2; ++a)
#pragma unroll
            for (int b = 0; b < 2; ++b)
#pragma unroll
                for (int m = 0; m < 4; ++m)
#pragma unroll
                    for (int n = 0; n < 2; ++n) acc[a][b][m][n] = (f32x4){0.f, 0.f, 0.f, 0.f};
        cur = nxt; cB = nB; ++ui;
#pragma unroll
        for (int h = 0; h < 2; ++h)
#pragma unroll
            for (int i = 0; i < 2; ++i) ca[h][i] = na[h][i];
        if constexpr (ALIGN_EPI) { if (wr == 1) PG8_BAR; }
    }
    PG8_WAIT_V(0);
    if constexpr (!ALIGN_EPI) { if (wr == 0) PG8_BAR; }
    PG8_BAR;
#undef PG8_SA
#undef PG8_SB
#undef PG8_STAGE
#undef PG8_LDA
#undef PG8_LDB
#undef PG8_MMA
#undef PG8_F8
#undef PG8_WAIT_V
#undef PG8_WAIT_L
#undef PG8_WAIT_VR
#undef PG8_BAR
#undef PG8_SCHED
#undef PG8_AOFF
}

struct EpiBf16 {
    static constexpr bool PERM = true; static constexpr int NST = 16;
    bf16_t* O; int ldc;
    __device__ __forceinline__ void operator()(const f32x4 (&acc)[2][2][4][2], const Unit& u, int wr, int wc, int fr, int fq) const {
        const int row0 = u.pm * BM + wr * 64 + fr, col0 = u.pn * BM + wc * 32 + 8 * fq;
#pragma unroll
        for (int ai = 0; ai < 2; ++ai)
#pragma unroll
            for (int m = 0; m < 4; ++m) { bf16_t* rowp = O + (size_t)(row0 + ai * HALF + m * 16) * ldc + col0;
#pragma unroll
                for (int bj = 0; bj < 2; ++bj) { const f32x4 v0 = acc[ai][bj][m][0], v1 = acc[ai][bj][m][1];
                    u32x4 w; w.x = cvt_pk_bf16(v0[0], v0[1]); w.y = cvt_pk_bf16(v0[2], v0[3]); w.z = cvt_pk_bf16(v1[0], v1[1]); w.w = cvt_pk_bf16(v1[2], v1[3]);
                    *(u32x4*)(rowp + bj * HALF) = w; } }
    }
};
struct EpiResBf16 {
    static constexpr bool PERM = true; static constexpr int NST = 0;
    const float* __restrict__ base; bf16_t* __restrict__ O; int ldc;
    __device__ __forceinline__ void operator()(const f32x4 (&acc)[2][2][4][2], const Unit& u, int wr, int wc, int fr, int fq) const {
        const int row0 = u.pm * BM + wr * 64 + fr, col0 = u.pn * BM + wc * 32 + 8 * fq;
#pragma unroll
        for (int ai = 0; ai < 2; ++ai)
#pragma unroll
            for (int mp = 0; mp < 2; ++mp) {
                f32x4 bs[2][2][2];
#pragma unroll
                for (int mm = 0; mm < 2; ++mm)
#pragma unroll
                    for (int bj = 0; bj < 2; ++bj)
#pragma unroll
                        for (int n = 0; n < 2; ++n) bs[mm][bj][n] = *(const f32x4*)(base + (size_t)(row0 + ai * HALF + (2 * mp + mm) * 16) * ldc + col0 + bj * HALF + 4 * n);
#pragma unroll
                for (int mm = 0; mm < 2; ++mm)
#pragma unroll
                    for (int bj = 0; bj < 2; ++bj) { const int m = 2 * mp + mm; const f32x4 v0 = acc[ai][bj][m][0] + bs[mm][bj][0], v1 = acc[ai][bj][m][1] + bs[mm][bj][1];
                        u32x4 w; w.x = cvt_pk_bf16(v0[0], v0[1]); w.y = cvt_pk_bf16(v0[2], v0[3]); w.z = cvt_pk_bf16(v1[0], v1[1]); w.w = cvt_pk_bf16(v1[2], v1[3]);
                        *(u32x4*)(O + (size_t)(row0 + ai * HALF + m * 16) * ldc + col0 + bj * HALF) = w; }
            }
    }
};
struct EpiSwiglu {
    static constexpr bool PERM = true; static constexpr int NST = 8;
    bf16_t* Hb; const LAS float* bias; const LAS float* rstd;
    __device__ __forceinline__ void operator()(const f32x4 (&acc)[2][2][4][2], const Unit& u, int wr, int wc, int fr, int fq) const {
        const int row0 = u.pm * BM + wr * 64 + fr, col0 = u.pn * HALF + wc * 32 + 8 * fq;
        const LAS float* bg = bias + u.i * 256 + wc * 32 + 8 * fq; const LAS float* bu = bg + 128;
        const f32x4 g0 = *(const LAS f32x4*)bg, g1 = *(const LAS f32x4*)(bg + 4), u0 = *(const LAS f32x4*)bu, u1 = *(const LAS f32x4*)(bu + 4);
        float rsv[2][4];
#pragma unroll
        for (int ai = 0; ai < 2; ++ai)
#pragma unroll
            for (int m = 0; m < 4; ++m) rsv[ai][m] = rstd[u.i * 256 + wr * 64 + fr + ai * HALF + m * 16];
#pragma unroll
        for (int ai = 0; ai < 2; ++ai)
#pragma unroll
            for (int m = 0; m < 4; ++m) {
                float r[8]; const float rs = rsv[ai][m];
#pragma unroll
                for (int n = 0; n < 2; ++n)
#pragma unroll
                    for (int j = 0; j < 4; ++j) {
                        float gt = acc[ai][0][m][n][j] * rs + (n ? g1[j] : g0[j]); float up = acc[ai][1][m][n][j] * rs + (n ? u1[j] : u0[j]);
                        gt = fminf(gt, 7.0f); up = fminf(fmaxf(up, -7.0f), 7.0f);
                        const float glu = gt * __builtin_amdgcn_rcpf(1.0f + __expf(-1.702f * gt));
                        r[n * 4 + j] = (up + 1.0f) * glu; }
                if constexpr (MOE_FP8) { u32x2 w; w.x = pk4_fp8(r[0], r[1], r[2], r[3]); w.y = pk4_fp8(r[4], r[5], r[6], r[7]);
                    *(u32x2*)((unsigned char*)Hb + tiled_off(row0 + ai * HALF + m * 16, col0, FF / 128)) = w; }
                else { u32x4 w; w.x = cvt_pk_bf16(r[0], r[1]); w.y = cvt_pk_bf16(r[2], r[3]); w.z = cvt_pk_bf16(r[4], r[5]); w.w = cvt_pk_bf16(r[6], r[7]);
                    *(u32x4*)((unsigned char*)Hb + tiled_off(row0 + ai * HALF + m * 16, 2 * col0, FF / 64)) = w; } }
    }
};
struct EpiDown {
    static constexpr bool PERM = true; static constexpr int NST = 16;
    bf16_t* Cb; const LAS float* bias; const LAS float* gate;
    __device__ __forceinline__ void operator()(const f32x4 (&acc)[2][2][4][2], const Unit& u, int wr, int wc, int fr, int fq) const {
        const int row0 = u.pm * BM + wr * 64 + fr, col0 = u.pn * BM + wc * 32 + 8 * fq;
        f32x4 bv[2][2]; float gtv[2][4];
#pragma unroll
        for (int bj = 0; bj < 2; ++bj)
#pragma unroll
            for (int n = 0; n < 2; ++n) bv[bj][n] = *(const LAS f32x4*)(bias + u.i * 256 + wc * 32 + 8 * fq + bj * HALF + 4 * n);
#pragma unroll
        for (int ai = 0; ai < 2; ++ai)
#pragma unroll
            for (int m = 0; m < 4; ++m) gtv[ai][m] = gate[u.i * 256 + wr * 64 + fr + ai * HALF + m * 16];
#pragma unroll
        for (int ai = 0; ai < 2; ++ai)
#pragma unroll
            for (int m = 0; m < 4; ++m) { const int row = row0 + ai * HALF + m * 16; const float gt = gtv[ai][m]; bf16_t* rowp = Cb + (size_t)row * D + col0;
#pragma unroll
                for (int bj = 0; bj < 2; ++bj) { const f32x4 v0 = (acc[ai][bj][m][0] + bv[bj][0]) * gt, v1 = (acc[ai][bj][m][1] + bv[bj][1]) * gt;
                    u32x4 w; w.x = cvt_pk_bf16(v0[0], v0[1]); w.y = cvt_pk_bf16(v0[2], v0[3]); w.z = cvt_pk_bf16(v1[0], v1[1]); w.w = cvt_pk_bf16(v1[2], v1[3]);
                    *(u32x4*)(rowp + bj * HALF) = w; } }
    }
};
}

struct Args { const float* in[16]; float* out; unsigned char* ws; int ph_lo, ph_hi, li, pad; };
struct Frame {
    LAS unsigned char* lds; int tid, lane, wave, G, bx;
    const float *x, *g_mix, *w_in, *conv_w, *w_gk_up, *b_gk_up, *gla_g, *w_out, *g_ffn, *w_router, *b_router, *w_gu, *b_gu, *w_dn, *b_dn, *g_fin;
    float* out; unsigned char* ws;
};

constexpr int TP = 68;
template <bool F8>
__device__ __forceinline__ void p0_tile(const float* W, int ldn, int K, int k0, int n0, void* WT, int drow0, LAS float* scr, int lane, float scale) {
    const float* src = W + (size_t)(k0 + (lane >> 4)) * ldn + n0 + 4 * (lane & 15);
    f32x4 v[16];
#pragma unroll
    for (int i = 0; i < 16; ++i) v[i] = *(const GAS f32x4*)(src + (size_t)(4 * i) * ldn);
#pragma unroll
    for (int i = 0; i < 16; ++i) *(LAS f32x4*)(scr + (4 * i + (lane >> 4)) * TP + 4 * (lane & 15)) = v[i];
    LDS_WAIT(); asm volatile("" ::: "memory");
    const LAS float* col = scr + lane;
    if constexpr (F8) {
        unsigned char* dst = (unsigned char*)WT + tiled_off(drow0 + lane, k0, K / 128);
#pragma unroll
        for (int q = 0; q < 4; ++q) { u32x4 o; unsigned w[4];
#pragma unroll
            for (int p = 0; p < 4; ++p) { const int kk = 16 * q + 4 * p; w[p] = pk4_fp8(col[kk * TP] * scale, col[(kk + 1) * TP] * scale, col[(kk + 2) * TP] * scale, col[(kk + 3) * TP] * scale); }
            o.x = w[0]; o.y = w[1]; o.z = w[2]; o.w = w[3]; *(GAS u32x4*)(dst + 16 * q) = o; }
    } else {
        bf16_t* dst = (bf16_t*)((unsigned char*)WT + tiled_off(drow0 + lane, 2 * k0, K / 64));
#pragma unroll
        for (int q = 0; q < 8; ++q) { u32x4 o; unsigned w[4];
#pragma unroll
            for (int p = 0; p < 4; ++p) { const int kk = 8 * q + 2 * p; w[p] = pk2(col[kk * TP], col[(kk + 1) * TP]); }
            o.x = w[0]; o.y = w[1]; o.z = w[2]; o.w = w[3]; *(GAS u32x4*)(dst + 8 * q) = o; }
    }
    LDS_WAIT(); asm volatile("" ::: "memory");
}
constexpr int W16P = 1032;
__device__ __forceinline__ void p0_prep(Frame& F) {
    LAS bf16_t* w16 = (LAS bf16_t*)F.lds;
    LAS float* part = (LAS float*)(F.lds + 16 * W16P * 2);
    for (int i = F.tid; i < 1024 * 16; i += NTHR) { const int k = i >> 4, r = i & 15; w16[r * W16P + k] = (bf16_t)f2bf(F.w_in[(size_t)k * DIN + C_GKL + r]); }
    __syncthreads();
    const int gw = F.bx * NWAVES + F.wave, NGW = F.G * NWAVES;
    bf16_t* XN = (bf16_t*)(F.ws + WS_XN); float* GKL = (float*)(F.ws + WS_GKL);
    { const int lane = F.lane, w = F.wave, fr = lane & 15, fq = lane >> 4, rt = w & 3, kh = w >> 2;
      for (int rep_a = 0; rep_a < 1 + ((REPMASK >> 11) & 1); ++rep_a)
      for (int grp = F.bx; grp < M / 64; grp += F.G) {
        const int m = grp * 64 + rt * 16 + fr;
        const float* xrow = F.x + (size_t)m * D + kh * 512 + 8 * fq; const float* grow = F.g_mix + kh * 512 + 8 * fq;
        f32x4 xv[16][2]; float s2 = 0.f; f32x4 c = (f32x4){0.f, 0.f, 0.f, 0.f};
#pragma unroll
        for (int s = 0; s < 16; ++s) { xv[s][0] = *(const f32x4*)(xrow + 32 * s); xv[s][1] = *(const f32x4*)(xrow + 32 * s + 4); }
#pragma unroll
        for (int s = 0; s < 16; ++s) {
            const f32x4 g0 = *(const f32x4*)(grow + 32 * s), g1 = *(const f32x4*)(grow + 32 * s + 4);
            const f32x4 x0 = xv[s][0], x1v = xv[s][1];
            s2 += (x0.x * x0.x + x0.y * x0.y) + (x0.z * x0.z + x0.w * x0.w) + (x1v.x * x1v.x + x1v.y * x1v.y) + (x1v.z * x1v.z + x1v.w * x1v.w);
            xv[s][0] = x0 * g0; xv[s][1] = x1v * g1;
            const u32x4 hv = {pk2(xv[s][0].x, xv[s][0].y), pk2(xv[s][0].z, xv[s][0].w), pk2(xv[s][1].x, xv[s][1].y), pk2(xv[s][1].z, xv[s][1].w)};
            const bf16x8 bb = *(const LAS bf16x8*)(w16 + fr * W16P + kh * 512 + 32 * s + 8 * fq);
            c = __builtin_amdgcn_mfma_f32_16x16x32_bf16(__builtin_bit_cast(bf16x8, hv), bb, c, 0, 0, 0);
        }
        s2 += __shfl_xor(s2, 16); s2 += __shfl_xor(s2, 32);
#pragma unroll
        for (int r = 0; r < 4; ++r) part[(kh * 64 + rt * 16 + 4 * fq + r) * 17 + fr] = c[r];
        if (fq == 0) part[(kh * 64 + rt * 16 + fr) * 17 + 16] = s2;
        __syncthreads();
        const int rowl = rt * 16 + fr;
        const float rstd = __builtin_amdgcn_rsqf((part[rowl * 17 + 16] + part[(64 + rowl) * 17 + 16]) * (1.0f / D) + RMS_EPS);
#pragma unroll
        for (int s = 0; s < 16; ++s) { const f32x4 a = xv[s][0] * rstd, b = xv[s][1] * rstd;
            const u32x4 o = {pk2(a.x, a.y), pk2(a.z, a.w), pk2(b.x, b.y), pk2(b.z, b.w)};
            *(GAS u32x4*)((unsigned char*)XN + tiled_off(m, 2 * (kh * 512 + 32 * s + 8 * fq), D / 64)) = o; }
        if (F.tid < 64) { const int row = F.tid; const float rs = __builtin_amdgcn_rsqf((part[row * 17 + 16] + part[(64 + row) * 17 + 16]) * (1.0f / D) + RMS_EPS);
#pragma unroll
            for (int q = 0; q < 4; ++q) { f32x4 o;
#pragma unroll
                for (int j = 0; j < 4; ++j) o[j] = (part[row * 17 + 4 * q + j] + part[(64 + row) * 17 + 4 * q + j]) * rs;
                *(f32x4*)(GKL + (size_t)(grp * 64 + row) * 16 + 4 * q) = o; } }
        __syncthreads();
      }
    }
    __syncthreads();
    LAS float* scr = (LAS float*)(F.lds + F.wave * (64 * TP * 4));
    constexpr int I_1 = (D / 64) * (NPROJ / 64), I_O = (D / 64) * (D / 64), I_GU = (D / 64) * (2 * FF / 64), I_DN = (FF / 64) * (D / 64);
    constexpr int NITEMS = I_1 + I_O + NE * (I_GU + I_DN);
    bf16_t* W1T = (bf16_t*)(F.ws + WS_W1T); bf16_t* WOT = (bf16_t*)(F.ws + WS_WOT); unsigned char* WGUT = F.ws + WS_WGUT; unsigned char* WDT = F.ws + WS_WDT;
    constexpr int ES = MOE_FP8 ? 1 : 2;
    for (int rep_b = 0; rep_b < 1 + ((REPMASK >> 12) & 1); ++rep_b)
    for (int it = gw; it < NITEMS; it += NGW) {
        int r = it;
        if (r < I_1) { const int nblk = NPROJ / 64, kb = r / nblk, nb = r % nblk; p0_tile<false>(F.w_in, DIN, D, 64 * kb, 64 * nb, W1T, 64 * nb, scr, F.lane, 1.0f); continue; } r -= I_1;
        if (r < I_O) { const int nblk = D / 64, kb = r / nblk, nb = r % nblk; p0_tile<false>(F.w_out, D, D, 64 * kb, 64 * nb, WOT, 64 * nb, scr, F.lane, 1.0f); continue; } r -= I_O;
        const int e = r / (I_GU + I_DN); r -= e * (I_GU + I_DN);
        if (r < I_GU) { const int nblk = 2 * FF / 64, kb = r / nblk, nb = r % nblk; const int n0 = 64 * nb, half = n0 / FF, j = n0 % FF, pn = j / 128, i0 = j % 128;
            p0_tile<MOE_FP8 != 0>(F.w_gu + (size_t)e * D * 2 * FF, 2 * FF, D, 64 * kb, n0, WGUT + (size_t)e * 2 * FF * D * ES, pn * 256 + half * 128 + i0, scr, F.lane, MOE_FP8 ? 32.0f : 1.0f); continue; } r -= I_GU;
        { const int nblk = D / 64, kb = r / nblk, nb = r % nblk;
          p0_tile<MOE_FP8 != 0>(F.w_dn + (size_t)e * FF * D, D, FF, 64 * kb, 64 * nb, WDT + (size_t)e * D * FF * ES, 64 * nb, scr, F.lane, MOE_FP8 ? 32.0f : 1.0f); }
    }
}

struct GlaIn { f32x4 gl[4]; u32x4 q, k, v0, v1, g0, g1; };
template <bool OUT>
__device__ __forceinline__ void gla_load(Frame& F, int u, GlaIn& L) {
    const bf16_t* PROJ = (const bf16_t*)(F.ws + WS_PROJ); const float* GKL = (const float*)(F.ws + WS_GKL);
    const int b = u / (NH * NCH), h = (u / NCH) % NH, n = u % NCH, tok0 = b * SEQ + n * CHUNK, tok = tok0 + F.lane, w = F.wave;
#pragma unroll
    for (int q = 0; q < 4; ++q) L.gl[q] = *(const f32x4*)(GKL + (size_t)tok * 16 + 4 * q);
    L.k = *(const u32x4*)(PROJ + (size_t)tok * NPROJ + C_K + h * DK + 8 * w);
    L.v0 = *(const u32x4*)(PROJ + (size_t)tok * NPROJ + C_V + h * DV + 16 * w); L.v1 = *(const u32x4*)(PROJ + (size_t)tok * NPROJ + C_V + h * DV + 16 * w + 8);
    if constexpr (OUT) {
        L.q = *(const u32x4*)(PROJ + (size_t)tok * NPROJ + C_Q + h * DK + 8 * w);
        const bf16_t* gp = PROJ + (size_t)(tok0 + (F.tid >> 3)) * NPROJ + C_G + h * DV + 16 * (F.tid & 7);
        L.g0 = *(const u32x4*)gp; L.g1 = *(const u32x4*)(gp + 8);
    }
}
constexpr int WGK_OFF = 81920;
__device__ __forceinline__ void gla_stage_wgk(Frame& F) {
    LAS float* wgk = (LAS float*)(F.lds + WGK_OFF);
    for (int i = F.tid; i < 17 * 256; i += NTHR) wgk[i] = i < 16 * 256 ? F.w_gk_up[i] : F.b_gk_up[i - 16 * 256];
    __syncthreads();
}
__device__ __forceinline__ void gla_decay(Frame& F, const GlaIn& L, int h, float (&bc)[8], float (&blast)[8]) {
    const LAS float* wgk = (const LAS float*)(F.lds + WGK_OFF);
    const float gl[16] = {L.gl[0].x, L.gl[0].y, L.gl[0].z, L.gl[0].w, L.gl[1].x, L.gl[1].y, L.gl[1].z, L.gl[1].w, L.gl[2].x, L.gl[2].y, L.gl[2].z, L.gl[2].w, L.gl[3].x, L.gl[3].y, L.gl[3].z, L.gl[3].w};
    const int dbase = h * DK + 8 * F.wave;
#pragma unroll
    for (int i = 0; i < 8; ++i) {
        float gk = wgk[16 * 256 + dbase + i];
#pragma unroll
        for (int r = 0; r < 16; ++r) gk += gl[r] * wgk[r * (NH * DK) + dbase + i];
        float la = log_sigmoidf_(gk) * (1.0f / 16.0f);
        la = wave_incl_scan(la);
        bc[i] = la; blast[i] = __builtin_bit_cast(float, __builtin_amdgcn_readlane(__builtin_bit_cast(int, la), 63));
        asm volatile("" ::: "memory");
    }
}

constexpr int LP = 72;
__device__ __forceinline__ void p2_gla_kv(Frame& F) {
    float* KVT = (float*)(F.ws + WS_KVT); float* DEC = (float*)(F.ws + WS_DEC);
    LAS bf16_t* kremT = (LAS bf16_t*)F.lds;
    LAS bf16_t* vT = (LAS bf16_t*)(F.lds + 64 * LP * 2);
    const int lane = F.lane, w = F.wave;
    gla_stage_wgk(F);
    GlaIn cur, nxt;
    if (F.bx < NUNITS_GLA) gla_load<false>(F, F.bx, cur);
    for (int u = F.bx; u < NUNITS_GLA; u += F.G) {
        if (u + F.G < NUNITS_GLA) gla_load<false>(F, u + F.G, nxt);
        const int h = (u / NCH) % NH;
        float bc[8], blast[8];
        gla_decay(F, cur, h, bc, blast);
        const unsigned kw[4] = {cur.k.x, cur.k.y, cur.k.z, cur.k.w};
#pragma unroll
        for (int i = 0; i < 8; ++i) { const float kv = (i & 1) ? bfhi(kw[i >> 1]) : bflo(kw[i >> 1]);
            kremT[(8 * w + i) * LP + lane] = (bf16_t)f2bf(kv * __expf(blast[i] - bc[i])); }
        if (lane == 0) {
#pragma unroll
            for (int i = 0; i < 8; ++i) DEC[(size_t)u * DK + 8 * w + i] = __expf(blast[i]);
        }
        { const unsigned vw[8] = {cur.v0.x, cur.v0.y, cur.v0.z, cur.v0.w, cur.v1.x, cur.v1.y, cur.v1.z, cur.v1.w};
#pragma unroll
          for (int i = 0; i < 16; ++i) vT[(16 * w + i) * LP + lane] = (bf16_t)((i & 1) ? (vw[i >> 1] >> 16) : (vw[i >> 1] & 0xffffu)); }
        __syncthreads();
        const int fr = lane & 15, fq = lane >> 4;
        bf16x8 a[2];
#pragma unroll
        for (int s = 0; s < 2; ++s) a[s] = *(const LAS bf16x8*)(vT + (16 * w + fr) * LP + 8 * fq + 32 * s);
#pragma unroll
        for (int dt = 0; dt < 4; ++dt) {
            f32x4 c = (f32x4){0.f, 0.f, 0.f, 0.f};
#pragma unroll
            for (int s = 0; s < 2; ++s) { const bf16x8 bb = *(const LAS bf16x8*)(kremT + (16 * dt + fr) * LP + 8 * fq + 32 * s); c = __builtin_amdgcn_mfma_f32_16x16x32_bf16(a[s], bb, c, 0, 0, 0); }
#pragma unroll
            for (int r = 0; r < 4; ++r) KVT[((size_t)u * DV + 16 * w + 4 * fq + r) * DK + 16 * dt + fr] = c[r];
        }
        __syncthreads();
        cur.gl[0] = nxt.gl[0]; cur.gl[1] = nxt.gl[1]; cur.gl[2] = nxt.gl[2]; cur.gl[3] = nxt.gl[3]; cur.k = nxt.k; cur.v0 = nxt.v0; cur.v1 = nxt.v1;
    }
}

__device__ __forceinline__ void p3_scan(Frame& F) {
    const float* KVT = (const float*)(F.ws + WS_KVT); const float* DEC = (const float*)(F.ws + WS_DEC); bf16_t* ST = (bf16_t*)(F.ws + WS_ST);
    for (int gid = F.bx * NTHR + F.tid; gid < BATCH * NH * DV * DK; gid += F.G * NTHR) {
        const int bh = gid >> 13, vd = gid & 8191, d = gid & 63;
        float S = 0.f;
#pragma unroll 8
        for (int n = 0; n < NCH; ++n) { const size_t u = (size_t)bh * NCH + n;
            ST[u * (DV * DK) + vd] = (bf16_t)f2bf(S);
            S = DEC[u * DK + d] * S + KVT[u * (DV * DK) + vd]; }
    }
}

constexpr int OTP = 132;
__device__ __forceinline__ void p4_gla_out(Frame& F) {
    const bf16_t* PROJ = (const bf16_t*)(F.ws + WS_PROJ); bf16_t* Y = (bf16_t*)(F.ws + WS_Y);
    LAS bf16_t* qd = (LAS bf16_t*)F.lds;
    LAS bf16_t* kd = (LAS bf16_t*)(F.lds + 64 * LP * 2);
    LAS bf16_t* vT = (LAS bf16_t*)(F.lds + 2 * 64 * LP * 2);
    LAS bf16_t* pm = (LAS bf16_t*)(F.lds + 4 * 64 * LP * 2);
    LAS float* red = (LAS float*)(F.lds + 5 * 64 * LP * 2);
    LAS float* ot = (LAS float*)(F.lds + 5 * 64 * LP * 2 + 512);
    const int lane = F.lane, w = F.wave, fr = lane & 15, fq = lane >> 4;
    const int ct = w & 3, vt0 = 4 * (w >> 2);
    float gng[4];
#pragma unroll
    for (int vi = 0; vi < 4; ++vi) gng[vi] = F.gla_g[16 * (vt0 + vi) + fr];
    gla_stage_wgk(F);
    GlaIn cur, nxt;
    for (int rep_g = 0; rep_g < 1 + ((REPMASK >> 20) & 1); ++rep_g) {
    if (F.bx < NUNITS_GLA) gla_load<true>(F, F.bx, cur);
    for (int u = F.bx; u < NUNITS_GLA; u += F.G) {
        if (u + F.G < NUNITS_GLA) gla_load<true>(F, u + F.G, nxt);
        const int b = u / (NH * NCH), h = (u / NCH) % NH, n = u % NCH;
        const int tok0 = b * SEQ + n * CHUNK;
        bf16x8 stf[4][2];
        { const bf16_t* ST = (const bf16_t*)(F.ws + WS_ST);
#pragma unroll
          for (int vi = 0; vi < 4; ++vi)
#pragma unroll
              for (int s = 0; s < 2; ++s) stf[vi][s] = *(const bf16x8*)(ST + ((size_t)u * DV + 16 * (vt0 + vi) + fr) * DK + 8 * fq + 32 * s); }
        float bc[8], blast[8];
        gla_decay(F, cur, h, bc, blast);
        { const unsigned qw[4] = {cur.q.x, cur.q.y, cur.q.z, cur.q.w}, kw[4] = {cur.k.x, cur.k.y, cur.k.z, cur.k.w};
          u32x4 qo, ko; unsigned qq[4], kk[4];
#pragma unroll
          for (int p = 0; p < 4; ++p) { const float e0 = __expf(bc[2 * p]), e1 = __expf(bc[2 * p + 1]);
              qq[p] = pk2(bflo(qw[p]) * 0.125f * e0, bfhi(qw[p]) * 0.125f * e1);
              kk[p] = pk2(bflo(kw[p]) * __expf(-bc[2 * p]), bfhi(kw[p]) * __expf(-bc[2 * p + 1])); }
          qo.x = qq[0]; qo.y = qq[1]; qo.z = qq[2]; qo.w = qq[3]; ko.x = kk[0]; ko.y = kk[1]; ko.z = kk[2]; ko.w = kk[3];
          *(LAS u32x4*)(qd + lane * LP + 8 * w) = qo; *(LAS u32x4*)(kd + lane * LP + 8 * w) = ko; }
        { const unsigned vw[8] = {cur.v0.x, cur.v0.y, cur.v0.z, cur.v0.w, cur.v1.x, cur.v1.y, cur.v1.z, cur.v1.w};
#pragma unroll
          for (int i = 0; i < 16; ++i) vT[(16 * w + i) * LP + lane] = (bf16_t)((i & 1) ? (vw[i >> 1] >> 16) : (vw[i >> 1] & 0xffffu)); }
        __syncthreads();
        { const int cts = w >> 1;
          bf16x8 a[2];
#pragma unroll
          for (int s = 0; s < 2; ++s) a[s] = *(const LAS bf16x8*)(qd + (16 * cts + fr) * LP + 8 * fq + 32 * s);
#pragma unroll
          for (int jj = 0; jj < 2; ++jj) { const int jt = 2 * (w & 1) + jj;
              f32x4 c = (f32x4){0.f, 0.f, 0.f, 0.f};
#pragma unroll
              for (int s = 0; s < 2; ++s) { const bf16x8 bb = *(const LAS bf16x8*)(kd + (16 * jt + fr) * LP + 8 * fq + 32 * s); c = __builtin_amdgcn_mfma_f32_16x16x32_bf16(a[s], bb, c, 0, 0, 0); }
#pragma unroll
              for (int r = 0; r < 4; ++r) { const int cc = 16 * cts + 4 * fq + r, jcol = 16 * jt + fr; pm[cc * LP + jcol] = (bf16_t)f2bf(jcol <= cc ? c[r] : 0.f); } } }
        __syncthreads();
        bf16x8 ap[2], aq[2];
#pragma unroll
        for (int s = 0; s < 2; ++s) { ap[s] = *(const LAS bf16x8*)(pm + (16 * ct + fr) * LP + 8 * fq + 32 * s); aq[s] = *(const LAS bf16x8*)(qd + (16 * ct + fr) * LP + 8 * fq + 32 * s); }
        f32x4 o[4]; float ss[4] = {0.f, 0.f, 0.f, 0.f};
#pragma unroll
        for (int vi = 0; vi < 4; ++vi) { const int vt = vt0 + vi;
            f32x4 c = (f32x4){0.f, 0.f, 0.f, 0.f};
#pragma unroll
            for (int s = 0; s < 2; ++s) { const bf16x8 bb = *(const LAS bf16x8*)(vT + (16 * vt + fr) * LP + 8 * fq + 32 * s); c = __builtin_amdgcn_mfma_f32_16x16x32_bf16(ap[s], bb, c, 0, 0, 0); }
#pragma unroll
            for (int s = 0; s < 2; ++s) c = __builtin_amdgcn_mfma_f32_16x16x32_bf16(aq[s], stf[vi][s], c, 0, 0, 0);
            o[vi] = c;
#pragma unroll
            for (int r = 0; r < 4; ++r) ss[r] += c[r] * c[r]; }
#pragma unroll
        for (int r = 0; r < 4; ++r) ss[r] = row16_sum(ss[r]);
        if (fr == 0) {
#pragma unroll
            for (int r = 0; r < 4; ++r) red[w * 16 + 4 * fq + r] = ss[r];
        }
        __syncthreads();
#pragma unroll
        for (int r = 0; r < 4; ++r) { const float tot = red[ct * 16 + 4 * fq + r] + red[(ct + 4) * 16 + 4 * fq + r]; const float rstd = __builtin_amdgcn_rsqf(tot * (1.0f / DV) + RMS_EPS);
#pragma unroll
            for (int vi = 0; vi < 4; ++vi) ot[(16 * ct + 4 * fq + r) * OTP + 16 * (vt0 + vi) + fr] = o[vi][r] * rstd * gng[vi]; }
        __syncthreads();
        { const int c = F.tid >> 3, sg = F.tid & 7; const LAS float* op = ot + c * OTP + 16 * sg;
          const unsigned gw[8] = {cur.g0.x, cur.g0.y, cur.g0.z, cur.g0.w, cur.g1.x, cur.g1.y, cur.g1.z, cur.g1.w};
          unsigned ow[8];
#pragma unroll
          for (int q = 0; q < 4; ++q) { const f32x4 ov = *(const LAS f32x4*)(op + 4 * q);
              const float ga = bflo(gw[2 * q]), gb = bfhi(gw[2 * q]), gc = bflo(gw[2 * q + 1]), gd = bfhi(gw[2 * q + 1]);
              ow[2 * q] = pk2(ov.x * (ga * sigmoidf_(ga)), ov.y * (gb * sigmoidf_(gb))); ow[2 * q + 1] = pk2(ov.z * (gc * sigmoidf_(gc)), ov.w * (gd * sigmoidf_(gd))); }
          unsigned char* yp = (unsigned char*)Y + tiled_off(tok0 + c, 2 * (CONVW + h * DV + 16 * sg), D / 64);
          *(u32x4*)yp = (u32x4){ow[0], ow[1], ow[2], ow[3]}; *(u32x4*)(yp + 16) = (u32x4){ow[4], ow[5], ow[6], ow[7]}; }
        __syncthreads();
        cur = nxt;
    }
    }
    for (int rep_c = 0; rep_c < 1 + ((REPMASK >> 21) & 1); ++rep_c)
    for (int it = F.bx * NTHR + F.tid; it < M * (CONVW / 8); it += F.G * NTHR) {
        const int t = it >> 6, c8 = (it & 63) * 8, s = t & (SEQ - 1);
        float acc[8];
#pragma unroll
        for (int j = 0; j < 8; ++j) acc[j] = 0.f;
#pragma unroll
        for (int i = 0; i < 3; ++i) { const int sp = s - 2 + i; if (sp < 0) continue;
            const size_t ro = (size_t)(t - 2 + i) * NPROJ;
            const u32x4 uh = *(const u32x4*)(PROJ + ro + C_UH + c8), gc = *(const u32x4*)(PROJ + ro + C_GC + c8);
            const unsigned uw[4] = {uh.x, uh.y, uh.z, uh.w}, gw[4] = {gc.x, gc.y, gc.z, gc.w};
            const f32x4 w0 = *(const f32x4*)(F.conv_w + i * CONVW + c8), w1 = *(const f32x4*)(F.conv_w + i * CONVW + c8 + 4);
            const float ww[8] = {w0.x, w0.y, w0.z, w0.w, w1.x, w1.y, w1.z, w1.w};
#pragma unroll
            for (int p = 0; p < 4; ++p) { acc[2 * p] += ww[2 * p] * (bflo(uw[p]) * bflo(gw[p])); acc[2 * p + 1] += ww[2 * p + 1] * (bfhi(uw[p]) * bfhi(gw[p])); } }
        const u32x4 gb = *(const u32x4*)(PROJ + (size_t)t * NPROJ + C_GB + c8); const unsigned bw[4] = {gb.x, gb.y, gb.z, gb.w};
        u32x4 o;
        o.x = pk2(bflo(bw[0]) * acc[0], bfhi(bw[0]) * acc[1]); o.y = pk2(bflo(bw[1]) * acc[2], bfhi(bw[1]) * acc[3]);
        o.z = pk2(bflo(bw[2]) * acc[4], bfhi(bw[2]) * acc[5]); o.w = pk2(bflo(bw[3]) * acc[6], bfhi(bw[3]) * acc[7]);
        *(u32x4*)((unsigned char*)Y + tiled_off(t, 2 * c8, D / 64)) = o;
    }
}

constexpr int WRP = 1032;
__device__ __forceinline__ void p6_router(Frame& F) {
    LAS bf16_t* wh = (LAS bf16_t*)F.lds;
    LAS bf16_t* wl = (LAS bf16_t*)(F.lds + 32 * WRP * 2);
    LAS float* lgp = (LAS float*)(F.lds + 2 * 32 * WRP * 2);
    LAS int* hist = (LAS int*)(F.lds + 2 * 32 * WRP * 2 + 2 * 64 * 33 * 4);
    const bf16_t* X1 = (const bf16_t*)(F.ws + WS_X1); bf16_t* XB = (bf16_t*)(F.ws + WS_XN); float* RSTD = (float*)(F.ws + WS_ROUTE + R_RSTD);
    int* TOPI = (int*)(F.ws + WS_ROUTE + R_TOPI); float* TOPG = (float*)(F.ws + WS_ROUTE + R_TOPG); int* HIST = (int*)(F.ws + WS_ROUTE + R_HIST);
    for (int i = F.tid; i < 1024 * 32; i += NTHR) { const int k = i >> 5, e = i & 31; const float wv = F.w_router[i]; const unsigned h = f2bf(wv); const float hf = __builtin_bit_cast(float, h << 16);
        wh[e * WRP + k] = (bf16_t)h; wl[e * WRP + k] = (bf16_t)f2bf(wv - hf); }
    const int lane = F.lane, w = F.wave, fr = lane & 15, fq = lane >> 4, rt = w & 3, kh = w >> 2;
    for (int wg = F.bx; wg < M / 64; wg += F.G) {
        if (F.tid < 32) hist[F.tid] = 0;
        __syncthreads();
        const int m = wg * 64 + rt * 16 + fr;
        const bf16_t* xrow = X1 + (size_t)m * D + kh * 512 + 8 * fq;
        bf16_t* orow = XB + (size_t)m * D + kh * 512 + 8 * fq;
        const float* grow = F.g_ffn + kh * 512 + 8 * fq;
        f32x4 c0 = (f32x4){0.f, 0.f, 0.f, 0.f}, c1 = c0; float s2 = 0.f;
#pragma unroll 4
        for (int s = 0; s < 16; ++s) {
            const u32x4 xr8 = *(const u32x4*)(xrow + 32 * s);
            const f32x4 x0 = {bflo(xr8.x), bfhi(xr8.x), bflo(xr8.y), bfhi(xr8.y)}, x1v = {bflo(xr8.z), bfhi(xr8.z), bflo(xr8.w), bfhi(xr8.w)};
            const f32x4 g0 = *(const f32x4*)(grow + 32 * s), g1 = *(const f32x4*)(grow + 32 * s + 4);
            s2 += (x0.x * x0.x + x0.y * x0.y) + (x0.z * x0.z + x0.w * x0.w) + (x1v.x * x1v.x + x1v.y * x1v.y) + (x1v.z * x1v.z + x1v.w * x1v.w);
            const float xg[8] = {x0.x * g0.x, x0.y * g0.y, x0.z * g0.z, x0.w * g0.w, x1v.x * g1.x, x1v.y * g1.y, x1v.z * g1.z, x1v.w * g1.w};
            unsigned hw[4], lw[4];
#pragma unroll
            for (int p = 0; p < 4; ++p) { const unsigned h0 = f2bf(xg[2 * p]), h1 = f2bf(xg[2 * p + 1]);
                hw[p] = h0 | (h1 << 16);
                lw[p] = pk2(xg[2 * p] - __builtin_bit_cast(float, h0 << 16), xg[2 * p + 1] - __builtin_bit_cast(float, h1 << 16)); }
            const u32x4 hv = {hw[0], hw[1], hw[2], hw[3]}, lv = {lw[0], lw[1], lw[2], lw[3]};
            if constexpr (MOE_FP8) { u32x2 f8; f8.x = pk4_fp8(xg[0], xg[1], xg[2], xg[3]); f8.y = pk4_fp8(xg[4], xg[5], xg[6], xg[7]); *(u32x2*)((unsigned char*)XB + (size_t)m * D + kh * 512 + 8 * fq + 32 * s) = f8; }
            else *(u32x4*)(orow + 32 * s) = hv;
            const bf16x8 ah = __builtin_bit_cast(bf16x8, hv), al = __builtin_bit_cast(bf16x8, lv);
            const int kk = kh * 512 + 32 * s + 8 * fq;
            const bf16x8 bh0 = *(const LAS bf16x8*)(wh + fr * WRP + kk), bh1 = *(const LAS bf16x8*)(wh + (16 + fr) * WRP + kk);
            const bf16x8 bl0 = *(const LAS bf16x8*)(wl + fr * WRP + kk), bl1 = *(const LAS bf16x8*)(wl + (16 + fr) * WRP + kk);
            c0 = __builtin_amdgcn_mfma_f32_16x16x32_bf16(ah, bh0, c0, 0, 0, 0); c1 = __builtin_amdgcn_mfma_f32_16x16x32_bf16(ah, bh1, c1, 0, 0, 0);
            c0 = __builtin_amdgcn_mfma_f32_16x16x32_bf16(al, bh0, c0, 0, 0, 0); c1 = __builtin_amdgcn_mfma_f32_16x16x32_bf16(al, bh1, c1, 0, 0, 0);
            c0 = __builtin_amdgcn_mfma_f32_16x16x32_bf16(ah, bl0, c0, 0, 0, 0); c1 = __builtin_amdgcn_mfma_f32_16x16x32_bf16(ah, bl1, c1, 0, 0, 0);
        }
        s2 += __shfl_xor(s2, 16); s2 += __shfl_xor(s2, 32);
#pragma unroll
        for (int r = 0; r < 4; ++r) { LAS float* dst = lgp + (kh * 64 + rt * 16 + 4 * fq + r) * 33; dst[fr] = c0[r]; dst[16 + fr] = c1[r]; }
        if (fq == 0) lgp[(kh * 64 + rt * 16 + fr) * 33 + 32] = s2;
        __syncthreads();
        if (F.tid < 64) {
            const int row = F.tid, mm = wg * 64 + row;
            const LAS float* p0 = lgp + row * 33; const LAS float* p1 = lgp + (64 + row) * 33;
            const float rstd = 1.0f / sqrtf((p0[32] + p1[32]) * (1.0f / D) + RMS_EPS);
            float l[32];
#pragma unroll
            for (int e = 0; e < 32; ++e) l[e] = (p0[e] + p1[e]) * rstd + F.b_router[e];
            int bi[4]; float bv[4]; unsigned used = 0u;
#pragma unroll
            for (int k = 0; k < 4; ++k) { float best = -3.0e38f; int be = 0;
#pragma unroll
                for (int e = 0; e < 32; ++e) { const bool ok = !((used >> e) & 1u) && l[e] > best; best = ok ? l[e] : best; be = ok ? e : be; }
                used |= 1u << be; bi[k] = be; bv[k] = best; }
            const float e1 = __expf(bv[1] - bv[0]), e2 = __expf(bv[2] - bv[0]), e3 = __expf(bv[3] - bv[0]); const float inv = 1.0f / (1.0f + e1 + e2 + e3);
            *(int4*)(TOPI + (size_t)mm * 4) = make_int4(bi[0], bi[1], bi[2], bi[3]);
            *(f32x4*)(TOPG + (size_t)mm * 4) = (f32x4){inv, e1 * inv, e2 * inv, e3 * inv};
            RSTD[mm] = rstd;
#pragma unroll
            for (int k = 0; k < 4; ++k) atomicAdd((int*)&hist[bi[k]], 1);
        }
        __syncthreads();
        if (F.tid < 32) HIST[wg * 32 + F.tid] = hist[F.tid];
        __syncthreads();
    }
}

__device__ __forceinline__ void p7_slots(Frame& F) {
    LAS int* part = (LAS int*)F.lds;
    LAS int* cnt = part + 1024;
    LAS int* pre = cnt + 32;
    LAS int* pst = pre + 32;
    LAS int* exa = pst + 64;
    const int* TOPI = (const int*)(F.ws + WS_ROUTE + R_TOPI); const float* TOPG = (const float*)(F.ws + WS_ROUTE + R_TOPG); const int* HIST = (const int*)(F.ws + WS_ROUTE + R_HIST);
    int* POS = (int*)(F.ws + WS_ROUTE + R_POS); int* ROWTOK = (int*)(F.ws + WS_ROUTE + R_ROWTOK); float* ROWGATE = (float*)(F.ws + WS_ROUTE + R_ROWGATE); int* META = (int*)(F.ws + WS_ROUTE + R_META);
    const float* RSTD = (const float*)(F.ws + WS_ROUTE + R_RSTD); float* ROWRSTD = (float*)(F.ws + WS_ROUTE + R_ROWRSTD);
    constexpr int NWG = M / 64;
    for (int wg = F.bx; wg < NWG; wg += F.G) {
        { const int e = F.tid & 31, p = F.tid >> 5; int tot = 0, bef = 0;
          for (int q = p * 16; q < p * 16 + 16; ++q) { const int hv = HIST[q * 32 + e]; tot += hv; bef += (q < wg) ? hv : 0; }
          part[(p * 32 + e) * 2] = tot; part[(p * 32 + e) * 2 + 1] = bef; }
        __syncthreads();
        if (F.tid < 32) { int tot = 0, bef = 0; for (int p = 0; p < 16; ++p) { tot += part[(p * 32 + F.tid) * 2]; bef += part[(p * 32 + F.tid) * 2 + 1]; } cnt[F.tid] = tot; pre[F.tid] = bef; }
        __syncthreads();
        if (F.tid == 0) { int s = 0; for (int e = 0; e < 32; ++e) { pst[e] = s; s += (cnt[e] + 255) & ~255; } pst[32] = s; }
        int my_e = 0, tokn = 0, kk = 0; float my_g = 0.f;
        if (F.tid < 256) { tokn = wg * 64 + (F.tid >> 2); kk = F.tid & 3; my_e = TOPI[(size_t)tokn * 4 + kk]; my_g = TOPG[(size_t)tokn * 4 + kk]; exa[F.tid] = my_e; }
        __syncthreads();
        if (F.tid < 256) { int rank = 0; for (int a = 0; a < F.tid; ++a) rank += (exa[a] == my_e) ? 1 : 0;
            const int slot = pst[my_e] + pre[my_e] + rank;
            ROWTOK[slot] = tokn; ROWGATE[slot] = my_g; ROWRSTD[slot] = RSTD[tokn]; POS[(size_t)tokn * 4 + kk] = slot; }
        if (wg < NE) { const int e = wg, c = cnt[e], s0 = pst[e] + c, s1 = pst[e] + ((c + 255) & ~255);
            for (int s = s0 + F.tid; s < s1; s += NTHR) { ROWTOK[s] = 0; ROWGATE[s] = 0.f; ROWRSTD[s] = 0.f; } }
        if (wg == 0) { if (F.tid == 0) META[0] = pst[32] >> 8;
            for (int t = F.tid; t < NTILES_MAX; t += NTHR) { int e = 0; for (int q = 0; q < 32; ++q) e += (t * 256 >= pst[q + 1]) ? 1 : 0; META[32 + t] = e < 32 ? e : 31; } }
        __syncthreads();
    }
}

__device__ __forceinline__ void p10_combine(Frame& F) {
    const bf16_t* X1 = (const bf16_t*)(F.ws + WS_X1); const bf16_t* CB = (const bf16_t*)(F.ws + WS_CONTRIB); const int* POS = (const int*)(F.ws + WS_ROUTE + R_POS);
    const int gw = F.bx * NWAVES + F.wave, NGW = F.G * NWAVES;
    for (int m = gw; m < M; m += NGW) {
        const GAS u32x2* xr = (const GAS u32x2*)(X1 + (size_t)m * D) + F.lane;
        f32x4 v[4];
#pragma unroll
        for (int j = 0; j < 4; ++j) { const u32x2 c = xr[64 * j]; v[j] = (f32x4){bflo(c.x), bfhi(c.x), bflo(c.y), bfhi(c.y)}; }
        const int4 ps = *(const int4*)(POS + (size_t)m * 4); const int pp[4] = {ps.x, ps.y, ps.z, ps.w};
#pragma unroll
        for (int k = 0; k < 4; ++k) { const GAS u32x2* cr = (const GAS u32x2*)(CB + (size_t)pp[k] * D) + F.lane;
#pragma unroll
            for (int j = 0; j < 4; ++j) { const u32x2 c = cr[64 * j]; v[j].x += bflo(c.x); v[j].y += bfhi(c.x); v[j].z += bflo(c.y); v[j].w += bfhi(c.y); } }
        float s2 = 0.f;
#pragma unroll
        for (int j = 0; j < 4; ++j) s2 += (v[j].x * v[j].x + v[j].y * v[j].y) + (v[j].z * v[j].z + v[j].w * v[j].w);
        const float rstd = 1.0f / sqrtf(wave_sum(s2) * (1.0f / D) + RMS_EPS);
        GAS f32x4* orow = (GAS f32x4*)(F.out + (size_t)m * D) + F.lane;
#pragma unroll
        for (int j = 0; j < 4; ++j) { const f32x4 g = *((const GAS f32x4*)F.g_fin + F.lane + 64 * j); orow[64 * j] = v[j] * rstd * g; }
    }
}

__global__ void __launch_bounds__(NTHR, 2) fwd_kernel(Args args) {
    extern __shared__ __attribute__((aligned(16))) unsigned char lds_raw[];
    Frame F;
    F.lds = (LAS unsigned char*)lds_raw;
    F.tid = threadIdx.x; F.lane = F.tid & 63; F.wave = __builtin_amdgcn_readfirstlane(F.tid >> 6); F.G = gridDim.x; F.bx = blockIdx.x;
    F.x = args.in[0]; F.g_mix = args.in[1]; F.w_in = args.in[2]; F.conv_w = args.in[3]; F.w_gk_up = args.in[4]; F.b_gk_up = args.in[5]; F.gla_g = args.in[6]; F.w_out = args.in[7];
    F.g_ffn = args.in[8]; F.w_router = args.in[9]; F.b_router = args.in[10]; F.w_gu = args.in[11]; F.b_gu = args.in[12]; F.w_dn = args.in[13]; F.b_dn = args.in[14]; F.g_fin = args.in[15];
    F.out = args.out; F.ws = args.ws;
    volatile LAS unsigned* MISC = (volatile LAS unsigned*)(F.lds + MISC_OFF);
    for (int u = F.tid; u < 256; u += NTHR) MISC[u] = 0u;
    __syncthreads();
    unsigned* ctl = (unsigned*)(F.ws + WS_CTL);
    XcdBarrier bar; bar.bar = ctl + CW_BAR; bar.x = 0; bar.st = nullptr;
    if (N_LAUNCHES == 1) bar = xcd_barrier_post(ctl + CW_BAR, MISC + 8);
    const int lo = args.ph_lo, hi = args.ph_hi;
#define IN(k) (lo <= (k) && (k) < hi)
#define SEAM(k) do { if (IN(k) && IN((k) + 1)) { xcd_barrier(bar); if (((REPMASK >> 22) & 1) != 0) xcd_barrier(bar); } } while (0)
#define REP(k) for (int rep_ = 0; rep_ < 1 + ((REPMASK >> (k)) & 1); ++rep_)
    const int* META = (const int*)(F.ws + WS_ROUTE + R_META);

    if (IN(0)) REP(0) { p0_prep(F); } SEAM(0);
    if (IN(1)) {
        pg8::StaticOrder S; S.init(M / 256, NPROJ / 256, F.G, F.bx, 1 + ((REPMASK >> 1) & 1));
        pg8::EpiBf16 E{(bf16_t*)(F.ws + WS_PROJ), NPROJ};
        pg8::gemm_phase<pg8::EpiBf16, pg8::StaticOrder, true, false, 1 + ((REPMASK >> 14) & 1)>(F.lds, F.ws + WS_XN, F.ws + WS_W1T, 0, D / 64, nullptr, S, E);
    } SEAM(1);
    if (IN(2)) REP(2) { p2_gla_kv(F); } SEAM(2);
    if (IN(3)) REP(3) { p3_scan(F); } SEAM(3);
    if (IN(4)) REP(4) { p4_gla_out(F); } SEAM(4);
    if (IN(5)) {
        pg8::StaticOrder S; S.init(M / 256, D / 256, F.G, F.bx, 1 + ((REPMASK >> 5) & 1));
        pg8::EpiResBf16 E{F.x, (bf16_t*)(F.ws + WS_X1), D};
        pg8::gemm_phase<pg8::EpiResBf16, pg8::StaticOrder, true, false, 1 + ((REPMASK >> 15) & 1)>(F.lds, F.ws + WS_Y, F.ws + WS_WOT, 0, D / 64, nullptr, S, E);
    } SEAM(5);
    if (IN(6)) REP(6) { p6_router(F); } SEAM(6);
    if (IN(7)) REP(7) { p7_slots(F); } SEAM(7);
    if (IN(8)) {
        const int ntiles = META[0];
        LAS int* te = (LAS int*)(F.lds + TE_OFF); LAS int* utab = te + NTILES_MAX;
        LAS unsigned short* ridx = (LAS unsigned short*)(F.lds + TE_OFF + 2048); LAS float* rstd = (LAS float*)(F.lds + TE_OFF + 2048 + pg8::UCAP * 512); LAS float* bias = rstd + pg8::UCAP * 256;
        for (int i = F.tid; i < NTILES_MAX; i += NTHR) te[i] = META[32 + i];
        __syncthreads();
        pg8::MoeOrder S0; S0.so.init(ntiles, 2 * FF / 256, F.G, F.bx); S0.tile_expert = te;
        int nun = 0;
        { const int* ROWTOK = (const int*)(F.ws + WS_ROUTE + R_ROWTOK); const float* ROWRSTD = (const float*)(F.ws + WS_ROUTE + R_ROWRSTD); pg8::Unit uu;
          for (; nun < pg8::UCAP && S0.next(nun, uu); ++nun) {
              if (F.tid == 0) { utab[4 * nun] = uu.pm; utab[4 * nun + 1] = uu.pn; utab[4 * nun + 2] = uu.pb; utab[4 * nun + 3] = uu.e; }
              if (F.tid < 256) { ridx[nun * 256 + F.tid] = (unsigned short)ROWTOK[uu.pm * 256 + F.tid]; rstd[nun * 256 + F.tid] = ROWRSTD[uu.pm * 256 + F.tid];
                  bias[nun * 256 + F.tid] = F.b_gu[(size_t)uu.e * 2048 + (F.tid >> 7) * 1024 + uu.pn * 128 + (F.tid & 127)]; } }
          __syncthreads(); }
        pg8::TabOrder S{utab, nun, (REPMASK >> 18) & 1};
#ifdef SKEW_TICKS
        { const unsigned long long t0 = __builtin_amdgcn_s_memrealtime(); const unsigned long long dl = (unsigned long long)((F.bx >> 3) & 31) * SKEW_TICKS;
          while (__builtin_amdgcn_s_memrealtime() - t0 < dl) __builtin_amdgcn_s_sleep(2); }
#endif
        pg8::EpiSwiglu E{(bf16_t*)(F.ws + WS_H), bias, rstd};
        constexpr int ES = MOE_FP8 ? 1 : 2;
        pg8::gemm_phase<pg8::EpiSwiglu, pg8::TabOrder, true, MOE_FP8 != 0, 1 + ((REPMASK >> 16) & 1)>(F.lds, F.ws + WS_XN, F.ws + WS_WGUT, D * ES, D * ES / 128, ridx, S, E);
    } SEAM(8);
    if (IN(9)) {
        const int ntiles = META[0];
        LAS int* te = (LAS int*)(F.lds + TE_OFF); LAS int* utab = te + NTILES_MAX;
        LAS float* gate = (LAS float*)(F.lds + TE_OFF + 2048); LAS float* bias = gate + pg8::UCAP * 256;
        for (int i = F.tid; i < NTILES_MAX; i += NTHR) te[i] = META[32 + i];
        __syncthreads();
        pg8::MoeOrder S0; S0.so.init(ntiles, D / 256, F.G, F.bx); S0.tile_expert = te;
        int nun = 0;
        { const float* ROWGATE = (const float*)(F.ws + WS_ROUTE + R_ROWGATE); pg8::Unit uu;
          for (; nun < pg8::UCAP && S0.next(nun, uu); ++nun) {
              if (F.tid == 0) { utab[4 * nun] = uu.pm; utab[4 * nun + 1] = uu.pn; utab[4 * nun + 2] = uu.pb; utab[4 * nun + 3] = uu.e; }
              if (F.tid < 256) { gate[nun * 256 + F.tid] = ROWGATE[uu.pm * 256 + F.tid]; bias[nun * 256 + F.tid] = F.b_dn[(size_t)uu.e * D + uu.pn * 256 + F.tid]; } }
          __syncthreads(); }
        pg8::TabOrder S{utab, nun, (REPMASK >> 19) & 1};
        pg8::EpiDown E{(bf16_t*)(F.ws + WS_CONTRIB), bias, gate};
        constexpr int ES = MOE_FP8 ? 1 : 2;
        pg8::gemm_phase<pg8::EpiDown, pg8::TabOrder, true, MOE_FP8 != 0, 1 + ((REPMASK >> 17) & 1)>(F.lds, F.ws + WS_H, F.ws + WS_WDT, 0, FF * ES / 128, nullptr, S, E);
    } SEAM(9);
    if (IN(10)) REP(10) { p10_combine(F); }
#undef IN
#undef SEAM
}

extern "C" void kernel_launch(void* const* d_in, const int* in_sizes, int n_in, void* d_out, int out_size, void* d_ws, size_t ws_size, hipStream_t stream) {
    static int grid = 0;
    if (grid == 0) {
        if (n_in != 16 || in_sizes[0] != M * D || out_size != M * D || ws_size < WS_END) { fprintf(stderr, "kernel_launch: unexpected shapes (n_in %d, in0 %d, out %d, ws %zu < %zu)\n", n_in, n_in > 0 ? in_sizes[0] : -1, out_size, ws_size, (size_t)WS_END); grid = -1; return; }
        int dev = 0, cus = 0, per_cu = 0;
        if (hipGetDevice(&dev) != hipSuccess || hipDeviceGetAttribute(&cus, hipDeviceAttributeMultiprocessorCount, dev) != hipSuccess) { grid = -1; return; }
        if (hipFuncSetAttribute((const void*)fwd_kernel, hipFuncAttributeMaxDynamicSharedMemorySize, LDS_BYTES) != hipSuccess) { fprintf(stderr, "kernel_launch: hipFuncSetAttribute failed\n"); grid = -1; return; }
        if (hipOccupancyMaxActiveBlocksPerMultiprocessor(&per_cu, (const void*)fwd_kernel, NTHR, LDS_BYTES) != hipSuccess || per_cu < 1) fprintf(stderr, "kernel_launch: occupancy query reports %d\n", per_cu);
        (void)hipGetLastError();
        grid = cus;
    }
    if (grid < 0) return;
    (void)hipMemsetAsync((char*)d_ws + WS_CTL, 0, CTL_ZERO_BYTES, stream);
    Args a{};
    for (int i = 0; i < 16; ++i) a.in[i] = (const float*)d_in[i];
    a.out = (float*)d_out; a.ws = (unsigned char*)d_ws;
    for (int li = 0; li < N_LAUNCHES; ++li) {
        if (N_LAUNCHES == 1) { a.ph_lo = 0; a.ph_hi = NPHASES; } else { a.ph_lo = li; a.ph_hi = li + 1; }
        a.li = li;
        hipLaunchKernelGGL(fwd_kernel, dim3(grid), dim3(NTHR), LDS_BYTES, stream, a);
    }
}
```

```cpp
#include <hip/hip_runtime.h>
#include <cstdio>
#include <cstdint>

#ifndef MK_N_LAUNCHES
#define MK_N_LAUNCHES 1
#endif

#ifndef MOE_FP8
#define MOE_FP8 1
#endif
#ifndef REPMASK
#define REPMASK 0
#endif
#define LAS __attribute__((address_space(3)))
#define GAS __attribute__((address_space(1)))
typedef unsigned short bf16_t;
typedef short bf16x8 __attribute__((ext_vector_type(8)));
typedef float f32x4 __attribute__((ext_vector_type(4)));
typedef float f32x2 __attribute__((ext_vector_type(2)));
typedef unsigned u32x4 __attribute__((ext_vector_type(4)));
typedef unsigned u32x2 __attribute__((ext_vector_type(2)));

constexpr int NWAVES = 8, NTHR = 512;
constexpr int NPHASES = 11;
constexpr int N_LAUNCHES = MK_N_LAUNCHES;
constexpr int BATCH = 4, SEQ = 4096, D = 1024, M = BATCH * SEQ;
constexpr int CONVW = 512, NH = 4, DK = 64, DV = 128, RANK = 16, CHUNK = 64, NCH = SEQ / CHUNK;
constexpr int DIN = 3088, NPROJ = 3072;
constexpr int C_UH = 0, C_GB = 512, C_GC = 1024, C_Q = 1536, C_K = 1792, C_V = 2048, C_G = 2560, C_GKL = 3072;
constexpr int NE = 32, TOPK = 4, FF = 1024;
constexpr int NUNITS_GLA = BATCH * NH * NCH;
constexpr int NROWS_MAX = M * TOPK + NE * 256;
constexpr int NTILES_MAX = NROWS_MAX / 256;
constexpr float RMS_EPS = 1e-5f;

constexpr size_t MiB = 1u << 20;
constexpr size_t WS_CTL = 0, CTL_ZERO_BYTES = 1 * MiB;
constexpr size_t WS_XN = 1 * MiB;
constexpr size_t WS_GKL = WS_XN + 32 * MiB;
constexpr size_t WS_W1T = WS_GKL + 1 * MiB;
constexpr size_t WS_WOT = WS_W1T + 6 * MiB;
constexpr size_t WS_WGUT = WS_WOT + 2 * MiB;
constexpr size_t WS_WDT = WS_WGUT + 128 * MiB;
constexpr size_t WS_PROJ = WS_WDT + 64 * MiB;
constexpr size_t WS_KVT = WS_PROJ + 96 * MiB;
constexpr size_t WS_DEC = WS_KVT + 32 * MiB;
constexpr size_t WS_ST = WS_DEC + 1 * MiB;
constexpr size_t WS_Y = WS_ST + 16 * MiB;
constexpr size_t WS_X1 = WS_Y + 32 * MiB;
constexpr size_t WS_ROUTE = WS_X1 + 64 * MiB;
constexpr size_t WS_H = WS_ROUTE + 2 * MiB;
constexpr size_t WS_CONTRIB = WS_H + 144 * MiB;
constexpr size_t WS_END = WS_CONTRIB + 144 * MiB;
constexpr size_t R_TOPI = 0;
constexpr size_t R_TOPG = 256 * 1024;
constexpr size_t R_POS = 512 * 1024;
constexpr size_t R_ROWTOK = 768 * 1024;
constexpr size_t R_ROWGATE = 1088 * 1024;
constexpr size_t R_HIST = 1408 * 1024;
constexpr size_t R_META = 1472 * 1024;
constexpr size_t R_RSTD = 1536 * 1024;
constexpr size_t R_ROWRSTD = 1664 * 1024;
constexpr int CW_BAR = 4096;

constexpr int LDS_BYTES = 160 * 1024 - 2048;
constexpr int MISC_OFF = LDS_BYTES - 1024;
constexpr int TE_OFF = 131072;

__device__ __forceinline__ unsigned f2bf(float f) { unsigned u = __builtin_bit_cast(unsigned, f); return (u + 0x7fffu + ((u >> 16) & 1u)) >> 16; }
__device__ __forceinline__ unsigned pk2(float lo, float hi) { typedef __bf16 bf2_ __attribute__((ext_vector_type(2))); const f32x2 v = {lo, hi}; return __builtin_bit_cast(unsigned, __builtin_convertvector(v, bf2_)); }
__device__ __forceinline__ float bf2f(unsigned short b) { return __builtin_bit_cast(float, (unsigned)b << 16); }
__device__ __forceinline__ float bflo(unsigned w) { return __builtin_bit_cast(float, w << 16); }
__device__ __forceinline__ float bfhi(unsigned w) { return __builtin_bit_cast(float, w & 0xffff0000u); }
__device__ __forceinline__ unsigned cvt_pk_bf16(float lo, float hi) { unsigned r; asm volatile("v_cvt_pk_bf16_f32 %0, %1, %2" : "=v"(r) : "v"(lo), "v"(hi)); return r; }
__device__ __forceinline__ unsigned pk4_fp8(float a, float b, float c, float d) { int w = 0; w = __builtin_amdgcn_cvt_pk_fp8_f32(a, b, w, false); w = __builtin_amdgcn_cvt_pk_fp8_f32(c, d, w, true); return (unsigned)w; }

__device__ __forceinline__ float sigmoidf_(float x) { return __builtin_amdgcn_rcpf(1.0f + __expf(-x)); }
__device__ __forceinline__ float log_sigmoidf_(float x) { return fminf(x, 0.f) - __logf(1.0f + __expf(-fabsf(x))); }
#define DPPF_(x, ctrl, rm) __builtin_bit_cast(float, __builtin_amdgcn_update_dpp(0, __builtin_bit_cast(int, (x)), (ctrl), (rm), 0xf, false))
__device__ __forceinline__ float row16_sum(float t) { t += DPPF_(t, 0xb1, 0xf); t += DPPF_(t, 0x4e, 0xf); t += DPPF_(t, 0x141, 0xf); t += DPPF_(t, 0x140, 0xf); return t; }
__device__ __forceinline__ float wave_incl_scan(float v) {
    v += DPPF_(v, 0x111, 0xf); v += DPPF_(v, 0x112, 0xf); v += DPPF_(v, 0x114, 0xf); v += DPPF_(v, 0x118, 0xf);
    v += DPPF_(v, 0x142, 0xa); v += DPPF_(v, 0x143, 0xc);
    return v;
}
__device__ __forceinline__ float wave_sum(float v) { const float t = wave_incl_scan(v); return __builtin_bit_cast(float, __builtin_amdgcn_readlane(__builtin_bit_cast(int, t), 63)); }
__host__ __device__ __forceinline__ size_t tiled_off(int row, int cbyte, int nt) { return ((size_t)((row >> 8) * nt + (cbyte >> 7)) << 15) + (size_t)(((row & 255) << 7) + (cbyte & 127)); }
#define LDS_WAIT() asm volatile("s_waitcnt lgkmcnt(0)" ::: "memory")
#define VM_WAIT() asm volatile("s_waitcnt vmcnt(0)" ::: "memory")

#define XB_TMO      128
#define XB_XCNT(j)  (256  + 64 * (j))
#define XB_XSUB(j)  (1280 + 64 * (j))
#define XB_XGEN(j)  (2304 + 64 * (j))
#define XB_TOP      3328
#define XB_TOPGEN   3392
#define XCD_BAR_WORDS 3456
#define XB_SPIN_CAP (1u << 18)
__device__ __forceinline__ unsigned xb_ld(unsigned* p)              { return __hip_atomic_load(p, __ATOMIC_RELAXED, __HIP_MEMORY_SCOPE_AGENT); }
__device__ __forceinline__ unsigned xb_add(unsigned* p, unsigned v) { return __hip_atomic_fetch_add(p, v, __ATOMIC_RELAXED, __HIP_MEMORY_SCOPE_AGENT); }
__device__ __forceinline__ unsigned xb_xcc_id() { return (unsigned)__builtin_amdgcn_s_getreg((3 << 11) | 20) & 0xFu; }
#define XB_SPIN(cond, bar) do { unsigned _sp = 0; while (cond) { __builtin_amdgcn_s_sleep(1); \
    if ((++_sp & 255u) == 0u) { if (xb_ld(&(bar)[XB_TMO])) break; if (_sp > XB_SPIN_CAP) { atomicAdd(&(bar)[XB_TMO], 1u); break; } } } } while (0)
struct XcdBarrier { unsigned* bar; unsigned x; volatile LAS unsigned* st; };
__device__ __forceinline__ XcdBarrier xcd_barrier_post(unsigned* bar, volatile LAS unsigned* st) {
    XcdBarrier b; b.bar = bar; b.x = xb_xcc_id(); b.st = st;
    if (threadIdx.x == 0) (void)xb_add(&bar[XB_XCNT(b.x)], 1u);
    return b;
}
__device__ __forceinline__ void xcd_barrier_complete(unsigned* bar, unsigned x, unsigned& nloc, unsigned& nx) {
    const unsigned G = gridDim.x * gridDim.y * gridDim.z;
    unsigned sum, cnt, mine, sp = 0u;
    for (;;) {
        sum = 0u; cnt = 0u; mine = 0u;
#pragma unroll
        for (unsigned j = 0; j < 16; ++j) { const unsigned c = xb_ld(&bar[XB_XCNT(j)]); sum += c; cnt += (c > 0u) ? 1u : 0u; mine = (j == x) ? c : mine; }
        if (sum == G) break;
        __builtin_amdgcn_s_sleep(1);
        if ((++sp & 255u) == 0u) { if (xb_ld(&bar[XB_TMO])) break; if (sp > XB_SPIN_CAP) { atomicAdd(&bar[XB_TMO], 1u); break; } }
    }
    nloc = mine > 0u ? mine : 1u; nx = cnt > 0u ? cnt : 1u;
}
__device__ __forceinline__ void xcd_barrier(const XcdBarrier& b) {
    asm volatile("s_waitcnt vmcnt(0)" ::: "memory");
    __syncthreads();
    if (threadIdx.x == 0) {
        unsigned* bar = b.bar;
        __builtin_amdgcn_s_waitcnt(0);
        unsigned nloc = b.st[0], nx = b.st[1];
        if (nloc == 0u) { xcd_barrier_complete(bar, b.x, nloc, nx); b.st[0] = nloc; b.st[1] = nx; }
        const unsigned old = xb_add(&bar[XB_XSUB(b.x)], 1u);
        const unsigned gen = old / nloc;
        if (old + 1u == (gen + 1u) * nloc) {
            __builtin_amdgcn_fence(__ATOMIC_RELEASE, "agent");
            asm volatile("s_waitcnt vmcnt(0)" ::: "memory");
            const unsigned og = xb_add(&bar[XB_TOP], 1u);
            const unsigned tg = og / nx;
            if (og + 1u == (tg + 1u) * nx) xb_add(&bar[XB_TOPGEN], 1u);
            else XB_SPIN(xb_ld(&bar[XB_TOPGEN]) == tg, bar);
            __builtin_amdgcn_fence(__ATOMIC_ACQUIRE, "agent");
            xb_add(&bar[XB_XGEN(b.x)], 1u);
            asm volatile("s_waitcnt vmcnt(0)" ::: "memory");
        } else {
            XB_SPIN(xb_ld(&bar[XB_XGEN(b.x)]) == gen, bar);
            __builtin_amdgcn_fence(__ATOMIC_ACQUIRE, "agent");
            asm volatile("s_waitcnt vmcnt(0)" ::: "memory");
        }
    }
    __syncthreads();
}

namespace pg8 {
constexpr int BM = 256, BK = 64, HALF = 128, HTB = HALF * BK * 2, STAGE_BYTES = 8 * HTB, NXCD = 8, WGM = 8;
__host__ __device__ __forceinline__ int lds_byte(int r, int c) { const int st = (r >> 4) * 2 + (c >> 5), rr = r & 15, cc = c & 31, ob = rr * 64 + cc * 2; return st * 1024 + (ob ^ (((ob >> 9) & 1) << 5)); }
__host__ __device__ __forceinline__ void stage_rc(int b, int& R, int& C) { const int st = b / 1024, sb = b % 1024, swz = sb ^ (((sb >> 9) & 1) << 5); R = (st >> 1) * 16 + swz / 64; C = (st & 1) * 32 + (swz % 64) / 2; }
__host__ __device__ __forceinline__ int perm32(int rho) { const int n = rho >> 4, i = rho & 15; return 8 * (i >> 2) + 4 * n + (i & 3); }
struct Unit { int pm, pn, pb, e, i; };
struct StaticOrder {
    int nM, nN, nwg, G, c, reps;
    __host__ __device__ void init(int nM_, int nN_, int G_, int c_, int reps_ = 1) { nM = nM_; nN = nN_; nwg = nM * nN; G = G_; c = c_; reps = reps_; }
    __host__ __device__ bool next(int i, Unit& u) const {
        const long L = (long)i * G + c; if (L >= (long)nwg * reps) return false;
        int wgid = (int)(L % nwg); { const int q = nwg / NXCD, r = nwg % NXCD, xcd = wgid % NXCD, off = wgid / NXCD; wgid = (xcd < r ? xcd * (q + 1) : r * (q + 1) + (xcd - r) * q) + off; }
        const int nig = WGM * nN, gid = wgid / nig, fm = gid * WGM, gsz = (nM - fm) < WGM ? (nM - fm) : WGM;
        u.pm = fm + ((wgid % nig) % gsz); u.pn = (wgid % nig) / gsz; u.pb = u.pn; u.e = 0; u.i = i; return true;
    }
};
struct MoeOrder {
    StaticOrder so; const LAS int* tile_expert;
    __device__ bool next(int i, Unit& u) const { if (!so.next(i, u)) return false; u.e = __builtin_amdgcn_readfirstlane(tile_expert[u.pm]); u.pb = u.e * so.nN + u.pn; return true; }
};
struct TabOrder {
    const LAS int* tab; int n; int dup;
    __device__ bool next(int i, Unit& u) const { if (i >= (n << dup)) return false; const LAS int* p = tab + 4 * (i >> dup);
        u.pm = __builtin_amdgcn_readfirstlane(p[0]); u.pn = __builtin_amdgcn_readfirstlane(p[1]); u.pb = __builtin_amdgcn_readfirstlane(p[2]); u.e = __builtin_amdgcn_readfirstlane(p[3]); u.i = i >> dup; return true; }
};
constexpr int UCAP = 10;
typedef int i32x8 __attribute__((ext_vector_type(8)));
typedef int i32x4 __attribute__((ext_vector_type(4)));
template <class Epi, class Sched, bool ALIGN_EPI, bool FP8, int NPASS = 1>
__device__ __forceinline__ void gemm_phase(LAS unsigned char* lds, const void* A, const void* Bt, const int ldA, const int nt, const LAS unsigned short* rowidx, const Sched& S, const Epi& E) {
    const int tid = threadIdx.x, wid = __builtin_amdgcn_readfirstlane(tid >> 6), lane = tid & 63, wr = wid >> 2, wc = wid & 3, fr = lane & 15, fq = lane >> 4;
    unsigned voffB[2];
#pragma unroll
    for (int i = 0; i < 2; ++i) { int R, C; stage_rc(tid * 16 + i * 8192, R, C); const int Rb = Epi::PERM ? ((R & ~31) + perm32(R & 31)) : R; voffB[i] = (unsigned)(Rb * 128 + C * 2); }
    const size_t kstep = 32768, kstepA = rowidx ? (size_t)128 : (size_t)32768;
    const size_t hstep = 16384;
    const size_t tstep = (size_t)nt * 32768;
    const unsigned ldsw = (unsigned)wid * 1024u;
    const int aoff = lds_byte(wr * 64 + fr, fq * 8), boff = lds_byte(wc * 32 + fr, fq * 8);
#define PG8_SA(b, h) (((b) * 2 + (h)) * HTB)
#define PG8_SB(b, h) ((4 + (b) * 2 + (h)) * HTB)
#define PG8_STAGE(bufoff, gbase, voff) do { _Pragma("unroll") for (int _i = 0; _i < 2; ++_i) \
        __builtin_amdgcn_global_load_lds((const unsigned*)((const char*)(gbase) + (voff)[_i]), (LAS unsigned*)(lds + (bufoff) + ldsw + _i * 8192), 16, 0, 0); } while (0)
#define PG8_LDA(dst, b, h) do { _Pragma("unroll") for (int m = 0; m < 4; ++m) _Pragma("unroll") for (int k = 0; k < 2; ++k) dst[m][k] = *(const LAS bf16x8*)(lds + PG8_SA(b, h) + aoff + m * 2048 + k * 1024); } while (0)
#define PG8_LDB(dst, b, h) do { _Pragma("unroll") for (int n = 0; n < 2; ++n) _Pragma("unroll") for (int k = 0; k < 2; ++k) dst[n][k] = *(const LAS bf16x8*)(lds + PG8_SB(b, h) + boff + n * 2048 + k * 1024); } while (0)
#define PG8_F8(x) __builtin_shufflevector(__builtin_bit_cast(i32x4, (x)[0]), __builtin_bit_cast(i32x4, (x)[1]), 0, 1, 2, 3, 4, 5, 6, 7)
#define PG8_MMA(ai, bj, At, Bt_) do { __builtin_amdgcn_s_setprio(1); _Pragma("unroll") for (int m = 0; m < 4; ++m) _Pragma("unroll") for (int n = 0; n < 2; ++n) { \
        if constexpr (FP8) { const i32x8 _a = PG8_F8(Bt_[n]), _b = PG8_F8(At[m]); \
            asm volatile("v_mfma_scale_f32_16x16x128_f8f6f4 %0, %1, %2, %0, %3, %4 op_sel_hi:[0,0,0]" : "+v"(acc[ai][bj][m][n]) : "v"(_a), "v"(_b), "v"(sclW), "v"(sclX)); } \
        else { _Pragma("unroll") for (int k = 0; k < 2; ++k) acc[ai][bj][m][n] = __builtin_amdgcn_mfma_f32_16x16x32_bf16(Bt_[n][k], At[m][k], acc[ai][bj][m][n], 0, 0, 0); } } \
        __builtin_amdgcn_s_setprio(0); } while (0)
#define PG8_WAIT_V(n) asm volatile("s_waitcnt vmcnt(" #n ")" ::: "memory")
#define PG8_WAIT_L(n) asm volatile("s_waitcnt lgkmcnt(" #n ")" ::: "memory")
#define PG8_WAIT_VR(rx) do { if (rx) { if constexpr (Epi::NST == 16) PG8_WAIT_V(24); else if constexpr (Epi::NST == 8) PG8_WAIT_V(16); else PG8_WAIT_V(8); } else PG8_WAIT_V(8); } while (0)
#define PG8_BAR __builtin_amdgcn_s_barrier()
#define PG8_SCHED __builtin_amdgcn_sched_barrier(0)
#define PG8_AOFF(dst, u, uo) do { _Pragma("unroll") for (int _h = 0; _h < 2; ++_h) _Pragma("unroll") for (int _i = 0; _i < 2; ++_i) { int _R, _C; stage_rc(tid * 16 + _i * 8192, _R, _C); \
        dst[_h][_i] = rowidx ? (unsigned)((int)rowidx[(u).i * BM + _h * HALF + _R] * ldA + _C * 2) : (unsigned)(((u).pm * nt << 15) + ((_h * HALF + _R) << 7) + _C * 2); } } while (0)
    Unit cur, nxt; int ui = 0;
    if (!S.next(0, cur)) return;
    f32x4 acc[2][2][4][2];
#pragma unroll
    for (int a = 0; a < 2; ++a)
#pragma unroll
        for (int b = 0; b < 2; ++b)
#pragma unroll
            for (int m = 0; m < 4; ++m)
#pragma unroll
                for (int n = 0; n < 2; ++n) acc[a][b][m][n] = (f32x4){0.f, 0.f, 0.f, 0.f};
    bf16x8 At[4][2], B0[2][2], B1[2][2];
    int sclW = 0x7A7A7A7A, sclX = 0x7F7F7F7F;
    asm volatile("" : "+v"(sclW), "+v"(sclX));
    unsigned ca[2][2], na[2][2];
    PG8_AOFF(ca, cur, 0);
    const char* cA = (const char*)A; const char* cB = (const char*)Bt + (size_t)cur.pb * tstep;
    PG8_STAGE(PG8_SB(0, 0), cB, voffB); PG8_STAGE(PG8_SB(0, 1), cB + hstep, voffB); PG8_STAGE(PG8_SA(0, 0), cA, ca[0]); PG8_STAGE(PG8_SA(0, 1), cA, ca[1]);
    if (wr == 1) PG8_BAR;
    PG8_WAIT_V(2); PG8_BAR;
    PG8_STAGE(PG8_SB(1, 0), cB + kstep, voffB); PG8_STAGE(PG8_SA(1, 0), cA + kstepA, ca[0]); PG8_STAGE(PG8_SB(1, 1), cB + hstep + kstep, voffB);
    PG8_WAIT_V(6); PG8_BAR;
    for (;;) {
        const bool has_next = S.next(ui + 1, nxt);
        if (has_next) { PG8_AOFF(na, nxt, ui + 1); }
        else {
#pragma unroll
            for (int h = 0; h < 2; ++h)
#pragma unroll
                for (int i = 0; i < 2; ++i) na[h][i] = ca[h][i];
        }
        const char* nB = has_next ? (const char*)Bt + (size_t)nxt.pb * tstep : cB;
#pragma unroll 1
        for (int pass = 0; pass < NPASS; ++pass)
#pragma unroll 1
        for (int t = 0; t < nt; t += 2) {
            const bool lastp = (pass == NPASS - 1);
            const bool last = (t == nt - 2);
            const char* a1 = cA + (size_t)(t + 1) * kstepA;
            const char* a2 = last ? cA : cA + (size_t)(t + 2) * kstepA; const char* b2 = last ? (lastp ? nB : cB) : cB + (size_t)(t + 2) * kstep;
            const char* a3 = a2 + kstepA; const char* b3 = b2 + kstep;
            unsigned o2[2][2];
#pragma unroll
            for (int h = 0; h < 2; ++h)
#pragma unroll
                for (int i = 0; i < 2; ++i) o2[h][i] = (last && lastp) ? na[h][i] : ca[h][i];
            const bool relax = (Epi::NST > 0) && (t == 0) && (ui > 0) && (pass == 0);
            PG8_LDB(B0, 0, 0); PG8_LDB(B1, 0, 1); PG8_SCHED; PG8_LDA(At, 0, 0); PG8_STAGE(PG8_SA(1, 1), a1, ca[1]);
            PG8_WAIT_VR(relax); PG8_WAIT_L(0); PG8_BAR; PG8_MMA(0, 0, At, B0); PG8_MMA(0, 1, At, B1); PG8_BAR; PG8_SCHED;
            PG8_LDA(At, 0, 1); PG8_STAGE(PG8_SB(0, 0), b2, voffB); PG8_STAGE(PG8_SB(0, 1), b2 + hstep, voffB); PG8_STAGE(PG8_SA(0, 0), a2, o2[0]);
            PG8_WAIT_VR(relax); PG8_WAIT_L(0); PG8_BAR; PG8_MMA(1, 0, At, B0); PG8_MMA(1, 1, At, B1); PG8_BAR; PG8_SCHED;
            PG8_LDB(B0, 1, 0); PG8_LDB(B1, 1, 1); PG8_SCHED; PG8_LDA(At, 1, 0); PG8_STAGE(PG8_SA(0, 1), a2, o2[1]);
            PG8_WAIT_V(8); PG8_WAIT_L(0); PG8_BAR; PG8_MMA(0, 0, At, B0); PG8_MMA(0, 1, At, B1); PG8_BAR; PG8_SCHED;
            PG8_LDA(At, 1, 1); PG8_STAGE(PG8_SB(1, 0), b3, voffB); PG8_STAGE(PG8_SB(1, 1), b3 + hstep, voffB); PG8_STAGE(PG8_SA(1, 0), a3, o2[0]);
            PG8_WAIT_V(8); PG8_WAIT_L(0); PG8_BAR; PG8_MMA(1, 0, At, B0); PG8_MMA(1, 1, At, B1); PG8_BAR; PG8_SCHED;
        }
        if constexpr (ALIGN_EPI) { if (wr == 0) PG8_BAR; }
        if constexpr (FP8) asm volatile("s_nop 15\n\ts_nop 15" ::: "memory");
        if constexpr (NPASS > 1) {
#pragma unroll
            for (int a = 0; a < 2; ++a)
#pragma unroll
                for (int b = 0; b < 2; ++b)
#pragma unroll
                    for (int m = 0; m < 4; ++m)
#pragma unroll
                        for (int n = 0; n < 2; ++n) acc[a][b][m][n] *= (1.0f / NPASS);
        }
        E(acc, cur, wr, wc, fr, fq);
        if constexpr (((REPMASK >> 13) & 1) != 0) { asm volatile("" ::: "memory"); E(acc, cur, wr, wc, fr, fq); }
        if (!has_next) break;
#pragma unroll
        for (int a = 0; a < 2; ++a)
#pragma unroll
            for (int b = 0; b < 2; ++b)
#pragma unroll
                for (int m = 0; m < 4; ++m)
#pragma unroll
                    for (int n = 0; n < 2; ++n) acc[a][b][m][n] = (f32x4){0.f, 0.f, 0.f, 0.f};
        cur = nxt; cB = nB; ++ui;
#pragma unroll
        for (int h = 0; h < 2; ++h)
#pragma unroll
            for (int i = 0; i < 2; ++i) ca[h][i] = na[h][i];
        if constexpr (ALIGN_EPI) { if (wr == 1) PG8_BAR; }
    }
    PG8_WAIT_V(0);
    if constexpr (!ALIGN_EPI) { if (wr == 0) PG8_BAR; }
    PG8_BAR;
#undef PG8_SA
#undef PG8_SB
#undef PG8_STAGE
#undef PG8_LDA
#undef PG8_LDB
#undef PG8_MMA
#undef PG8_F8
#undef PG8_WAIT_V
#undef PG8_WAIT_L
#undef PG8_WAIT_VR
#undef PG8_BAR
#undef PG8_SCHED
#undef PG8_AOFF
}

struct EpiBf16 {
    static constexpr bool PERM = true; static constexpr int NST = 16;
    bf16_t* O; int ldc;
    __device__ __forceinline__ void operator()(const f32x4 (&acc)[2][2][4][2], const Unit& u, int wr, int wc, int fr, int fq) const {
        const int row0 = u.pm * BM + wr * 64 + fr, col0 = u.pn * BM + wc * 32 + 8 * fq;
#pragma unroll
        for (int ai = 0; ai < 2; ++ai)
#pragma unroll
            for (int m = 0; m < 4; ++m) { bf16_t* rowp = O + (size_t)(row0 + ai * HALF + m * 16) * ldc + col0;
#pragma unroll
                for (int bj = 0; bj < 2; ++bj) { const f32x4 v0 = acc[ai][bj][m][0], v1 = acc[ai][bj][m][1];
                    u32x4 w; w.x = cvt_pk_bf16(v0[0], v0[1]); w.y = cvt_pk_bf16(v0[2], v0[3]); w.z = cvt_pk_bf16(v1[0], v1[1]); w.w = cvt_pk_bf16(v1[2], v1[3]);
                    *(u32x4*)(rowp + bj * HALF) = w; } }
    }
};
struct EpiResBf16 {
    static constexpr bool PERM = true; static constexpr int NST = 0;
    const float* __restrict__ base; bf16_t* __restrict__ O; int ldc;
    __device__ __forceinline__ void operator()(const f32x4 (&acc)[2][2][4][2], const Unit& u, int wr, int wc, int fr, int fq) const {
        const int row0 = u.pm * BM + wr * 64 + fr, col0 = u.pn * BM + wc * 32 + 8 * fq;
#pragma unroll
        for (int ai = 0; ai < 2; ++ai)
#pragma unroll
            for (int mp = 0; mp < 2; ++mp) {
                f32x4 bs[2][2][2];
#pragma unroll
                for (int mm = 0; mm < 2; ++mm)
#pragma unroll
                    for (int bj = 0; bj < 2; ++bj)
#pragma unroll
                        for (int n = 0; n < 2; ++n) bs[mm][bj][n] = *(const f32x4*)(base + (size_t)(row0 + ai * HALF + (2 * mp + mm) * 16) * ldc + col0 + bj * HALF + 4 * n);
#pragma unroll
                for (int mm = 0; mm < 2; ++mm)
#pragma unroll
                    for (int bj = 0; bj < 2; ++bj) { const int m = 2 * mp + mm; const f32x4 v0 = acc[ai][bj][m][0] + bs[mm][bj][0], v1 = acc[ai][bj][m][1] + bs[mm][bj][1];
                        u32x4 w; w.x = cvt_pk_bf16(v0[0], v0[1]); w.y = cvt_pk_bf16(v0[2], v0[3]); w.z = cvt_pk_bf16(v1[0], v1[1]); w.w = cvt_pk_bf16(v1[2], v1[3]);
                        *(u32x4*)(O + (size_t)(row0 + ai * HALF + m * 16) * ldc + col0 + bj * HALF) = w; }
            }
    }
};
struct EpiSwiglu {
    static constexpr bool PERM = true; static constexpr int NST = 8;
    bf16_t* Hb; const LAS float* bias; const LAS float* rstd;
    __device__ __forceinline__ void operator()(const f32x4 (&acc)[2][2][4][2], const Unit& u, int wr, int wc, int fr, int fq) const {
        const int row0 = u.pm * BM + wr * 64 + fr, col0 = u.pn * HALF + wc * 32 + 8 * fq;
        const LAS float* bg = bias + u.i * 256 + wc * 32 + 8 * fq; const LAS float* bu = bg + 128;
        const f32x4 g0 = *(const LAS f32x4*)bg, g1 = *(const LAS f32x4*)(bg + 4), u0 = *(const LAS f32x4*)bu, u1 = *(const LAS f32x4*)(bu + 4);
        float rsv[2][4];
#pragma unroll
        for (int ai = 0; ai < 2; ++ai)
#pragma unroll
            for (int m = 0; m < 4; ++m) rsv[ai][m] = rstd[u.i * 256 + wr * 64 + fr + ai * HALF + m * 16];
#pragma unroll
        for (int ai = 0; ai < 2; ++ai)
#pragma unroll
            for (int m = 0; m < 4; ++m) {
                float r[8]; const float rs = rsv[ai][m];
#pragma unroll
                for (int n = 0; n < 2; ++n)
#pragma unroll
                    for (int j = 0; j < 4; ++j) {
                        float gt = acc[ai][0][m][n][j] * rs + (n ? g1[j] : g0[j]); float up = acc[ai][1][m][n][j] * rs + (n ? u1[j] : u0[j]);
                        gt = fminf(gt, 7.0f); up = fminf(fmaxf(up, -7.0f), 7.0f);
                        const float glu = gt * __builtin_amdgcn_rcpf(1.0f + __expf(-1.702f * gt));
                        r[n * 4 + j] = (up + 1.0f) * glu; }
                if constexpr (MOE_FP8) { u32x2 w; w.x = pk4_fp8(r[0], r[1], r[2], r[3]); w.y = pk4_fp8(r[4], r[5], r[6], r[7]);
                    *(u32x2*)((unsigned char*)Hb + tiled_off(row0 + ai * HALF + m * 16, col0, FF / 128)) = w; }
                else { u32x4 w; w.x = cvt_pk_bf16(r[0], r[1]); w.y = cvt_pk_bf16(r[2], r[3]); w.z = cvt_pk_bf16(r[4], r[5]); w.w = cvt_pk_bf16(r[6], r[7]);
                    *(u32x4*)((unsigned char*)Hb + tiled_off(row0 + ai * HALF + m * 16, 2 * col0, FF / 64)) = w; } }
    }
};
struct EpiDown {
    static constexpr bool PERM = true; static constexpr int NST = 16;
    bf16_t* Cb; const LAS float* bias; const LAS float* gate;
    __device__ __forceinline__ void operator()(const f32x4 (&acc)[2][2][4][2], const Unit& u, int wr, int wc, int fr, int fq) const {
        const int row0 = u.pm * BM + wr * 64 + fr, col0 = u.pn * BM + wc * 32 + 8 * fq;
        f32x4 bv[2][2]; float gtv[2][4];
#pragma unroll
        for (int bj = 0; bj < 2; ++bj)
#pragma unroll
            for (int n = 0; n < 2; ++n) bv[bj][n] = *(const LAS f32x4*)(bias + u.i * 256 + wc * 32 + 8 * fq + bj * HALF + 4 * n);
#pragma unroll
        for (int ai = 0; ai < 2; ++ai)
#pragma unroll
            for (int m = 0; m < 4; ++m) gtv[ai][m] = gate[u.i * 256 + wr * 64 + fr + ai * HALF + m * 16];
#pragma unroll
        for (int ai = 0; ai < 2; ++ai)
#pragma unroll
            for (int m = 0; m < 4; ++m) { const int row = row0 + ai * HALF + m * 16; const float gt = gtv[ai][m]; bf16_t* rowp = Cb + (size_t)row * D + col0;
#pragma unroll
                for (int bj = 0; bj < 2; ++bj) { const f32x4 v0 = (acc[ai][bj][m][0] + bv[bj][0]) * gt, v1 = (acc[ai][bj][m][1] + bv[bj][1]) * gt;
                    u32x4 w; w.x = cvt_pk_bf16(v0[0], v0[1]); w.y = cvt_pk_bf16(v0[2], v0[3]); w.z = cvt_pk_bf16(v1[0], v1[1]); w.w = cvt_pk_bf16(v1[2], v1[3]);
                    *(u32x4*)(rowp + bj * HALF) = w; } }
    }
};
}

struct Args { const float* in[16]; float* out; unsigned char* ws; int ph_lo, ph_hi, li, pad; };
struct Frame {
    LAS unsigned char* lds; int tid, lane, wave, G, bx;
    const float *x, *g_mix, *w_in, *conv_w, *w_gk_up, *b_gk_up, *gla_g, *w_out, *g_ffn, *w_router, *b_router, *w_gu, *b_gu, *w_dn, *b_dn, *g_fin;
    float* out; unsigned char* ws;
};

struct P0Item { const float* W; unsigned char* dst; int ldn, k0, seg0, seg1; bool f8; };
__device__ __forceinline__ void p0_decode(Frame& F, int it, P0Item& I) {
    constexpr int ES = MOE_FP8 ? 1 : 2, NTE = D * ES / 128;
    constexpr int I_1 = (NPROJ / 256) * 16, I_O = (D / 256) * 16, I_GU = (2 * FF / 256) * NTE, I_DN = (D / 256) * NTE;
    if (it < I_1) { const int tile = it / 16, kt = it % 16; I = P0Item{F.w_in, F.ws + WS_W1T + ((size_t)(tile * 16 + kt) << 15), DIN, 64 * kt, 256 * tile, 256 * tile + 128, false}; return; }
    it -= I_1;
    if (it < I_O) { const int tile = it / 16, kt = it % 16; I = P0Item{F.w_out, F.ws + WS_WOT + ((size_t)(tile * 16 + kt) << 15), D, 64 * kt, 256 * tile, 256 * tile + 128, false}; return; }
    it -= I_O;
    const int e = it / (I_GU + I_DN); it -= e * (I_GU + I_DN);
    if (it < I_GU) { const int pn = it / NTE, kt = it % NTE;
        I = P0Item{F.w_gu + (size_t)e * D * 2 * FF, F.ws + WS_WGUT + ((size_t)((e * 8 + pn) * NTE + kt) << 15), 2 * FF, (128 / ES) * kt, 128 * pn, FF + 128 * pn, MOE_FP8 != 0}; return; }
    it -= I_GU;
    { const int pn = it / NTE, kt = it % NTE;
      I = P0Item{F.w_dn + (size_t)e * FF * D, F.ws + WS_WDT + ((size_t)((e * 4 + pn) * NTE + kt) << 15), D, (128 / ES) * kt, 256 * pn, 256 * pn + 128, MOE_FP8 != 0}; }
}
__device__ __forceinline__ void p0_load(const P0Item& I, int lane, int wave, f32x4 (&v)[16]) {
    const int n4 = 4 * lane, col = n4 < 128 ? I.seg0 + n4 : I.seg1 + (n4 - 128);
    const int kpw = I.f8 ? 16 : 8;
    const float* src = I.W + (size_t)(I.k0 + kpw * wave) * I.ldn + col;
#pragma unroll
    for (int kk = 0; kk < 8; ++kk) v[kk] = *(const GAS f32x4*)(src + (size_t)kk * I.ldn);
    if (I.f8) {
#pragma unroll
        for (int kk = 8; kk < 16; ++kk) v[kk] = *(const GAS f32x4*)(src + (size_t)kk * I.ldn);
    }
}
constexpr int W16P = 1032;
__device__ __forceinline__ void p0_prep(Frame& F) {
    LAS bf16_t* w16 = (LAS bf16_t*)F.lds;
    LAS float* part = (LAS float*)(F.lds + 16 * W16P * 2);
    for (int i = F.tid; i < 1024 * 16; i += NTHR) { const int k = i >> 4, r = i & 15; w16[r * W16P + k] = (bf16_t)f2bf(F.w_in[(size_t)k * DIN + C_GKL + r]); }
    __syncthreads();
    const int gw = F.bx * NWAVES + F.wave, NGW = F.G * NWAVES;
    bf16_t* XN = (bf16_t*)(F.ws + WS_XN); float* GKL = (float*)(F.ws + WS_GKL);
    { const int lane = F.lane, w = F.wave, fr = lane & 15, fq = lane >> 4, rt = w & 3, kh = w >> 2;
      for (int rep_a = 0; rep_a < 1 + ((REPMASK >> 11) & 1); ++rep_a)
      for (int grp = F.bx; grp < M / 64; grp += F.G) {
        const int m = grp * 64 + rt * 16 + fr;
        const float* xrow = F.x + (size_t)m * D + kh * 512 + 8 * fq; const float* grow = F.g_mix + kh * 512 + 8 * fq;
        f32x4 xv[16][2]; float s2 = 0.f; f32x4 c = (f32x4){0.f, 0.f, 0.f, 0.f};
#pragma unroll
        for (int s = 0; s < 16; ++s) { xv[s][0] = *(const f32x4*)(xrow + 32 * s); xv[s][1] = *(const f32x4*)(xrow + 32 * s + 4); }
#pragma unroll
        for (int s = 0; s < 16; ++s) {
            const f32x4 g0 = *(const f32x4*)(grow + 32 * s), g1 = *(const f32x4*)(grow + 32 * s + 4);
            const f32x4 x0 = xv[s][0], x1v = xv[s][1];
            s2 += (x0.x * x0.x + x0.y * x0.y) + (x0.z * x0.z + x0.w * x0.w) + (x1v.x * x1v.x + x1v.y * x1v.y) + (x1v.z * x1v.z + x1v.w * x1v.w);
            xv[s][0] = x0 * g0; xv[s][1] = x1v * g1;
            const u32x4 hv = {pk2(xv[s][0].x, xv[s][0].y), pk2(xv[s][0].z, xv[s][0].w), pk2(xv[s][1].x, xv[s][1].y), pk2(xv[s][1].z, xv[s][1].w)};
            const bf16x8 bb = *(const LAS bf16x8*)(w16 + fr * W16P + kh * 512 + 32 * s + 8 * fq);
            c = __builtin_amdgcn_mfma_f32_16x16x32_bf16(__builtin_bit_cast(bf16x8, hv), bb, c, 0, 0, 0);
        }
        s2 += __shfl_xor(s2, 16); s2 += __shfl_xor(s2, 32);
#pragma unroll
        for (int r = 0; r < 4; ++r) part[(kh * 64 + rt * 16 + 4 * fq + r) * 17 + fr] = c[r];
        if (fq == 0) part[(kh * 64 + rt * 16 + fr) * 17 + 16] = s2;
        __syncthreads();
        const int rowl = rt * 16 + fr;
        const float rstd = __builtin_amdgcn_rsqf((part[rowl * 17 + 16] + part[(64 + rowl) * 17 + 16]) * (1.0f / D) + RMS_EPS);
#pragma unroll
        for (int s = 0; s < 16; ++s) { const f32x4 a = xv[s][0] * rstd, b = xv[s][1] * rstd;
            const u32x4 o = {pk2(a.x, a.y), pk2(a.z, a.w), pk2(b.x, b.y), pk2(b.z, b.w)};
            *(GAS u32x4*)((unsigned char*)XN + tiled_off(m, 2 * (kh * 512 + 32 * s + 8 * fq), D / 64)) = o; }
        if (F.tid < 64) { const int row = F.tid; const float rs = __builtin_amdgcn_rsqf((part[row * 17 + 16] + part[(64 + row) * 17 + 16]) * (1.0f / D) + RMS_EPS);
#pragma unroll
            for (int q = 0; q < 4; ++q) { f32x4 o;
#pragma unroll
                for (int j = 0; j < 4; ++j) o[j] = (part[row * 17 + 4 * q + j] + part[(64 + row) * 17 + 4 * q + j]) * rs;
                *(f32x4*)(GKL + (size_t)(grp * 64 + row) * 16 + 4 * q) = o; } }
        __syncthreads();
      }
    }
    __syncthreads();
    {
        constexpr int ES = MOE_FP8 ? 1 : 2, NTE = D * ES / 128;
        constexpr int NITEMS = (NPROJ / 256) * 16 + (D / 256) * 16 + NE * ((2 * FF / 256) * NTE + (D / 256) * NTE);
        LAS unsigned char* img = F.lds;
        const int lane = F.lane, w = F.wave;
        for (int rep_b = 0; rep_b < 1 + ((REPMASK >> 12) & 1); ++rep_b) {
        P0Item ci, ni; f32x4 cv[16], nv[16];
        if (F.bx < NITEMS) { p0_decode(F, F.bx, ci); p0_load(ci, lane, w, cv); }
        for (int it = F.bx; it < NITEMS; it += F.G) {
            const bool hn = it + F.G < NITEMS;
            if (hn) { p0_decode(F, it + F.G, ni); p0_load(ni, lane, w, nv); }
#pragma unroll
            for (int j = 0; j < 4; ++j) { u32x4 o;
                if (ci.f8) { o.x = pk4_fp8(cv[0][j] * 32.f, cv[1][j] * 32.f, cv[2][j] * 32.f, cv[3][j] * 32.f); o.y = pk4_fp8(cv[4][j] * 32.f, cv[5][j] * 32.f, cv[6][j] * 32.f, cv[7][j] * 32.f);
                             o.z = pk4_fp8(cv[8][j] * 32.f, cv[9][j] * 32.f, cv[10][j] * 32.f, cv[11][j] * 32.f); o.w = pk4_fp8(cv[12][j] * 32.f, cv[13][j] * 32.f, cv[14][j] * 32.f, cv[15][j] * 32.f); }
                else { o.x = pk2(cv[0][j], cv[1][j]); o.y = pk2(cv[2][j], cv[3][j]); o.z = pk2(cv[4][j], cv[5][j]); o.w = pk2(cv[6][j], cv[7][j]); }
                *(LAS u32x4*)(img + (4 * lane + j) * 128 + ((w ^ (lane & 7)) << 4)) = o; }
            __syncthreads();
#pragma unroll
            for (int q = 0; q < 4; ++q) { const int idx = F.tid + NTHR * q, n = idx >> 3, c = idx & 7;
                const u32x4 o = *(const LAS u32x4*)(img + n * 128 + ((c ^ ((n >> 2) & 7)) << 4));
                *(GAS u32x4*)(ci.dst + (size_t)idx * 16) = o; }
            __syncthreads();
            if (hn) { ci = ni;
#pragma unroll
                for (int kk = 0; kk < 16; ++kk) cv[kk] = nv[kk]; }
        }
        }
    }
}

struct GlaIn { f32x4 gl[4]; u32x4 q, k, v0, v1, g0, g1; };
template <bool OUT>
__device__ __forceinline__ void gla_load(Frame& F, int u, GlaIn& L) {
    const bf16_t* PROJ = (const bf16_t*)(F.ws + WS_PROJ); const float* GKL = (const float*)(F.ws + WS_GKL);
    const int b = u / (NH * NCH), h = (u / NCH) % NH, n = u % NCH, tok0 = b * SEQ + n * CHUNK, tok = tok0 + F.lane, w = F.wave;
#pragma unroll
    for (int q = 0; q < 4; ++q) L.gl[q] = *(const f32x4*)(GKL + (size_t)tok * 16 + 4 * q);
    L.k = *(const u32x4*)(PROJ + (size_t)tok * NPROJ + C_K + h * DK + 8 * w);
    L.v0 = *(const u32x4*)(PROJ + (size_t)tok * NPROJ + C_V + h * DV + 16 * w); L.v1 = *(const u32x4*)(PROJ + (size_t)tok * NPROJ + C_V + h * DV + 16 * w + 8);
    if constexpr (OUT) {
        L.q = *(const u32x4*)(PROJ + (size_t)tok * NPROJ + C_Q + h * DK + 8 * w);
        const bf16_t* gp = PROJ + (size_t)(tok0 + (F.tid >> 3)) * NPROJ + C_G + h * DV + 16 * (F.tid & 7);
        L.g0 = *(const u32x4*)gp; L.g1 = *(const u32x4*)(gp + 8);
    }
}
constexpr int WGK_OFF = 81920;
__device__ __forceinline__ void gla_stage_wgk(Frame& F) {
    LAS float* wgk = (LAS float*)(F.lds + WGK_OFF);
    for (int i = F.tid; i < 17 * 256; i += NTHR) wgk[i] = i < 16 * 256 ? F.w_gk_up[i] : F.b_gk_up[i - 16 * 256];
    __syncthreads();
}
__device__ __forceinline__ void gla_decay(Frame& F, const GlaIn& L, int h, float (&bc)[8], float (&blast)[8]) {
    const LAS float* wgk = (const LAS float*)(F.lds + WGK_OFF);
    const float gl[16] = {L.gl[0].x, L.gl[0].y, L.gl[0].z, L.gl[0].w, L.gl[1].x, L.gl[1].y, L.gl[1].z, L.gl[1].w, L.gl[2].x, L.gl[2].y, L.gl[2].z, L.gl[2].w, L.gl[3].x, L.gl[3].y, L.gl[3].z, L.gl[3].w};
    const int dbase = h * DK + 8 * F.wave;
#pragma unroll
    for (int i = 0; i < 8; ++i) {
        float gk = wgk[16 * 256 + dbase + i];
#pragma unroll
        for (int r = 0; r < 16; ++r) gk += gl[r] * wgk[r * (NH * DK) + dbase + i];
        float la = log_sigmoidf_(gk) * (1.0f / 16.0f);
        la = wave_incl_scan(la);
        bc[i] = la; blast[i] = __builtin_bit_cast(float, __builtin_amdgcn_readlane(__builtin_bit_cast(int, la), 63));
        asm volatile("" ::: "memory");
    }
}

constexpr int LP = 72;
__device__ __forceinline__ void p2_gla_kv(Frame& F) {
    float* KVT = (float*)(F.ws + WS_KVT); float* DEC = (float*)(F.ws + WS_DEC);
    LAS bf16_t* kremT = (LAS bf16_t*)F.lds;
    LAS bf16_t* vT = (LAS bf16_t*)(F.lds + 64 * LP * 2);
    const int lane = F.lane, w = F.wave;
    gla_stage_wgk(F);
    GlaIn cur, nxt;
    if (F.bx < NUNITS_GLA) gla_load<false>(F, F.bx, cur);
    for (int u = F.bx; u < NUNITS_GLA; u += F.G) {
        if (u + F.G < NUNITS_GLA) gla_load<false>(F, u + F.G, nxt);
        const int h = (u / NCH) % NH;
        float bc[8], blast[8];
        gla_decay(F, cur, h, bc, blast);
        const unsigned kw[4] = {cur.k.x, cur.k.y, cur.k.z, cur.k.w};
#pragma unroll
        for (int i = 0; i < 8; ++i) { const float kv = (i & 1) ? bfhi(kw[i >> 1]) : bflo(kw[i >> 1]);
            kremT[(8 * w + i) * LP + lane] = (bf16_t)f2bf(kv * __expf(blast[i] - bc[i])); }
        if (lane == 0) {
#pragma unroll
            for (int i = 0; i < 8; ++i) DEC[(size_t)u * DK + 8 * w + i] = __expf(blast[i]);
        }
        { const unsigned vw[8] = {cur.v0.x, cur.v0.y, cur.v0.z, cur.v0.w, cur.v1.x, cur.v1.y, cur.v1.z, cur.v1.w};
#pragma unroll
          for (int i = 0; i < 16; ++i) vT[(16 * w + i) * LP + lane] = (bf16_t)((i & 1) ? (vw[i >> 1] >> 16) : (vw[i >> 1] & 0xffffu)); }
        __syncthreads();
        const int fr = lane & 15, fq = lane >> 4;
        bf16x8 a[2];
#pragma unroll
        for (int s = 0; s < 2; ++s) a[s] = *(const LAS bf16x8*)(vT + (16 * w + fr) * LP + 8 * fq + 32 * s);
#pragma unroll
        for (int dt = 0; dt < 4; ++dt) {
            f32x4 c = (f32x4){0.f, 0.f, 0.f, 0.f};
#pragma unroll
            for (int s = 0; s < 2; ++s) { const bf16x8 bb = *(const LAS bf16x8*)(kremT + (16 * dt + fr) * LP + 8 * fq + 32 * s); c = __builtin_amdgcn_mfma_f32_16x16x32_bf16(a[s], bb, c, 0, 0, 0); }
#pragma unroll
            for (int r = 0; r < 4; ++r) KVT[((size_t)u * DV + 16 * w + 4 * fq + r) * DK + 16 * dt + fr] = c[r];
        }
        __syncthreads();
        cur.gl[0] = nxt.gl[0]; cur.gl[1] = nxt.gl[1]; cur.gl[2] = nxt.gl[2]; cur.gl[3] = nxt.gl[3]; cur.k = nxt.k; cur.v0 = nxt.v0; cur.v1 = nxt.v1;
    }
}

__device__ __forceinline__ void p3_scan(Frame& F) {
    const float* KVT = (const float*)(F.ws + WS_KVT); const float* DEC = (const float*)(F.ws + WS_DEC); bf16_t* ST = (bf16_t*)(F.ws + WS_ST);
    for (int gid = F.bx * NTHR + F.tid; gid < BATCH * NH * DV * DK; gid += F.G * NTHR) {
        const int bh = gid >> 13, vd = gid & 8191, d = gid & 63;
        float S = 0.f;
#pragma unroll 8
        for (int n = 0; n < NCH; ++n) { const size_t u = (size_t)bh * NCH + n;
            ST[u * (DV * DK) + vd] = (bf16_t)f2bf(S);
            S = DEC[u * DK + d] * S + KVT[u * (DV * DK) + vd]; }
    }
}

constexpr int OTP = 132;
__device__ __forceinline__ void p4_gla_out(Frame& F) {
    const bf16_t* PROJ = (const bf16_t*)(F.ws + WS_PROJ); bf16_t* Y = (bf16_t*)(F.ws + WS_Y);
    LAS bf16_t* qd = (LAS bf16_t*)F.lds;
    LAS bf16_t* kd = (LAS bf16_t*)(F.lds + 64 * LP * 2);
    LAS bf16_t* vT = (LAS bf16_t*)(F.lds + 2 * 64 * LP * 2);
    LAS bf16_t* pm = (LAS bf16_t*)(F.lds + 4 * 64 * LP * 2);
    LAS float* red = (LAS float*)(F.lds + 5 * 64 * LP * 2);
    LAS float* ot = (LAS float*)(F.lds + 5 * 64 * LP * 2 + 512);
    const int lane = F.lane, w = F.wave, fr = lane & 15, fq = lane >> 4;
    const int ct = w & 3, vt0 = 4 * (w >> 2);
    float gng[4];
#pragma unroll
    for (int vi = 0; vi < 4; ++vi) gng[vi] = F.gla_g[16 * (vt0 + vi) + fr];
    gla_stage_wgk(F);
    GlaIn cur, nxt;
    for (int rep_g = 0; rep_g < 1 + ((REPMASK >> 20) & 1); ++rep_g) {
    if (F.bx < NUNITS_GLA) gla_load<true>(F, F.bx, cur);
    for (int u = F.bx; u < NUNITS_GLA; u += F.G) {
        if (u + F.G < NUNITS_GLA) gla_load<true>(F, u + F.G, nxt);
        const int b = u / (NH * NCH), h = (u / NCH) % NH, n = u % NCH;
        const int tok0 = b * SEQ + n * CHUNK;
        bf16x8 stf[4][2];
        { const bf16_t* ST = (const bf16_t*)(F.ws + WS_ST);
#pragma unroll
          for (int vi = 0; vi < 4; ++vi)
#pragma unroll
              for (int s = 0; s < 2; ++s) stf[vi][s] = *(const bf16x8*)(ST + ((size_t)u * DV + 16 * (vt0 + vi) + fr) * DK + 8 * fq + 32 * s); }
        float bc[8], blast[8];
        gla_decay(F, cur, h, bc, blast);
        { const unsigned qw[4] = {cur.q.x, cur.q.y, cur.q.z, cur.q.w}, kw[4] = {cur.k.x, cur.k.y, cur.k.z, cur.k.w};
          u32x4 qo, ko; unsigned qq[4], kk[4];
#pragma unroll
          for (int p = 0; p < 4; ++p) { const float e0 = __expf(bc[2 * p]), e1 = __expf(bc[2 * p + 1]);
              qq[p] = pk2(bflo(qw[p]) * 0.125f * e0, bfhi(qw[p]) * 0.125f * e1);
              kk[p] = pk2(bflo(kw[p]) * __expf(-bc[2 * p]), bfhi(kw[p]) * __expf(-bc[2 * p + 1])); }
          qo.x = qq[0]; qo.y = qq[1]; qo.z = qq[2]; qo.w = qq[3]; ko.x = kk[0]; ko.y = kk[1]; ko.z = kk[2]; ko.w = kk[3];
          *(LAS u32x4*)(qd + lane * LP + 8 * w) = qo; *(LAS u32x4*)(kd + lane * LP + 8 * w) = ko; }
        { const unsigned vw[8] = {cur.v0.x, cur.v0.y, cur.v0.z, cur.v0.w, cur.v1.x, cur.v1.y, cur.v1.z, cur.v1.w};
#pragma unroll
          for (int i = 0; i < 16; ++i) vT[(16 * w + i) * LP + lane] = (bf16_t)((i & 1) ? (vw[i >> 1] >> 16) : (vw[i >> 1] & 0xffffu)); }
        __syncthreads();
        { const int cts = w >> 1;
          bf16x8 a[2];
#pragma unroll
          for (int s = 0; s < 2; ++s) a[s] = *(const LAS bf16x8*)(qd + (16 * cts + fr) * LP + 8 * fq + 32 * s);
#pragma unroll
          for (int jj = 0; jj < 2; ++jj) { const int jt = 2 * (w & 1) + jj;
              f32x4 c = (f32x4){0.f, 0.f, 0.f, 0.f};
#pragma unroll
              for (int s = 0; s < 2; ++s) { const bf16x8 bb = *(const LAS bf16x8*)(kd + (16 * jt + fr) * LP + 8 * fq + 32 * s); c = __builtin_amdgcn_mfma_f32_16x16x32_bf16(a[s], bb, c, 0, 0, 0); }
#pragma unroll
              for (int r = 0; r < 4; ++r) { const int cc = 16 * cts + 4 * fq + r, jcol = 16 * jt + fr; pm[cc * LP + jcol] = (bf16_t)f2bf(jcol <= cc ? c[r] : 0.f); } } }
        __syncthreads();
        bf16x8 ap[2], aq[2];
#pragma unroll
        for (int s = 0; s < 2; ++s) { ap[s] = *(const LAS bf16x8*)(pm + (16 * ct + fr) * LP + 8 * fq + 32 * s); aq[s] = *(const LAS bf16x8*)(qd + (16 * ct + fr) * LP + 8 * fq + 32 * s); }
        f32x4 o[4]; float ss[4] = {0.f, 0.f, 0.f, 0.f};
#pragma unroll
        for (int vi = 0; vi < 4; ++vi) { const int vt = vt0 + vi;
            f32x4 c = (f32x4){0.f, 0.f, 0.f, 0.f};
#pragma unroll
            for (int s = 0; s < 2; ++s) { const bf16x8 bb = *(const LAS bf16x8*)(vT + (16 * vt + fr) * LP + 8 * fq + 32 * s); c = __builtin_amdgcn_mfma_f32_16x16x32_bf16(ap[s], bb, c, 0, 0, 0); }
#pragma unroll
            for (int s = 0; s < 2; ++s) c = __builtin_amdgcn_mfma_f32_16x16x32_bf16(aq[s], stf[vi][s], c, 0, 0, 0);
            o[vi] = c;
#pragma unroll
            for (int r = 0; r < 4; ++r) ss[r] += c[r] * c[r]; }
#pragma unroll
        for (int r = 0; r < 4; ++r) ss[r] = row16_sum(ss[r]);
        if (fr == 0) {
#pragma unroll
            for (int r = 0; r < 4; ++r) red[w * 16 + 4 * fq + r] = ss[r];
        }
        __syncthreads();
#pragma unroll
        for (int r = 0; r < 4; ++r) { const float tot = red[ct * 16 + 4 * fq + r] + red[(ct + 4) * 16 + 4 * fq + r]; const float rstd = __builtin_amdgcn_rsqf(tot * (1.0f / DV) + RMS_EPS);
#pragma unroll
            for (int vi = 0; vi < 4; ++vi) ot[(16 * ct + 4 * fq + r) * OTP + 16 * (vt0 + vi) + fr] = o[vi][r] * rstd * gng[vi]; }
        __syncthreads();
        { const int c = F.tid >> 3, sg = F.tid & 7; const LAS float* op = ot + c * OTP + 16 * sg;
          const unsigned gw[8] = {cur.g0.x, cur.g0.y, cur.g0.z, cur.g0.w, cur.g1.x, cur.g1.y, cur.g1.z, cur.g1.w};
          unsigned ow[8];
#pragma unroll
          for (int q = 0; q < 4; ++q) { const f32x4 ov = *(const LAS f32x4*)(op + 4 * q);
              const float ga = bflo(gw[2 * q]), gb = bfhi(gw[2 * q]), gc = bflo(gw[2 * q + 1]), gd = bfhi(gw[2 * q + 1]);
              ow[2 * q] = pk2(ov.x * (ga * sigmoidf_(ga)), ov.y * (gb * sigmoidf_(gb))); ow[2 * q + 1] = pk2(ov.z * (gc * sigmoidf_(gc)), ov.w * (gd * sigmoidf_(gd))); }
          unsigned char* yp = (unsigned char*)Y + tiled_off(tok0 + c, 2 * (CONVW + h * DV + 16 * sg), D / 64);
          *(u32x4*)yp = (u32x4){ow[0], ow[1], ow[2], ow[3]}; *(u32x4*)(yp + 16) = (u32x4){ow[4], ow[5], ow[6], ow[7]}; }
        __syncthreads();
        cur = nxt;
    }
    }
    for (int rep_c = 0; rep_c < 1 + ((REPMASK >> 21) & 1); ++rep_c)
    for (int it = F.bx * NTHR + F.tid; it < M * (CONVW / 8); it += F.G * NTHR) {
        const int t = it >> 6, c8 = (it & 63) * 8, s = t & (SEQ - 1);
        float acc[8];
#pragma unroll
        for (int j = 0; j < 8; ++j) acc[j] = 0.f;
#pragma unroll
        for (int i = 0; i < 3; ++i) { const int sp = s - 2 + i; if (sp < 0) continue;
            const size_t ro = (size_t)(t - 2 + i) * NPROJ;
            const u32x4 uh = *(const u32x4*)(PROJ + ro + C_UH + c8), gc = *(const u32x4*)(PROJ + ro + C_GC + c8);
            const unsigned uw[4] = {uh.x, uh.y, uh.z, uh.w}, gw[4] = {gc.x, gc.y, gc.z, gc.w};
            const f32x4 w0 = *(const f32x4*)(F.conv_w + i * CONVW + c8), w1 = *(const f32x4*)(F.conv_w + i * CONVW + c8 + 4);
            const float ww[8] = {w0.x, w0.y, w0.z, w0.w, w1.x, w1.y, w1.z, w1.w};
#pragma unroll
            for (int p = 0; p < 4; ++p) { acc[2 * p] += ww[2 * p] * (bflo(uw[p]) * bflo(gw[p])); acc[2 * p + 1] += ww[2 * p + 1] * (bfhi(uw[p]) * bfhi(gw[p])); } }
        const u32x4 gb = *(const u32x4*)(PROJ + (size_t)t * NPROJ + C_GB + c8); const unsigned bw[4] = {gb.x, gb.y, gb.z, gb.w};
        u32x4 o;
        o.x = pk2(bflo(bw[0]) * acc[0], bfhi(bw[0]) * acc[1]); o.y = pk2(bflo(bw[1]) * acc[2], bfhi(bw[1]) * acc[3]);
        o.z = pk2(bflo(bw[2]) * acc[4], bfhi(bw[2]) * acc[5]); o.w = pk2(bflo(bw[3]) * acc[6], bfhi(bw[3]) * acc[7]);
        *(u32x4*)((unsigned char*)Y + tiled_off(t, 2 * c8, D / 64)) = o;
    }
}

constexpr int WRP = 1032;
__device__ __forceinline__ void p6_router(Frame& F) {
    LAS bf16_t* wh = (LAS bf16_t*)F.lds;
    LAS bf16_t* wl = (LAS bf16_t*)(F.lds + 32 * WRP * 2);
    LAS float* lgp = (LAS float*)(F.lds + 2 * 32 * WRP * 2);
    LAS int* hist = (LAS int*)(F.lds + 2 * 32 * WRP * 2 + 2 * 64 * 33 * 4);
    const bf16_t* X1 = (const bf16_t*)(F.ws + WS_X1); bf16_t* XB = (bf16_t*)(F.ws + WS_XN); float* RSTD = (float*)(F.ws + WS_ROUTE + R_RSTD);
    int* TOPI = (int*)(F.ws + WS_ROUTE + R_TOPI); float* TOPG = (float*)(F.ws + WS_ROUTE + R_TOPG); int* HIST = (int*)(F.ws + WS_ROUTE + R_HIST);
    for (int i = F.tid; i < 1024 * 32; i += NTHR) { const int k = i >> 5, e = i & 31; const float wv = F.w_router[i]; const unsigned h = f2bf(wv); const float hf = __builtin_bit_cast(float, h << 16);
        wh[e * WRP + k] = (bf16_t)h; wl[e * WRP + k] = (bf16_t)f2bf(wv - hf); }
    const int lane = F.lane, w = F.wave, fr = lane & 15, fq = lane >> 4, rt = w & 3, kh = w >> 2;
    for (int wg = F.bx; wg < M / 64; wg += F.G) {
        if (F.tid < 32) hist[F.tid] = 0;
        __syncthreads();
        const int m = wg * 64 + rt * 16 + fr;
        const bf16_t* xrow = X1 + (size_t)m * D + kh * 512 + 8 * fq;
        bf16_t* orow = XB + (size_t)m * D + kh * 512 + 8 * fq;
        const float* grow = F.g_ffn + kh * 512 + 8 * fq;
        f32x4 c0 = (f32x4){0.f, 0.f, 0.f, 0.f}, c1 = c0; float s2 = 0.f;
#pragma unroll 4
        for (int s = 0; s < 16; ++s) {
            const u32x4 xr8 = *(const u32x4*)(xrow + 32 * s);
            const f32x4 x0 = {bflo(xr8.x), bfhi(xr8.x), bflo(xr8.y), bfhi(xr8.y)}, x1v = {bflo(xr8.z), bfhi(xr8.z), bflo(xr8.w), bfhi(xr8.w)};
            const f32x4 g0 = *(const f32x4*)(grow + 32 * s), g1 = *(const f32x4*)(grow + 32 * s + 4);
            s2 += (x0.x * x0.x + x0.y * x0.y) + (x0.z * x0.z + x0.w * x0.w) + (x1v.x * x1v.x + x1v.y * x1v.y) + (x1v.z * x1v.z + x1v.w * x1v.w);
            const float xg[8] = {x0.x * g0.x, x0.y * g0.y, x0.z * g0.z, x0.w * g0.w, x1v.x * g1.x, x1v.y * g1.y, x1v.z * g1.z, x1v.w * g1.w};
            unsigned hw[4], lw[4];
#pragma unroll
            for (int p = 0; p < 4; ++p) { const unsigned h0 = f2bf(xg[2 * p]), h1 = f2bf(xg[2 * p + 1]);
                hw[p] = h0 | (h1 << 16);
                lw[p] = pk2(xg[2 * p] - __builtin_bit_cast(float, h0 << 16), xg[2 * p + 1] - __builtin_bit_cast(float, h1 << 16)); }
            const u32x4 hv = {hw[0], hw[1], hw[2], hw[3]}, lv = {lw[0], lw[1], lw[2], lw[3]};
            if constexpr (MOE_FP8) { u32x2 f8; f8.x = pk4_fp8(xg[0], xg[1], xg[2], xg[3]); f8.y = pk4_fp8(xg[4], xg[5], xg[6], xg[7]); *(u32x2*)((unsigned char*)XB + (size_t)m * D + kh * 512 + 8 * fq + 32 * s) = f8; }
            else *(u32x4*)(orow + 32 * s) = hv;
            const bf16x8 ah = __builtin_bit_cast(bf16x8, hv), al = __builtin_bit_cast(bf16x8, lv);
            const int kk = kh * 512 + 32 * s + 8 * fq;
            const bf16x8 bh0 = *(const LAS bf16x8*)(wh + fr * WRP + kk), bh1 = *(const LAS bf16x8*)(wh + (16 + fr) * WRP + kk);
            const bf16x8 bl0 = *(const LAS bf16x8*)(wl + fr * WRP + kk), bl1 = *(const LAS bf16x8*)(wl + (16 + fr) * WRP + kk);
            c0 = __builtin_amdgcn_mfma_f32_16x16x32_bf16(ah, bh0, c0, 0, 0, 0); c1 = __builtin_amdgcn_mfma_f32_16x16x32_bf16(ah, bh1, c1, 0, 0, 0);
            c0 = __builtin_amdgcn_mfma_f32_16x16x32_bf16(al, bh0, c0, 0, 0, 0); c1 = __builtin_amdgcn_mfma_f32_16x16x32_bf16(al, bh1, c1, 0, 0, 0);
            c0 = __builtin_amdgcn_mfma_f32_16x16x32_bf16(ah, bl0, c0, 0, 0, 0); c1 = __builtin_amdgcn_mfma_f32_16x16x32_bf16(ah, bl1, c1, 0, 0, 0);
        }
        s2 += __shfl_xor(s2, 16); s2 += __shfl_xor(s2, 32);
#pragma unroll
        for (int r = 0; r < 4; ++r) { LAS float* dst = lgp + (kh * 64 + rt * 16 + 4 * fq + r) * 33; dst[fr] = c0[r]; dst[16 + fr] = c1[r]; }
        if (fq == 0) lgp[(kh * 64 + rt * 16 + fr) * 33 + 32] = s2;
        __syncthreads();
        if (F.tid < 64) {
            const int row = F.tid, mm = wg * 64 + row;
            const LAS float* p0 = lgp + row * 33; const LAS float* p1 = lgp + (64 + row) * 33;
            const float rstd = 1.0f / sqrtf((p0[32] + p1[32]) * (1.0f / D) + RMS_EPS);
            float l[32];
#pragma unroll
            for (int e = 0; e < 32; ++e) l[e] = (p0[e] + p1[e]) * rstd + F.b_router[e];
            int bi[4]; float bv[4]; unsigned used = 0u;
#pragma unroll
            for (int k = 0; k < 4; ++k) { float best = -3.0e38f; int be = 0;
#pragma unroll
                for (int e = 0; e < 32; ++e) { const bool ok = !((used >> e) & 1u) && l[e] > best; best = ok ? l[e] : best; be = ok ? e : be; }
                used |= 1u << be; bi[k] = be; bv[k] = best; }
            const float e1 = __expf(bv[1] - bv[0]), e2 = __expf(bv[2] - bv[0]), e3 = __expf(bv[3] - bv[0]); const float inv = 1.0f / (1.0f + e1 + e2 + e3);
            *(int4*)(TOPI + (size_t)mm * 4) = make_int4(bi[0], bi[1], bi[2], bi[3]);
            *(f32x4*)(TOPG + (size_t)mm * 4) = (f32x4){inv, e1 * inv, e2 * inv, e3 * inv};
            RSTD[mm] = rstd;
#pragma unroll
            for (int k = 0; k < 4; ++k) atomicAdd((int*)&hist[bi[k]], 1);
        }
        __syncthreads();
        if (F.tid < 32) HIST[wg * 32 + F.tid] = hist[F.tid];
        __syncthreads();
    }
}

__device__ __forceinline__ void p7_slots(Frame& F) {
    LAS int* part = (LAS int*)F.lds;
    LAS int* cnt = part + 1024;
    LAS int* pre = cnt + 32;
    LAS int* pst = pre + 32;
    LAS int* exa = pst + 64;
    const int* TOPI = (const int*)(F.ws + WS_ROUTE + R_TOPI); const float* TOPG = (const float*)(F.ws + WS_ROUTE + R_TOPG); const int* HIST = (const int*)(F.ws + WS_ROUTE + R_HIST);
    int* POS = (int*)(F.ws + WS_ROUTE + R_POS); int* ROWTOK = (int*)(F.ws + WS_ROUTE + R_ROWTOK); float* ROWGATE = (float*)(F.ws + WS_ROUTE + R_ROWGATE); int* META = (int*)(F.ws + WS_ROUTE + R_META);
    const float* RSTD = (const float*)(F.ws + WS_ROUTE + R_RSTD); float* ROWRSTD = (float*)(F.ws + WS_ROUTE + R_ROWRSTD);
    constexpr int NWG = M / 64;
    for (int wg = F.bx; wg < NWG; wg += F.G) {
        { const int e = F.tid & 31, p = F.tid >> 5; int tot = 0, bef = 0;
          for (int q = p * 16; q < p * 16 + 16; ++q) { const int hv = HIST[q * 32 + e]; tot += hv; bef += (q < wg) ? hv : 0; }
          part[(p * 32 + e) * 2] = tot; part[(p * 32 + e) * 2 + 1] = bef; }
        __syncthreads();
        if (F.tid < 32) { int tot = 0, bef = 0; for (int p = 0; p < 16; ++p) { tot += part[(p * 32 + F.tid) * 2]; bef += part[(p * 32 + F.tid) * 2 + 1]; } cnt[F.tid] = tot; pre[F.tid] = bef; }
        __syncthreads();
        if (F.tid == 0) { int s = 0; for (int e = 0; e < 32; ++e) { pst[e] = s; s += (cnt[e] + 255) & ~255; } pst[32] = s; }
        int my_e = 0, tokn = 0, kk = 0; float my_g = 0.f;
        if (F.tid < 256) { tokn = wg * 64 + (F.tid >> 2); kk = F.tid & 3; my_e = TOPI[(size_t)tokn * 4 + kk]; my_g = TOPG[(size_t)tokn * 4 + kk]; exa[F.tid] = my_e; }
        __syncthreads();
        if (F.tid < 256) { int rank = 0; for (int a = 0; a < F.tid; ++a) rank += (exa[a] == my_e) ? 1 : 0;
            const int slot = pst[my_e] + pre[my_e] + rank;
            ROWTOK[slot] = tokn; ROWGATE[slot] = my_g; ROWRSTD[slot] = RSTD[tokn]; POS[(size_t)tokn * 4 + kk] = slot; }
        if (wg < NE) { const int e = wg, c = cnt[e], s0 = pst[e] + c, s1 = pst[e] + ((c + 255) & ~255);
            for (int s = s0 + F.tid; s < s1; s += NTHR) { ROWTOK[s] = 0; ROWGATE[s] = 0.f; ROWRSTD[s] = 0.f; } }
        if (wg == 0) { if (F.tid == 0) META[0] = pst[32] >> 8;
            for (int t = F.tid; t < NTILES_MAX; t += NTHR) { int e = 0; for (int q = 0; q < 32; ++q) e += (t * 256 >= pst[q + 1]) ? 1 : 0; META[32 + t] = e < 32 ? e : 31; } }
        __syncthreads();
    }
}

__device__ __forceinline__ void p10_combine(Frame& F) {
    const bf16_t* X1 = (const bf16_t*)(F.ws + WS_X1); const bf16_t* CB = (const bf16_t*)(F.ws + WS_CONTRIB); const int* POS = (const int*)(F.ws + WS_ROUTE + R_POS);
    const int gw = F.bx * NWAVES + F.wave, NGW = F.G * NWAVES;
    for (int m = gw; m < M; m += NGW) {
        const GAS u32x2* xr = (const GAS u32x2*)(X1 + (size_t)m * D) + F.lane;
        f32x4 v[4];
#pragma unroll
        for (int j = 0; j < 4; ++j) { const u32x2 c = xr[64 * j]; v[j] = (f32x4){bflo(c.x), bfhi(c.x), bflo(c.y), bfhi(c.y)}; }
        const int4 ps = *(const int4*)(POS + (size_t)m * 4); const int pp[4] = {ps.x, ps.y, ps.z, ps.w};
#pragma unroll
        for (int k = 0; k < 4; ++k) { const GAS u32x2* cr = (const GAS u32x2*)(CB + (size_t)pp[k] * D) + F.lane;
#pragma unroll
            for (int j = 0; j < 4; ++j) { const u32x2 c = cr[64 * j]; v[j].x += bflo(c.x); v[j].y += bfhi(c.x); v[j].z += bflo(c.y); v[j].w += bfhi(c.y); } }
        float s2 = 0.f;
#pragma unroll
        for (int j = 0; j < 4; ++j) s2 += (v[j].x * v[j].x + v[j].y * v[j].y) + (v[j].z * v[j].z + v[j].w * v[j].w);
        const float rstd = 1.0f / sqrtf(wave_sum(s2) * (1.0f / D) + RMS_EPS);
        GAS f32x4* orow = (GAS f32x4*)(F.out + (size_t)m * D) + F.lane;
#pragma unroll
        for (int j = 0; j < 4; ++j) { const f32x4 g = *((const GAS f32x4*)F.g_fin + F.lane + 64 * j); orow[64 * j] = v[j] * rstd * g; }
    }
}

__global__ void __launch_bounds__(NTHR, 2) fwd_kernel(Args args) {
    extern __shared__ __attribute__((aligned(16))) unsigned char lds_raw[];
    Frame F;
    F.lds = (LAS unsigned char*)lds_raw;
    F.tid = threadIdx.x; F.lane = F.tid & 63; F.wave = __builtin_amdgcn_readfirstlane(F.tid >> 6); F.G = gridDim.x; F.bx = blockIdx.x;
    F.x = args.in[0]; F.g_mix = args.in[1]; F.w_in = args.in[2]; F.conv_w = args.in[3]; F.w_gk_up = args.in[4]; F.b_gk_up = args.in[5]; F.gla_g = args.in[6]; F.w_out = args.in[7];
    F.g_ffn = args.in[8]; F.w_router = args.in[9]; F.b_router = args.in[10]; F.w_gu = args.in[11]; F.b_gu = args.in[12]; F.w_dn = args.in[13]; F.b_dn = args.in[14]; F.g_fin = args.in[15];
    F.out = args.out; F.ws = args.ws;
    volatile LAS unsigned* MISC = (volatile LAS unsigned*)(F.lds + MISC_OFF);
    for (int u = F.tid; u < 256; u += NTHR) MISC[u] = 0u;
    __syncthreads();
    unsigned* ctl = (unsigned*)(F.ws + WS_CTL);
    XcdBarrier bar; bar.bar = ctl + CW_BAR; bar.x = 0; bar.st = nullptr;
    if (N_LAUNCHES == 1) bar = xcd_barrier_post(ctl + CW_BAR, MISC + 8);
    const int lo = args.ph_lo, hi = args.ph_hi;
#define IN(k) (lo <= (k) && (k) < hi)
#define SEAM(k) do { if (IN(k) && IN((k) + 1)) { xcd_barrier(bar); if (((REPMASK >> 22) & 1) != 0) xcd_barrier(bar); } } while (0)
#define REP(k) for (int rep_ = 0; rep_ < 1 + ((REPMASK >> (k)) & 1); ++rep_)
    const int* META = (const int*)(F.ws + WS_ROUTE + R_META);

    if (IN(0)) REP(0) { p0_prep(F); } SEAM(0);
    if (IN(1)) {
        pg8::StaticOrder S; S.init(M / 256, NPROJ / 256, F.G, F.bx, 1 + ((REPMASK >> 1) & 1));
        pg8::EpiBf16 E{(bf16_t*)(F.ws + WS_PROJ), NPROJ};
        pg8::gemm_phase<pg8::EpiBf16, pg8::StaticOrder, true, false, 1 + ((REPMASK >> 14) & 1)>(F.lds, F.ws + WS_XN, F.ws + WS_W1T, 0, D / 64, nullptr, S, E);
    } SEAM(1);
    if (IN(2)) REP(2) { p2_gla_kv(F); } SEAM(2);
    if (IN(3)) REP(3) { p3_scan(F); } SEAM(3);
    if (IN(4)) REP(4) { p4_gla_out(F); } SEAM(4);
    if (IN(5)) {
        pg8::StaticOrder S; S.init(M / 256, D / 256, F.G, F.bx, 1 + ((REPMASK >> 5) & 1));
        pg8::EpiResBf16 E{F.x, (bf16_t*)(F.ws + WS_X1), D};
        pg8::gemm_phase<pg8::EpiResBf16, pg8::StaticOrder, true, false, 1 + ((REPMASK >> 15) & 1)>(F.lds, F.ws + WS_Y, F.ws + WS_WOT, 0, D / 64, nullptr, S, E);
    } SEAM(5);
    if (IN(6)) REP(6) { p6_router(F); } SEAM(6);
    if (IN(7)) REP(7) { p7_slots(F); } SEAM(7);
    if (IN(8)) {
        const int ntiles = META[0];
        LAS int* te = (LAS int*)(F.lds + TE_OFF); LAS int* utab = te + NTILES_MAX;
        LAS unsigned short* ridx = (LAS unsigned short*)(F.lds + TE_OFF + 2048); LAS float* rstd = (LAS float*)(F.lds + TE_OFF + 2048 + pg8::UCAP * 512); LAS float* bias = rstd + pg8::UCAP * 256;
        for (int i = F.tid; i < NTILES_MAX; i += NTHR) te[i] = META[32 + i];
        __syncthreads();
        pg8::MoeOrder S0; S0.so.init(ntiles, 2 * FF / 256, F.G, F.bx); S0.tile_expert = te;
        int nun = 0;
        { const int* ROWTOK = (const int*)(F.ws + WS_ROUTE + R_ROWTOK); const float* ROWRSTD = (const float*)(F.ws + WS_ROUTE + R_ROWRSTD); pg8::Unit uu;
          for (; nun < pg8::UCAP && S0.next(nun, uu); ++nun) {
              if (F.tid == 0) { utab[4 * nun] = uu.pm; utab[4 * nun + 1] = uu.pn; utab[4 * nun + 2] = uu.pb; utab[4 * nun + 3] = uu.e; }
              if (F.tid < 256) { ridx[nun * 256 + F.tid] = (unsigned short)ROWTOK[uu.pm * 256 + F.tid]; rstd[nun * 256 + F.tid] = ROWRSTD[uu.pm * 256 + F.tid];
                  bias[nun * 256 + F.tid] = F.b_gu[(size_t)uu.e * 2048 + (F.tid >> 7) * 1024 + uu.pn * 128 + (F.tid & 127)]; } }
          __syncthreads(); }
        pg8::TabOrder S{utab, nun, (REPMASK >> 18) & 1};
#ifdef SKEW_TICKS
        { const unsigned long long t0 = __builtin_amdgcn_s_memrealtime(); const unsigned long long dl = (unsigned long long)((F.bx >> 3) & 31) * SKEW_TICKS;
          while (__builtin_amdgcn_s_memrealtime() - t0 < dl) __builtin_amdgcn_s_sleep(2); }
#endif
        pg8::EpiSwiglu E{(bf16_t*)(F.ws + WS_H), bias, rstd};
        constexpr int ES = MOE_FP8 ? 1 : 2;
        pg8::gemm_phase<pg8::EpiSwiglu, pg8::TabOrder, true, MOE_FP8 != 0, 1 + ((REPMASK >> 16) & 1)>(F.lds, F.ws + WS_XN, F.ws + WS_WGUT, D * ES, D * ES / 128, ridx, S, E);
    } SEAM(8);
    if (IN(9)) {
        const int ntiles = META[0];
        LAS int* te = (LAS int*)(F.lds + TE_OFF); LAS int* utab = te + NTILES_MAX;
        LAS float* gate = (LAS float*)(F.lds + TE_OFF + 2048); LAS float* bias = gate + pg8::UCAP * 256;
        for (int i = F.tid; i < NTILES_MAX; i += NTHR) te[i] = META[32 + i];
        __syncthreads();
        pg8::MoeOrder S0; S0.so.init(ntiles, D / 256, F.G, F.bx); S0.tile_expert = te;
        int nun = 0;
        { const float* ROWGATE = (const float*)(F.ws + WS_ROUTE + R_ROWGATE); pg8::Unit uu;
          for (; nun < pg8::UCAP && S0.next(nun, uu); ++nun) {
              if (F.tid == 0) { utab[4 * nun] = uu.pm; utab[4 * nun + 1] = uu.pn; utab[4 * nun + 2] = uu.pb; utab[4 * nun + 3] = uu.e; }
              if (F.tid < 256) { gate[nun * 256 + F.tid] = ROWGATE[uu.pm * 256 + F.tid]; bias[nun * 256 + F.tid] = F.b_dn[(size_t)uu.e * D + uu.pn * 256 + F.tid]; } }
          __syncthreads(); }
        pg8::TabOrder S{utab, nun, (REPMASK >> 19) & 1};
        pg8::EpiDown E{(bf16_t*)(F.ws + WS_CONTRIB), bias, gate};
        constexpr int ES = MOE_FP8 ? 1 : 2;
        pg8::gemm_phase<pg8::EpiDown, pg8::TabOrder, true, MOE_FP8 != 0, 1 + ((REPMASK >> 17) & 1)>(F.lds, F.ws + WS_H, F.ws + WS_WDT, 0, FF * ES / 128, nullptr, S, E);
    } SEAM(9);
    if (IN(10)) REP(10) { p10_combine(F); }
#undef IN
#undef SEAM
}

extern "C" void kernel_launch(void* const* d_in, const int* in_sizes, int n_in, void* d_out, int out_size, void* d_ws, size_t ws_size, hipStream_t stream) {
    static int grid = 0;
    if (grid == 0) {
        if (n_in != 16 || in_sizes[0] != M * D || out_size != M * D || ws_size < WS_END) { fprintf(stderr, "kernel_launch: unexpected shapes (n_in %d, in0 %d, out %d, ws %zu < %zu)\n", n_in, n_in > 0 ? in_sizes[0] : -1, out_size, ws_size, (size_t)WS_END); grid = -1; return; }
        int dev = 0, cus = 0, per_cu = 0;
        if (hipGetDevice(&dev) != hipSuccess || hipDeviceGetAttribute(&cus, hipDeviceAttributeMultiprocessorCount, dev) != hipSuccess) { grid = -1; return; }
        if (hipFuncSetAttribute((const void*)fwd_kernel, hipFuncAttributeMaxDynamicSharedMemorySize, LDS_BYTES) != hipSuccess) { fprintf(stderr, "kernel_launch: hipFuncSetAttribute failed\n"); grid = -1; return; }
        if (hipOccupancyMaxActiveBlocksPerMultiprocessor(&per_cu, (const void*)fwd_kernel, NTHR, LDS_BYTES) != hipSuccess || per_cu < 1) fprintf(stderr, "kernel_launch: occupancy query reports %d\n", per_cu);
        (void)hipGetLastError();
        grid = cus;
    }
    if (grid < 0) return;
    (void)hipMemsetAsync((char*)d_ws + WS_CTL, 0, CTL_ZERO_BYTES, stream);
    Args a{};
    for (int i = 0; i < 16; ++i) a.in[i] = (const float*)d_in[i];
    a.out = (float*)d_out; a.ws = (unsigned char*)d_ws;
    for (int li = 0; li < N_LAUNCHES; ++li) {
        if (N_LAUNCHES == 1) { a.ph_lo = 0; a.ph_hi = NPHASES; } else { a.ph_lo = li; a.ph_hi = li + 1; }
        a.li = li;
        hipLaunchKernelGGL(fwd_kernel, dim3(grid), dim3(NTHR), LDS_BYTES, stream, a);
    }
}
```

```cpp
#include <hip/hip_runtime.h>
#include <cstdio>
#include <cstdint>

#ifndef MK_N_LAUNCHES
#define MK_N_LAUNCHES 1
#endif

#ifndef MOE_FP8
#define MOE_FP8 1
#endif
#ifndef REPMASK
#define REPMASK 0
#endif
#define LAS __attribute__((address_space(3)))
#define GAS __attribute__((address_space(1)))
typedef unsigned short bf16_t;
typedef short bf16x8 __attribute__((ext_vector_type(8)));
typedef float f32x4 __attribute__((ext_vector_type(4)));
typedef float f32x2 __attribute__((ext_vector_type(2)));
typedef unsigned u32x4 __attribute__((ext_vector_type(4)));
typedef unsigned u32x2 __attribute__((ext_vector_type(2)));

constexpr int NWAVES = 8, NTHR = 512;
constexpr int NPHASES = 11;
constexpr int N_LAUNCHES = MK_N_LAUNCHES;
constexpr int BATCH = 4, SEQ = 4096, D = 1024, M = BATCH * SEQ;
constexpr int CONVW = 512, NH = 4, DK = 64, DV = 128, RANK = 16, CHUNK = 64, NCH = SEQ / CHUNK;
constexpr int DIN = 3088, NPROJ = 3072;
constexpr int C_UH = 0, C_GB = 512, C_GC = 1024, C_Q = 1536, C_K = 1792, C_V = 2048, C_G = 2560, C_GKL = 3072;
constexpr int NE = 32, TOPK = 4, FF = 1024;
constexpr int NUNITS_GLA = BATCH * NH * NCH;
constexpr int NROWS_MAX = M * TOPK + NE * 256;
constexpr int NTILES_MAX = NROWS_MAX / 256;
constexpr float RMS_EPS = 1e-5f;

constexpr size_t MiB = 1u << 20;
constexpr size_t WS_CTL = 0, CTL_ZERO_BYTES = 1 * MiB;
constexpr size_t WS_XN = 1 * MiB;
constexpr size_t WS_GKL = WS_XN + 32 * MiB;
constexpr size_t WS_W1T = WS_GKL + 1 * MiB;
constexpr size_t WS_WOT = WS_W1T + 6 * MiB;
constexpr size_t WS_WGUT = WS_WOT + 2 * MiB;
constexpr size_t WS_WDT = WS_WGUT + 128 * MiB;
constexpr size_t WS_PROJ = WS_WDT + 64 * MiB;
constexpr size_t WS_KVT = WS_PROJ + 96 * MiB;
constexpr size_t WS_DEC = WS_KVT + 32 * MiB;
constexpr size_t WS_ST = WS_DEC + 1 * MiB;
constexpr size_t WS_Y = WS_ST + 16 * MiB;
constexpr size_t WS_X1 = WS_Y + 32 * MiB;
constexpr size_t WS_ROUTE = WS_X1 + 64 * MiB;
constexpr size_t WS_H = WS_ROUTE + 2 * MiB;
constexpr size_t WS_CONTRIB = WS_H + 144 * MiB;
constexpr size_t WS_END = WS_CONTRIB + 144 * MiB;
constexpr size_t R_TOPI = 0;
constexpr size_t R_TOPG = 256 * 1024;
constexpr size_t R_POS = 512 * 1024;
constexpr size_t R_ROWTOK = 768 * 1024;
constexpr size_t R_ROWGATE = 1088 * 1024;
constexpr size_t R_HIST = 1408 * 1024;
constexpr size_t R_META = 1472 * 1024;
constexpr size_t R_RSTD = 1536 * 1024;
constexpr size_t R_ROWRSTD = 1664 * 1024;
constexpr int CW_BAR = 4096;

constexpr int LDS_BYTES = 160 * 1024 - 2048;
constexpr int MISC_OFF = LDS_BYTES - 1024;
constexpr int TE_OFF = 131072;

__device__ __forceinline__ unsigned f2bf(float f) { unsigned u = __builtin_bit_cast(unsigned, f); return (u + 0x7fffu + ((u >> 16) & 1u)) >> 16; }
__device__ __forceinline__ unsigned pk2(float lo, float hi) { typedef __bf16 bf2_ __attribute__((ext_vector_type(2))); const f32x2 v = {lo, hi}; return __builtin_bit_cast(unsigned, __builtin_convertvector(v, bf2_)); }
__device__ __forceinline__ float bf2f(unsigned short b) { return __builtin_bit_cast(float, (unsigned)b << 16); }
__device__ __forceinline__ float bflo(unsigned w) { return __builtin_bit_cast(float, w << 16); }
__device__ __forceinline__ float bfhi(unsigned w) { return __builtin_bit_cast(float, w & 0xffff0000u); }
__device__ __forceinline__ unsigned cvt_pk_bf16(float lo, float hi) { unsigned r; asm volatile("v_cvt_pk_bf16_f32 %0, %1, %2" : "=v"(r) : "v"(lo), "v"(hi)); return r; }
__device__ __forceinline__ unsigned pk4_fp8(float a, float b, float c, float d) { int w = 0; w = __builtin_amdgcn_cvt_pk_fp8_f32(a, b, w, false); w = __builtin_amdgcn_cvt_pk_fp8_f32(c, d, w, true); return (unsigned)w; }

__device__ __forceinline__ float sigmoidf_(float x) { return __builtin_amdgcn_rcpf(1.0f + __expf(-x)); }
__device__ __forceinline__ float log_sigmoidf_(float x) { return fminf(x, 0.f) - __logf(1.0f + __expf(-fabsf(x))); }
#define DPPF_(x, ctrl, rm) __builtin_bit_cast(float, __builtin_amdgcn_update_dpp(0, __builtin_bit_cast(int, (x)), (ctrl), (rm), 0xf, false))
__device__ __forceinline__ float row16_sum(float t) { t += DPPF_(t, 0xb1, 0xf); t += DPPF_(t, 0x4e, 0xf); t += DPPF_(t, 0x141, 0xf); t += DPPF_(t, 0x140, 0xf); return t; }
__device__ __forceinline__ float wave_incl_scan(float v) {
    v += DPPF_(v, 0x111, 0xf); v += DPPF_(v, 0x112, 0xf); v += DPPF_(v, 0x114, 0xf); v += DPPF_(v, 0x118, 0xf);
    v += DPPF_(v, 0x142, 0xa); v += DPPF_(v, 0x143, 0xc);
    return v;
}
__device__ __forceinline__ float wave_sum(float v) { const float t = wave_incl_scan(v); return __builtin_bit_cast(float, __builtin_amdgcn_readlane(__builtin_bit_cast(int, t), 63)); }
__host__ __device__ __forceinline__ size_t tiled_off(int row, int cbyte, int nt) { return ((size_t)((row >> 8) * nt + (cbyte >> 7)) << 15) + (size_t)(((row & 255) << 7) + (cbyte & 127)); }
#define LDS_WAIT() asm volatile("s_waitcnt lgkmcnt(0)" ::: "memory")
#define VM_WAIT() asm volatile("s_waitcnt vmcnt(0)" ::: "memory")

#define XB_TMO      128
#define XB_XCNT(j)  (256  + 64 * (j))
#define XB_XSUB(j)  (1280 + 64 * (j))
#define XB_XGEN(j)  (2304 + 64 * (j))
#define XB_TOP      3328
#define XB_TOPGEN   3392
#define XCD_BAR_WORDS 3456
#define XB_SPIN_CAP (1u << 18)
__device__ __forceinline__ unsigned xb_ld(unsigned* p)              { return __hip_atomic_load(p, __ATOMIC_RELAXED, __HIP_MEMORY_SCOPE_AGENT); }
__device__ __forceinline__ unsigned xb_add(unsigned* p, unsigned v) { return __hip_atomic_fetch_add(p, v, __ATOMIC_RELAXED, __HIP_MEMORY_SCOPE_AGENT); }
__device__ __forceinline__ unsigned xb_xcc_id() { return (unsigned)__builtin_amdgcn_s_getreg((3 << 11) | 20) & 0xFu; }
#define XB_SPIN(cond, bar) do { unsigned _sp = 0; while (cond) { __builtin_amdgcn_s_sleep(1); \
    if ((++_sp & 255u) == 0u) { if (xb_ld(&(bar)[XB_TMO])) break; if (_sp > XB_SPIN_CAP) { atomicAdd(&(bar)[XB_TMO], 1u); break; } } } } while (0)
struct XcdBarrier { unsigned* bar; unsigned x; volatile LAS unsigned* st; };
__device__ __forceinline__ XcdBarrier xcd_barrier_post(unsigned* bar, volatile LAS unsigned* st) {
    XcdBarrier b; b.bar = bar; b.x = xb_xcc_id(); b.st = st;
    if (threadIdx.x == 0) (void)xb_add(&bar[XB_XCNT(b.x)], 1u);
    return b;
}
__device__ __forceinline__ void xcd_barrier_complete(unsigned* bar, unsigned x, unsigned& nloc, unsigned& nx) {
    const unsigned G = gridDim.x * gridDim.y * gridDim.z;
    unsigned sum, cnt, mine, sp = 0u;
    for (;;) {
        sum = 0u; cnt = 0u; mine = 0u;
#pragma unroll
        for (unsigned j = 0; j < 16; ++j) { const unsigned c = xb_ld(&bar[XB_XCNT(j)]); sum += c; cnt += (c > 0u) ? 1u : 0u; mine = (j == x) ? c : mine; }
        if (sum == G) break;
        __builtin_amdgcn_s_sleep(1);
        if ((++sp & 255u) == 0u) { if (xb_ld(&bar[XB_TMO])) break; if (sp > XB_SPIN_CAP) { atomicAdd(&bar[XB_TMO], 1u); break; } }
    }
    nloc = mine > 0u ? mine : 1u; nx = cnt > 0u ? cnt : 1u;
}
__device__ __forceinline__ void xcd_barrier(const XcdBarrier& b) {
    asm volatile("s_waitcnt vmcnt(0)" ::: "memory");
    __syncthreads();
    if (threadIdx.x == 0) {
        unsigned* bar = b.bar;
        __builtin_amdgcn_s_waitcnt(0);
        unsigned nloc = b.st[0], nx = b.st[1];
        if (nloc == 0u) { xcd_barrier_complete(bar, b.x, nloc, nx); b.st[0] = nloc; b.st[1] = nx; }
        const unsigned old = xb_add(&bar[XB_XSUB(b.x)], 1u);
        const unsigned gen = old / nloc;
        if (old + 1u == (gen + 1u) * nloc) {
            __builtin_amdgcn_fence(__ATOMIC_RELEASE, "agent");
            asm volatile("s_waitcnt vmcnt(0)" ::: "memory");
            const unsigned og = xb_add(&bar[XB_TOP], 1u);
            const unsigned tg = og / nx;
            if (og + 1u == (tg + 1u) * nx) xb_add(&bar[XB_TOPGEN], 1u);
            else XB_SPIN(xb_ld(&bar[XB_TOPGEN]) == tg, bar);
            __builtin_amdgcn_fence(__ATOMIC_ACQUIRE, "agent");
            xb_add(&bar[XB_XGEN(b.x)], 1u);
            asm volatile("s_waitcnt vmcnt(0)" ::: "memory");
        } else {
            XB_SPIN(xb_ld(&bar[XB_XGEN(b.x)]) == gen, bar);
            __builtin_amdgcn_fence(__ATOMIC_ACQUIRE, "agent");
            asm volatile("s_waitcnt vmcnt(0)" ::: "memory");
        }
    }
    __syncthreads();
}

namespace pg8 {
constexpr int BM = 256, BK = 64, HALF = 128, HTB = HALF * BK * 2, STAGE_BYTES = 8 * HTB, NXCD = 8, WGM = 8;
__host__ __device__ __forceinline__ int lds_byte(int r, int c) { const int st = (r >> 4) * 2 + (c >> 5), rr = r & 15, cc = c & 31, ob = rr * 64 + cc * 2; return st * 1024 + (ob ^ (((ob >> 9) & 1) << 5)); }
__host__ __device__ __forceinline__ void stage_rc(int b, int& R, int& C) { const int st = b / 1024, sb = b % 1024, swz = sb ^ (((sb >> 9) & 1) << 5); R = (st >> 1) * 16 + swz / 64; C = (st & 1) * 32 + (swz % 64) / 2; }
__host__ __device__ __forceinline__ int perm32(int rho) { const int n = rho >> 4, i = rho & 15; return 8 * (i >> 2) + 4 * n + (i & 3); }
struct Unit { int pm, pn, pb, e, i; };
struct StaticOrder {
    int nM, nN, nwg, G, c, reps;
    __host__ __device__ void init(int nM_, int nN_, int G_, int c_, int reps_ = 1) { nM = nM_; nN = nN_; nwg = nM * nN; G = G_; c = c_; reps = reps_; }
    __host__ __device__ bool next(int i, Unit& u) const {
        const long L = (long)i * G + c; if (L >= (long)nwg * reps) return false;
        int wgid = (int)(L % nwg); { const int q = nwg / NXCD, r = nwg % NXCD, xcd = wgid % NXCD, off = wgid / NXCD; wgid = (xcd < r ? xcd * (q + 1) : r * (q + 1) + (xcd - r) * q) + off; }
        const int nig = WGM * nN, gid = wgid / nig, fm = gid * WGM, gsz = (nM - fm) < WGM ? (nM - fm) : WGM;
        u.pm = fm + ((wgid % nig) % gsz); u.pn = (wgid % nig) / gsz; u.pb = u.pn; u.e = 0; u.i = i; return true;
    }
};
struct MoeOrder {
    StaticOrder so; const LAS int* tile_expert;
    __device__ bool next(int i, Unit& u) const { if (!so.next(i, u)) return false; u.e = __builtin_amdgcn_readfirstlane(tile_expert[u.pm]); u.pb = u.e * so.nN + u.pn; return true; }
};
struct TabOrder {
    const LAS int* tab; int n; int dup;
    __device__ bool next(int i, Unit& u) const { if (i >= (n << dup)) return false; const LAS int* p = tab + 4 * (i >> dup);
        u.pm = __builtin_amdgcn_readfirstlane(p[0]); u.pn = __builtin_amdgcn_readfirstlane(p[1]); u.pb = __builtin_amdgcn_readfirstlane(p[2]); u.e = __builtin_amdgcn_readfirstlane(p[3]); u.i = i >> dup; return true; }
};
constexpr int UCAP = 10;
typedef int i32x8 __attribute__((ext_vector_type(8)));
typedef int i32x4 __attribute__((ext_vector_type(4)));
template <class Epi, class Sched, bool ALIGN_EPI, bool FP8, int NPASS = 1>
__device__ __forceinline__ void gemm_phase(LAS unsigned char* lds, const void* A, const void* Bt, const int ldA, const int nt, const LAS unsigned short* rowidx, const Sched& S, const Epi& E) {
    const int tid = threadIdx.x, wid = __builtin_amdgcn_readfirstlane(tid >> 6), lane = tid & 63, wr = wid >> 2, wc = wid & 3, fr = lane & 15, fq = lane >> 4;
    unsigned voffB[2];
#pragma unroll
    for (int i = 0; i < 2; ++i) { int R, C; stage_rc(tid * 16 + i * 8192, R, C); const int Rb = Epi::PERM ? ((R & ~31) + perm32(R & 31)) : R; voffB[i] = (unsigned)(Rb * 128 + C * 2); }
    const size_t kstep = 32768, kstepA = rowidx ? (size_t)128 : (size_t)32768;
    const size_t hstep = 16384;
    const size_t tstep = (size_t)nt * 32768;
    const unsigned ldsw = (unsigned)wid * 1024u;
    const int aoff = lds_byte(wr * 64 + fr, fq * 8), boff = lds_byte(wc * 32 + fr, fq * 8);
#define PG8_SA(b, h) (((b) * 2 + (h)) * HTB)
#define PG8_SB(b, h) ((4 + (b) * 2 + (h)) * HTB)
#define PG8_STAGE(bufoff, gbase, voff) do { _Pragma("unroll") for (int _i = 0; _i < 2; ++_i) \
        __builtin_amdgcn_global_load_lds((const unsigned*)((const char*)(gbase) + (voff)[_i]), (LAS unsigned*)(lds + (bufoff) + ldsw + _i * 8192), 16, 0, 0); } while (0)
#define PG8_LDA(dst, b, h) do { _Pragma("unroll") for (int m = 0; m < 4; ++m) _Pragma("unroll") for (int k = 0; k < 2; ++k) dst[m][k] = *(const LAS bf16x8*)(lds + PG8_SA(b, h) + aoff + m * 2048 + k * 1024); } while (0)
#define PG8_LDB(dst, b, h) do { _Pragma("unroll") for (int n = 0; n < 2; ++n) _Pragma("unroll") for (int k = 0; k < 2; ++k) dst[n][k] = *(const LAS bf16x8*)(lds + PG8_SB(b, h) + boff + n * 2048 + k * 1024); } while (0)
#define PG8_F8(x) __builtin_shufflevector(__builtin_bit_cast(i32x4, (x)[0]), __builtin_bit_cast(i32x4, (x)[1]), 0, 1, 2, 3, 4, 5, 6, 7)
#define PG8_MMA(ai, bj, At, Bt_) do { __builtin_amdgcn_s_setprio(1); _Pragma("unroll") for (int m = 0; m < 4; ++m) _Pragma("unroll") for (int n = 0; n < 2; ++n) { \
        if constexpr (FP8) { const i32x8 _a = PG8_F8(Bt_[n]), _b = PG8_F8(At[m]); \
            asm volatile("v_mfma_scale_f32_16x16x128_f8f6f4 %0, %1, %2, %0, %3, %4 op_sel_hi:[0,0,0]" : "+v"(acc[ai][bj][m][n]) : "v"(_a), "v"(_b), "v"(sclW), "v"(sclX)); } \
        else { _Pragma("unroll") for (int k = 0; k < 2; ++k) acc[ai][bj][m][n] = __builtin_amdgcn_mfma_f32_16x16x32_bf16(Bt_[n][k], At[m][k], acc[ai][bj][m][n], 0, 0, 0); } } \
        __builtin_amdgcn_s_setprio(0); } while (0)
#define PG8_WAIT_V(n) asm volatile("s_waitcnt vmcnt(" #n ")" ::: "memory")
#define PG8_WAIT_L(n) asm volatile("s_waitcnt lgkmcnt(" #n ")" ::: "memory")
#define PG8_WAIT_VR(rx) do { if (rx) { if constexpr (Epi::NST == 16) PG8_WAIT_V(24); else if constexpr (Epi::NST == 8) PG8_WAIT_V(16); else PG8_WAIT_V(8); } else PG8_WAIT_V(8); } while (0)
#define PG8_BAR __builtin_amdgcn_s_barrier()
#define PG8_SCHED __builtin_amdgcn_sched_barrier(0)
#define PG8_AOFF(dst, u, uo) do { _Pragma("unroll") for (int _h = 0; _h < 2; ++_h) _Pragma("unroll") for (int _i = 0; _i < 2; ++_i) { int _R, _C; stage_rc(tid * 16 + _i * 8192, _R, _C); \
        dst[_h][_i] = rowidx ? (unsigned)((int)rowidx[(u).i * BM + _h * HALF + _R] * ldA + _C * 2) : (unsigned)(((u).pm * nt << 15) + ((_h * HALF + _R) << 7) + _C * 2); } } while (0)
    Unit cur, nxt; int ui = 0;
    if (!S.next(0, cur)) return;
    f32x4 acc[2][2][4][2];
#pragma unroll
    for (int a = 0; a < 2; ++a)
#pragma unroll
        for (int b = 0; b < 2; ++b)
#pragma unroll
            for (int m = 0; m < 4; ++m)
#pragma unroll
                for (int n = 0; n < 2; ++n) acc[a][b][m][n] = (f32x4){0.f, 0.f, 0.f, 0.f};
    bf16x8 At[4][2], B0[2][2], B1[2][2];
    int sclW = 0x7A7A7A7A, sclX = 0x7F7F7F7F;
    asm volatile("" : "+v"(sclW), "+v"(sclX));
    unsigned ca[2][2], na[2][2];
    PG8_AOFF(ca, cur, 0);
    const char* cA = (const char*)A; const char* cB = (const char*)Bt + (size_t)cur.pb * tstep;
    PG8_STAGE(PG8_SB(0, 0), cB, voffB); PG8_STAGE(PG8_SB(0, 1), cB + hstep, voffB); PG8_STAGE(PG8_SA(0, 0), cA, ca[0]); PG8_STAGE(PG8_SA(0, 1), cA, ca[1]);
    if (wr == 1) PG8_BAR;
    PG8_WAIT_V(2); PG8_BAR;
    PG8_STAGE(PG8_SB(1, 0), cB + kstep, voffB); PG8_STAGE(PG8_SA(1, 0), cA + kstepA, ca[0]); PG8_STAGE(PG8_SB(1, 1), cB + hstep + kstep, voffB);
    PG8_WAIT_V(6); PG8_BAR;
    for (;;) {
        const bool has_next = S.next(ui + 1, nxt);
        if (has_next) { PG8_AOFF(na, nxt, ui + 1); }
        else {
#pragma unroll
            for (int h = 0; h < 2; ++h)
#pragma unroll
                for (int i = 0; i < 2; ++i) na[h][i] = ca[h][i];
        }
        const char* nB = has_next ? (const char*)Bt + (size_t)nxt.pb * tstep : cB;
#pragma unroll 1
        for (int pass = 0; pass < NPASS; ++pass)
#pragma unroll 1
        for (int t = 0; t < nt; t += 2) {
            const bool lastp = (pass == NPASS - 1);
            const bool last = (t == nt - 2);
            const char* a1 = cA + (size_t)(t + 1) * kstepA;
            const char* a2 = last ? cA : cA + (size_t)(t + 2) * kstepA; const char* b2 = last ? (lastp ? nB : cB) : cB + (size_t)(t + 2) * kstep;
            const char* a3 = a2 + kstepA; const char* b3 = b2 + kstep;
            unsigned o2[2][2];
#pragma unroll
            for (int h = 0; h < 2; ++h)
#pragma unroll
                for (int i = 0; i < 2; ++i) o2[h][i] = (last && lastp) ? na[h][i] : ca[h][i];
            constexpr bool relax = false;
            PG8_LDB(B0, 0, 0); PG8_LDB(B1, 0, 1); PG8_SCHED; PG8_LDA(At, 0, 0); PG8_STAGE(PG8_SA(1, 1), a1, ca[1]);
            PG8_WAIT_VR(relax); PG8_WAIT_L(0); PG8_BAR; PG8_MMA(0, 0, At, B0); PG8_MMA(0, 1, At, B1); PG8_BAR; PG8_SCHED;
            PG8_LDA(At, 0, 1); PG8_STAGE(PG8_SB(0, 0), b2, voffB); PG8_STAGE(PG8_SB(0, 1), b2 + hstep, voffB); PG8_STAGE(PG8_SA(0, 0), a2, o2[0]);
            PG8_WAIT_VR(relax); PG8_WAIT_L(0); PG8_BAR; PG8_MMA(1, 0, At, B0); PG8_MMA(1, 1, At, B1); PG8_BAR; PG8_SCHED;
            PG8_LDB(B0, 1, 0); PG8_LDB(B1, 1, 1); PG8_SCHED; PG8_LDA(At, 1, 0); PG8_STAGE(PG8_SA(0, 1), a2, o2[1]);
            PG8_WAIT_V(8); PG8_WAIT_L(0); PG8_BAR; PG8_MMA(0, 0, At, B0); PG8_MMA(0, 1, At, B1); PG8_BAR; PG8_SCHED;
            PG8_LDA(At, 1, 1); PG8_STAGE(PG8_SB(1, 0), b3, voffB); PG8_STAGE(PG8_SB(1, 1), b3 + hstep, voffB); PG8_STAGE(PG8_SA(1, 0), a3, o2[0]);
            PG8_WAIT_V(8); PG8_WAIT_L(0); PG8_BAR; PG8_MMA(1, 0, At, B0); PG8_MMA(1, 1, At, B1); PG8_BAR; PG8_SCHED;
        }
        if constexpr (ALIGN_EPI) { if (wr == 0) PG8_BAR; }
        if constexpr (FP8) asm volatile("s_nop 15\n\ts_nop 15" ::: "memory");
        if constexpr (NPASS > 1) {
#pragma unroll
            for (int a = 0; a < 2; ++a)
#pragma unroll
                for (int b = 0; b < 2; ++b)
#pragma unroll
                    for (int m = 0; m < 4; ++m)
#pragma unroll
                        for (int n = 0; n < 2; ++n) acc[a][b][m][n] *= (1.0f / NPASS);
        }
        E(acc, cur, wr, wc, fr, fq);
        if constexpr (((REPMASK >> 13) & 1) != 0) { asm volatile("" ::: "memory"); E(acc, cur, wr, wc, fr, fq); }
        if (!has_next) break;
#pragma unroll
        for (int a = 0; a < 2; ++a)
#pragma unroll
            for (int b = 0; b < 2; ++b)
#pragma unroll
                for (int m = 0; m < 4; ++m)
#pragma unroll
                    for (int n = 0; n < 2; ++n) acc[a][b][m][n] = (f32x4){0.f, 0.f, 0.f, 0.f};
        cur = nxt; cB = nB; ++ui;
#pragma unroll
        for (int h = 0; h < 2; ++h)
#pragma unroll
            for (int i = 0; i < 2; ++i) ca[h][i] = na[h][i];
        if constexpr (ALIGN_EPI) { if (wr == 1) PG8_BAR; }
    }
    PG8_WAIT_V(0);
    if constexpr (!ALIGN_EPI) { if (wr == 0) PG8_BAR; }
    PG8_BAR;
#undef PG8_SA
#undef PG8_SB
#undef PG8_STAGE
#undef PG8_LDA
#undef PG8_LDB
#undef PG8_MMA
#undef PG8_F8
#undef PG8_WAIT_V
#undef PG8_WAIT_L
#undef PG8_WAIT_VR
#undef PG8_BAR
#undef PG8_SCHED
#undef PG8_AOFF
}

struct EpiBf16 {
    static constexpr bool PERM = true; static constexpr int NST = 16;
    bf16_t* O; int ldc;
    __device__ __forceinline__ void operator()(const f32x4 (&acc)[2][2][4][2], const Unit& u, int wr, int wc, int fr, int fq) const {
        const int row0 = u.pm * BM + wr * 64 + fr, col0 = u.pn * BM + wc * 32 + 8 * fq;
#pragma unroll
        for (int ai = 0; ai < 2; ++ai)
#pragma unroll
            for (int m = 0; m < 4; ++m) { bf16_t* rowp = O + (size_t)(row0 + ai * HALF + m * 16) * ldc + col0;
#pragma unroll
                for (int bj = 0; bj < 2; ++bj) { const f32x4 v0 = acc[ai][bj][m][0], v1 = acc[ai][bj][m][1];
                    u32x4 w; w.x = cvt_pk_bf16(v0[0], v0[1]); w.y = cvt_pk_bf16(v0[2], v0[3]); w.z = cvt_pk_bf16(v1[0], v1[1]); w.w = cvt_pk_bf16(v1[2], v1[3]);
                    *(u32x4*)(rowp + bj * HALF) = w; } }
    }
};
struct EpiResBf16 {
    static constexpr bool PERM = true; static constexpr int NST = 0;
    const float* __restrict__ base; bf16_t* __restrict__ O; int ldc;
    __device__ __forceinline__ void operator()(const f32x4 (&acc)[2][2][4][2], const Unit& u, int wr, int wc, int fr, int fq) const {
        const int row0 = u.pm * BM + wr * 64 + fr, col0 = u.pn * BM + wc * 32 + 8 * fq;
#pragma unroll
        for (int ai = 0; ai < 2; ++ai)
#pragma unroll
            for (int mp = 0; mp < 2; ++mp) {
                f32x4 bs[2][2][2];
#pragma unroll
                for (int mm = 0; mm < 2; ++mm)
#pragma unroll
                    for (int bj = 0; bj < 2; ++bj)
#pragma unroll
                        for (int n = 0; n < 2; ++n) bs[mm][bj][n] = *(const f32x4*)(base + (size_t)(row0 + ai * HALF + (2 * mp + mm) * 16) * ldc + col0 + bj * HALF + 4 * n);
#pragma unroll
                for (int mm = 0; mm < 2; ++mm)
#pragma unroll
                    for (int bj = 0; bj < 2; ++bj) { const int m = 2 * mp + mm; const f32x4 v0 = acc[ai][bj][m][0] + bs[mm][bj][0], v1 = acc[ai][bj][m][1] + bs[mm][bj][1];
                        u32x4 w; w.x = cvt_pk_bf16(v0[0], v0[1]); w.y = cvt_pk_bf16(v0[2], v0[3]); w.z = cvt_pk_bf16(v1[0], v1[1]); w.w = cvt_pk_bf16(v1[2], v1[3]);
                        *(u32x4*)(O + (size_t)(row0 + ai * HALF + m * 16) * ldc + col0 + bj * HALF) = w; }
            }
    }
};
struct EpiSwiglu {
    static constexpr bool PERM = true; static constexpr int NST = 8;
    bf16_t* Hb; const LAS float* bias; const LAS float* rstd;
    __device__ __forceinline__ void operator()(const f32x4 (&acc)[2][2][4][2], const Unit& u, int wr, int wc, int fr, int fq) const {
        const int row0 = u.pm * BM + wr * 64 + fr, col0 = u.pn * HALF + wc * 32 + 8 * fq;
        const LAS float* bg = bias + u.i * 256 + wc * 32 + 8 * fq; const LAS float* bu = bg + 128;
        const f32x4 g0 = *(const LAS f32x4*)bg, g1 = *(const LAS f32x4*)(bg + 4), u0 = *(const LAS f32x4*)bu, u1 = *(const LAS f32x4*)(bu + 4);
        float rsv[2][4];
#pragma unroll
        for (int ai = 0; ai < 2; ++ai)
#pragma unroll
            for (int m = 0; m < 4; ++m) rsv[ai][m] = rstd[u.i * 256 + wr * 64 + fr + ai * HALF + m * 16];
#pragma unroll
        for (int ai = 0; ai < 2; ++ai)
#pragma unroll
            for (int m = 0; m < 4; ++m) {
                float r[8]; const float rs = rsv[ai][m];
#pragma unroll
                for (int n = 0; n < 2; ++n)
#pragma unroll
                    for (int j = 0; j < 4; ++j) {
                        float gt = acc[ai][0][m][n][j] * rs + (n ? g1[j] : g0[j]); float up = acc[ai][1][m][n][j] * rs + (n ? u1[j] : u0[j]);
                        gt = fminf(gt, 7.0f); up = fminf(fmaxf(up, -7.0f), 7.0f);
                        const float glu = gt * __builtin_amdgcn_rcpf(1.0f + __builtin_amdgcn_exp2f(gt * (-1.702f * 1.4426950408889634f)));
                        r[n * 4 + j] = (up + 1.0f) * glu; }
                if constexpr (MOE_FP8) { u32x2 w; w.x = pk4_fp8(r[0], r[1], r[2], r[3]); w.y = pk4_fp8(r[4], r[5], r[6], r[7]);
                    *(u32x2*)((unsigned char*)Hb + tiled_off(row0 + ai * HALF + m * 16, col0, FF / 128)) = w; }
                else { u32x4 w; w.x = cvt_pk_bf16(r[0], r[1]); w.y = cvt_pk_bf16(r[2], r[3]); w.z = cvt_pk_bf16(r[4], r[5]); w.w = cvt_pk_bf16(r[6], r[7]);
                    *(u32x4*)((unsigned char*)Hb + tiled_off(row0 + ai * HALF + m * 16, 2 * col0, FF / 64)) = w; } }
    }
};
struct EpiDown {
    static constexpr bool PERM = true; static constexpr int NST = 16;
    bf16_t* Cb; const LAS float* bias; const LAS float* gate;
    __device__ __forceinline__ void operator()(const f32x4 (&acc)[2][2][4][2], const Unit& u, int wr, int wc, int fr, int fq) const {
        const int row0 = u.pm * BM + wr * 64 + fr, col0 = u.pn * BM + wc * 32 + 8 * fq;
        f32x4 bv[2][2]; float gtv[2][4];
#pragma unroll
        for (int bj = 0; bj < 2; ++bj)
#pragma unroll
            for (int n = 0; n < 2; ++n) bv[bj][n] = *(const LAS f32x4*)(bias + u.i * 256 + wc * 32 + 8 * fq + bj * HALF + 4 * n);
#pragma unroll
        for (int ai = 0; ai < 2; ++ai)
#pragma unroll
            for (int m = 0; m < 4; ++m) gtv[ai][m] = gate[u.i * 256 + wr * 64 + fr + ai * HALF + m * 16];
#pragma unroll
        for (int ai = 0; ai < 2; ++ai)
#pragma unroll
            for (int m = 0; m < 4; ++m) { const int row = row0 + ai * HALF + m * 16; const float gt = gtv[ai][m]; bf16_t* rowp = Cb + (size_t)row * D + col0;
#pragma unroll
                for (int bj = 0; bj < 2; ++bj) { const f32x4 v0 = (acc[ai][bj][m][0] + bv[bj][0]) * gt, v1 = (acc[ai][bj][m][1] + bv[bj][1]) * gt;
                    u32x4 w; w.x = cvt_pk_bf16(v0[0], v0[1]); w.y = cvt_pk_bf16(v0[2], v0[3]); w.z = cvt_pk_bf16(v1[0], v1[1]); w.w = cvt_pk_bf16(v1[2], v1[3]);
                    *(u32x4*)(rowp + bj * HALF) = w; } }
    }
};
}

struct Args { const float* in[16]; float* out; unsigned char* ws; int ph_lo, ph_hi, li, pad; };
struct Frame {
    LAS unsigned char* lds; int tid, lane, wave, G, bx;
    const float *x, *g_mix, *w_in, *conv_w, *w_gk_up, *b_gk_up, *gla_g, *w_out, *g_ffn, *w_router, *b_router, *w_gu, *b_gu, *w_dn, *b_dn, *g_fin;
    float* out; unsigned char* ws;
};

struct P0Item { const float* W; unsigned char* dst; int ldn, k0, seg0, seg1; bool f8; };
__device__ __forceinline__ void p0_decode(Frame& F, int it, P0Item& I) {
    constexpr int ES = MOE_FP8 ? 1 : 2, NTE = D * ES / 128;
    constexpr int I_1 = (NPROJ / 256) * 16, I_O = (D / 256) * 16, I_GU = (2 * FF / 256) * NTE, I_DN = (D / 256) * NTE;
    if (it < I_1) { const int tile = it / 16, kt = it % 16; I = P0Item{F.w_in, F.ws + WS_W1T + ((size_t)(tile * 16 + kt) << 15), DIN, 64 * kt, 256 * tile, 256 * tile + 128, false}; return; }
    it -= I_1;
    if (it < I_O) { const int tile = it / 16, kt = it % 16; I = P0Item{F.w_out, F.ws + WS_WOT + ((size_t)(tile * 16 + kt) << 15), D, 64 * kt, 256 * tile, 256 * tile + 128, false}; return; }
    it -= I_O;
    const int e = it / (I_GU + I_DN); it -= e * (I_GU + I_DN);
    if (it < I_GU) { const int pn = it / NTE, kt = it % NTE;
        I = P0Item{F.w_gu + (size_t)e * D * 2 * FF, F.ws + WS_WGUT + ((size_t)((e * 8 + pn) * NTE + kt) << 15), 2 * FF, (128 / ES) * kt, 128 * pn, FF + 128 * pn, MOE_FP8 != 0}; return; }
    it -= I_GU;
    { const int pn = it / NTE, kt = it % NTE;
      I = P0Item{F.w_dn + (size_t)e * FF * D, F.ws + WS_WDT + ((size_t)((e * 4 + pn) * NTE + kt) << 15), D, (128 / ES) * kt, 256 * pn, 256 * pn + 128, MOE_FP8 != 0}; }
}
__device__ __forceinline__ void p0_load(const P0Item& I, int lane, int wave, f32x4 (&v)[16]) {
    const int n4 = 4 * lane, col = n4 < 128 ? I.seg0 + n4 : I.seg1 + (n4 - 128);
    const int kpw = I.f8 ? 16 : 8;
    const float* src = I.W + (size_t)(I.k0 + kpw * wave) * I.ldn + col;
#pragma unroll
    for (int kk = 0; kk < 8; ++kk) v[kk] = *(const GAS f32x4*)(src + (size_t)kk * I.ldn);
    if (I.f8) {
#pragma unroll
        for (int kk = 8; kk < 16; ++kk) v[kk] = *(const GAS f32x4*)(src + (size_t)kk * I.ldn);
    }
}
constexpr int W16P = 1032;
__device__ __forceinline__ void p0_prep(Frame& F) {
    LAS bf16_t* w16 = (LAS bf16_t*)F.lds;
    LAS float* part = (LAS float*)(F.lds + 16 * W16P * 2);
    for (int i = F.tid; i < 1024 * 16; i += NTHR) { const int k = i >> 4, r = i & 15; w16[r * W16P + k] = (bf16_t)f2bf(F.w_in[(size_t)k * DIN + C_GKL + r]); }
    __syncthreads();
    const int gw = F.bx * NWAVES + F.wave, NGW = F.G * NWAVES;
    bf16_t* XN = (bf16_t*)(F.ws + WS_XN); float* GKL = (float*)(F.ws + WS_GKL);
    { const int lane = F.lane, w = F.wave, fr = lane & 15, fq = lane >> 4, rt = w & 3, kh = w >> 2;
      for (int rep_a = 0; rep_a < 1 + ((REPMASK >> 11) & 1); ++rep_a)
      for (int grp = F.bx; grp < M / 64; grp += F.G) {
        const int m = grp * 64 + rt * 16 + fr;
        const float* xrow = F.x + (size_t)m * D + kh * 512 + 8 * fq; const float* grow = F.g_mix + kh * 512 + 8 * fq;
        f32x4 xv[16][2]; float s2 = 0.f; f32x4 c = (f32x4){0.f, 0.f, 0.f, 0.f};
#pragma unroll
        for (int s = 0; s < 16; ++s) { xv[s][0] = *(const f32x4*)(xrow + 32 * s); xv[s][1] = *(const f32x4*)(xrow + 32 * s + 4); }
#pragma unroll
        for (int s = 0; s < 16; ++s) {
            const f32x4 g0 = *(const f32x4*)(grow + 32 * s), g1 = *(const f32x4*)(grow + 32 * s + 4);
            const f32x4 x0 = xv[s][0], x1v = xv[s][1];
            s2 += (x0.x * x0.x + x0.y * x0.y) + (x0.z * x0.z + x0.w * x0.w) + (x1v.x * x1v.x + x1v.y * x1v.y) + (x1v.z * x1v.z + x1v.w * x1v.w);
            xv[s][0] = x0 * g0; xv[s][1] = x1v * g1;
            const u32x4 hv = {pk2(xv[s][0].x, xv[s][0].y), pk2(xv[s][0].z, xv[s][0].w), pk2(xv[s][1].x, xv[s][1].y), pk2(xv[s][1].z, xv[s][1].w)};
            const bf16x8 bb = *(const LAS bf16x8*)(w16 + fr * W16P + kh * 512 + 32 * s + 8 * fq);
            c = __builtin_amdgcn_mfma_f32_16x16x32_bf16(__builtin_bit_cast(bf16x8, hv), bb, c, 0, 0, 0);
        }
        s2 += __shfl_xor(s2, 16); s2 += __shfl_xor(s2, 32);
#pragma unroll
        for (int r = 0; r < 4; ++r) part[(kh * 64 + rt * 16 + 4 * fq + r) * 17 + fr] = c[r];
        if (fq == 0) part[(kh * 64 + rt * 16 + fr) * 17 + 16] = s2;
        __syncthreads();
        const int rowl = rt * 16 + fr;
        const float rstd = __builtin_amdgcn_rsqf((part[rowl * 17 + 16] + part[(64 + rowl) * 17 + 16]) * (1.0f / D) + RMS_EPS);
#pragma unroll
        for (int s = 0; s < 16; ++s) { const f32x4 a = xv[s][0] * rstd, b = xv[s][1] * rstd;
            const u32x4 o = {pk2(a.x, a.y), pk2(a.z, a.w), pk2(b.x, b.y), pk2(b.z, b.w)};
            *(GAS u32x4*)((unsigned char*)XN + tiled_off(m, 2 * (kh * 512 + 32 * s + 8 * fq), D / 64)) = o; }
        if (F.tid < 64) { const int row = F.tid; const float rs = __builtin_amdgcn_rsqf((part[row * 17 + 16] + part[(64 + row) * 17 + 16]) * (1.0f / D) + RMS_EPS);
#pragma unroll
            for (int q = 0; q < 4; ++q) { f32x4 o;
#pragma unroll
                for (int j = 0; j < 4; ++j) o[j] = (part[row * 17 + 4 * q + j] + part[(64 + row) * 17 + 4 * q + j]) * rs;
                *(f32x4*)(GKL + (size_t)(grp * 64 + row) * 16 + 4 * q) = o; } }
        __syncthreads();
      }
    }
    __syncthreads();
    {
        constexpr int ES = MOE_FP8 ? 1 : 2, NTE = D * ES / 128;
        constexpr int NITEMS = (NPROJ / 256) * 16 + (D / 256) * 16 + NE * ((2 * FF / 256) * NTE + (D / 256) * NTE);
        LAS unsigned char* img = F.lds;
        const int lane = F.lane, w = F.wave;
        for (int rep_b = 0; rep_b < 1 + ((REPMASK >> 12) & 1); ++rep_b) {
        P0Item ci, ni; f32x4 cv[16], nv[16];
        if (F.bx < NITEMS) { p0_decode(F, F.bx, ci); p0_load(ci, lane, w, cv); }
        for (int it = F.bx; it < NITEMS; it += F.G) {
            const bool hn = it + F.G < NITEMS;
            if (hn) { p0_decode(F, it + F.G, ni); p0_load(ni, lane, w, nv); }
#pragma unroll
            for (int j = 0; j < 4; ++j) { u32x4 o;
                if (ci.f8) { o.x = pk4_fp8(cv[0][j] * 32.f, cv[1][j] * 32.f, cv[2][j] * 32.f, cv[3][j] * 32.f); o.y = pk4_fp8(cv[4][j] * 32.f, cv[5][j] * 32.f, cv[6][j] * 32.f, cv[7][j] * 32.f);
                             o.z = pk4_fp8(cv[8][j] * 32.f, cv[9][j] * 32.f, cv[10][j] * 32.f, cv[11][j] * 32.f); o.w = pk4_fp8(cv[12][j] * 32.f, cv[13][j] * 32.f, cv[14][j] * 32.f, cv[15][j] * 32.f); }
                else { o.x = pk2(cv[0][j], cv[1][j]); o.y = pk2(cv[2][j], cv[3][j]); o.z = pk2(cv[4][j], cv[5][j]); o.w = pk2(cv[6][j], cv[7][j]); }
                *(LAS u32x4*)(img + (4 * lane + j) * 128 + ((w ^ (lane & 7)) << 4)) = o; }
            __syncthreads();
#pragma unroll
            for (int q = 0; q < 4; ++q) { const int idx = F.tid + NTHR * q, n = idx >> 3, c = idx & 7;
                const u32x4 o = *(const LAS u32x4*)(img + n * 128 + ((c ^ ((n >> 2) & 7)) << 4));
                *(GAS u32x4*)(ci.dst + (size_t)idx * 16) = o; }
            __syncthreads();
            if (hn) { ci = ni;
#pragma unroll
                for (int kk = 0; kk < 16; ++kk) cv[kk] = nv[kk]; }
        }
        }
    }
}

struct GlaIn { f32x4 gl[4]; u32x4 q, k, v0, v1, g0, g1; };
template <bool OUT>
__device__ __forceinline__ void gla_load(Frame& F, int u, GlaIn& L) {
    const bf16_t* PROJ = (const bf16_t*)(F.ws + WS_PROJ); const float* GKL = (const float*)(F.ws + WS_GKL);
    const int b = u / (NH * NCH), h = (u / NCH) % NH, n = u % NCH, tok0 = b * SEQ + n * CHUNK, tok = tok0 + F.lane, w = F.wave;
#pragma unroll
    for (int q = 0; q < 4; ++q) L.gl[q] = *(const f32x4*)(GKL + (size_t)tok * 16 + 4 * q);
    L.k = *(const u32x4*)(PROJ + (size_t)tok * NPROJ + C_K + h * DK + 8 * w);
    L.v0 = *(const u32x4*)(PROJ + (size_t)tok * NPROJ + C_V + h * DV + 16 * w); L.v1 = *(const u32x4*)(PROJ + (size_t)tok * NPROJ + C_V + h * DV + 16 * w + 8);
    if constexpr (OUT) {
        L.q = *(const u32x4*)(PROJ + (size_t)tok * NPROJ + C_Q + h * DK + 8 * w);
        const bf16_t* gp = PROJ + (size_t)(tok0 + (F.tid >> 3)) * NPROJ + C_G + h * DV + 16 * (F.tid & 7);
        L.g0 = *(const u32x4*)gp; L.g1 = *(const u32x4*)(gp + 8);
    }
}
constexpr int WGK_OFF = 81920;
__device__ __forceinline__ void gla_stage_wgk(Frame& F) {
    LAS float* wgk = (LAS float*)(F.lds + WGK_OFF);
    for (int i = F.tid; i < 17 * 256; i += NTHR) wgk[i] = i < 16 * 256 ? F.w_gk_up[i] : F.b_gk_up[i - 16 * 256];
    __syncthreads();
}
__device__ __forceinline__ void gla_decay(Frame& F, const GlaIn& L, int h, float (&bc)[8], float (&blast)[8]) {
    const LAS float* wgk = (const LAS float*)(F.lds + WGK_OFF);
    const float gl[16] = {L.gl[0].x, L.gl[0].y, L.gl[0].z, L.gl[0].w, L.gl[1].x, L.gl[1].y, L.gl[1].z, L.gl[1].w, L.gl[2].x, L.gl[2].y, L.gl[2].z, L.gl[2].w, L.gl[3].x, L.gl[3].y, L.gl[3].z, L.gl[3].w};
    const int dbase = h * DK + 8 * F.wave;
#pragma unroll
    for (int i = 0; i < 8; ++i) {
        float gk = wgk[16 * 256 + dbase + i];
#pragma unroll
        for (int r = 0; r < 16; ++r) gk += gl[r] * wgk[r * (NH * DK) + dbase + i];
        float la = log_sigmoidf_(gk) * (1.0f / 16.0f);
        la = wave_incl_scan(la);
        bc[i] = la; blast[i] = __builtin_bit_cast(float, __builtin_amdgcn_readlane(__builtin_bit_cast(int, la), 63));
        asm volatile("" ::: "memory");
    }
}

constexpr int LP = 72;
__device__ __forceinline__ void p2_gla_kv(Frame& F) {
    float* KVT = (float*)(F.ws + WS_KVT); float* DEC = (float*)(F.ws + WS_DEC);
    LAS bf16_t* kremT = (LAS bf16_t*)F.lds;
    LAS bf16_t* vT = (LAS bf16_t*)(F.lds + 64 * LP * 2);
    const int lane = F.lane, w = F.wave;
    gla_stage_wgk(F);
    GlaIn cur, nxt;
    if (F.bx < NUNITS_GLA) gla_load<false>(F, F.bx, cur);
    for (int u = F.bx; u < NUNITS_GLA; u += F.G) {
        if (u + F.G < NUNITS_GLA) gla_load<false>(F, u + F.G, nxt);
        const int h = (u / NCH) % NH;
        float bc[8], blast[8];
        gla_decay(F, cur, h, bc, blast);
        const unsigned kw[4] = {cur.k.x, cur.k.y, cur.k.z, cur.k.w};
#pragma unroll
        for (int i = 0; i < 8; ++i) { const float kv = (i & 1) ? bfhi(kw[i >> 1]) : bflo(kw[i >> 1]);
            kremT[(8 * w + i) * LP + lane] = (bf16_t)f2bf(kv * __expf(blast[i] - bc[i])); }
        if (lane == 0) {
#pragma unroll
            for (int i = 0; i < 8; ++i) DEC[(size_t)u * DK + 8 * w + i] = __expf(blast[i]);
        }
        { const unsigned vw[8] = {cur.v0.x, cur.v0.y, cur.v0.z, cur.v0.w, cur.v1.x, cur.v1.y, cur.v1.z, cur.v1.w};
#pragma unroll
          for (int i = 0; i < 16; ++i) vT[(16 * w + i) * LP + lane] = (bf16_t)((i & 1) ? (vw[i >> 1] >> 16) : (vw[i >> 1] & 0xffffu)); }
        __syncthreads();
        const int fr = lane & 15, fq = lane >> 4;
        bf16x8 a[2];
#pragma unroll
        for (int s = 0; s < 2; ++s) a[s] = *(const LAS bf16x8*)(vT + (16 * w + fr) * LP + 8 * fq + 32 * s);
#pragma unroll
        for (int dt = 0; dt < 4; ++dt) {
            f32x4 c = (f32x4){0.f, 0.f, 0.f, 0.f};
#pragma unroll
            for (int s = 0; s < 2; ++s) { const bf16x8 bb = *(const LAS bf16x8*)(kremT + (16 * dt + fr) * LP + 8 * fq + 32 * s); c = __builtin_amdgcn_mfma_f32_16x16x32_bf16(a[s], bb, c, 0, 0, 0); }
#pragma unroll
            for (int r = 0; r < 4; ++r) KVT[((size_t)u * DV + 16 * w + 4 * fq + r) * DK + 16 * dt + fr] = c[r];
        }
        __syncthreads();
        cur.gl[0] = nxt.gl[0]; cur.gl[1] = nxt.gl[1]; cur.gl[2] = nxt.gl[2]; cur.gl[3] = nxt.gl[3]; cur.k = nxt.k; cur.v0 = nxt.v0; cur.v1 = nxt.v1;
    }
}

__device__ __forceinline__ void p3_scan(Frame& F) {
    const float* KVT = (const float*)(F.ws + WS_KVT); const float* DEC = (const float*)(F.ws + WS_DEC); bf16_t* ST = (bf16_t*)(F.ws + WS_ST);
    for (int gid = F.bx * NTHR + F.tid; gid < BATCH * NH * DV * DK; gid += F.G * NTHR) {
        const int bh = gid >> 13, vd = gid & 8191, d = gid & 63;
        float S = 0.f;
#pragma unroll 8
        for (int n = 0; n < NCH; ++n) { const size_t u = (size_t)bh * NCH + n;
            ST[u * (DV * DK) + vd] = (bf16_t)f2bf(S);
            S = DEC[u * DK + d] * S + KVT[u * (DV * DK) + vd]; }
    }
}

constexpr int OTP = 132;
__device__ __forceinline__ void p4_gla_out(Frame& F) {
    const bf16_t* PROJ = (const bf16_t*)(F.ws + WS_PROJ); bf16_t* Y = (bf16_t*)(F.ws + WS_Y);
    LAS bf16_t* qd = (LAS bf16_t*)F.lds;
    LAS bf16_t* kd = (LAS bf16_t*)(F.lds + 64 * LP * 2);
    LAS bf16_t* vT = (LAS bf16_t*)(F.lds + 2 * 64 * LP * 2);
    LAS bf16_t* pm = (LAS bf16_t*)(F.lds + 4 * 64 * LP * 2);
    LAS float* red = (LAS float*)(F.lds + 5 * 64 * LP * 2);
    LAS float* ot = (LAS float*)(F.lds + 5 * 64 * LP * 2 + 512);
    const int lane = F.lane, w = F.wave, fr = lane & 15, fq = lane >> 4;
    const int ct = w & 3, vt0 = 4 * (w >> 2);
    float gng[4];
#pragma unroll
    for (int vi = 0; vi < 4; ++vi) gng[vi] = F.gla_g[16 * (vt0 + vi) + fr];
    gla_stage_wgk(F);
    GlaIn cur, nxt;
    for (int rep_g = 0; rep_g < 1 + ((REPMASK >> 20) & 1); ++rep_g) {
    if (F.bx < NUNITS_GLA) gla_load<true>(F, F.bx, cur);
    for (int u = F.bx; u < NUNITS_GLA; u += F.G) {
        if (u + F.G < NUNITS_GLA) gla_load<true>(F, u + F.G, nxt);
        const int b = u / (NH * NCH), h = (u / NCH) % NH, n = u % NCH;
        const int tok0 = b * SEQ + n * CHUNK;
        bf16x8 stf[4][2];
        { const bf16_t* ST = (const bf16_t*)(F.ws + WS_ST);
#pragma unroll
          for (int vi = 0; vi < 4; ++vi)
#pragma unroll
              for (int s = 0; s < 2; ++s) stf[vi][s] = *(const bf16x8*)(ST + ((size_t)u * DV + 16 * (vt0 + vi) + fr) * DK + 8 * fq + 32 * s); }
        float bc[8], blast[8];
        gla_decay(F, cur, h, bc, blast);
        { const unsigned qw[4] = {cur.q.x, cur.q.y, cur.q.z, cur.q.w}, kw[4] = {cur.k.x, cur.k.y, cur.k.z, cur.k.w};
          u32x4 qo, ko; unsigned qq[4], kk[4];
#pragma unroll
          for (int p = 0; p < 4; ++p) { const float e0 = __expf(bc[2 * p]), e1 = __expf(bc[2 * p + 1]);
              qq[p] = pk2(bflo(qw[p]) * 0.125f * e0, bfhi(qw[p]) * 0.125f * e1);
              kk[p] = pk2(bflo(kw[p]) * __expf(-bc[2 * p]), bfhi(kw[p]) * __expf(-bc[2 * p + 1])); }
          qo.x = qq[0]; qo.y = qq[1]; qo.z = qq[2]; qo.w = qq[3]; ko.x = kk[0]; ko.y = kk[1]; ko.z = kk[2]; ko.w = kk[3];
          *(LAS u32x4*)(qd + lane * LP + 8 * w) = qo; *(LAS u32x4*)(kd + lane * LP + 8 * w) = ko; }
        { const unsigned vw[8] = {cur.v0.x, cur.v0.y, cur.v0.z, cur.v0.w, cur.v1.x, cur.v1.y, cur.v1.z, cur.v1.w};
#pragma unroll
          for (int i = 0; i < 16; ++i) vT[(16 * w + i) * LP + lane] = (bf16_t)((i & 1) ? (vw[i >> 1] >> 16) : (vw[i >> 1] & 0xffffu)); }
        __syncthreads();
        { const int cts = w >> 1;
          bf16x8 a[2];
#pragma unroll
          for (int s = 0; s < 2; ++s) a[s] = *(const LAS bf16x8*)(qd + (16 * cts + fr) * LP + 8 * fq + 32 * s);
#pragma unroll
          for (int jj = 0; jj < 2; ++jj) { const int jt = 2 * (w & 1) + jj;
              f32x4 c = (f32x4){0.f, 0.f, 0.f, 0.f};
#pragma unroll
              for (int s = 0; s < 2; ++s) { const bf16x8 bb = *(const LAS bf16x8*)(kd + (16 * jt + fr) * LP + 8 * fq + 32 * s); c = __builtin_amdgcn_mfma_f32_16x16x32_bf16(a[s], bb, c, 0, 0, 0); }
#pragma unroll
              for (int r = 0; r < 4; ++r) { const int cc = 16 * cts + 4 * fq + r, jcol = 16 * jt + fr; pm[cc * LP + jcol] = (bf16_t)f2bf(jcol <= cc ? c[r] : 0.f); } } }
        __syncthreads();
        bf16x8 ap[2], aq[2];
#pragma unroll
        for (int s = 0; s < 2; ++s) { ap[s] = *(const LAS bf16x8*)(pm + (16 * ct + fr) * LP + 8 * fq + 32 * s); aq[s] = *(const LAS bf16x8*)(qd + (16 * ct + fr) * LP + 8 * fq + 32 * s); }
        f32x4 o[4]; float ss[4] = {0.f, 0.f, 0.f, 0.f};
#pragma unroll
        for (int vi = 0; vi < 4; ++vi) { const int vt = vt0 + vi;
            f32x4 c = (f32x4){0.f, 0.f, 0.f, 0.f};
#pragma unroll
            for (int s = 0; s < 2; ++s) { const bf16x8 bb = *(const LAS bf16x8*)(vT + (16 * vt + fr) * LP + 8 * fq + 32 * s); c = __builtin_amdgcn_mfma_f32_16x16x32_bf16(ap[s], bb, c, 0, 0, 0); }
#pragma unroll
            for (int s = 0; s < 2; ++s) c = __builtin_amdgcn_mfma_f32_16x16x32_bf16(aq[s], stf[vi][s], c, 0, 0, 0);
            o[vi] = c;
#pragma unroll
            for (int r = 0; r < 4; ++r) ss[r] += c[r] * c[r]; }
#pragma unroll
        for (int r = 0; r < 4; ++r) ss[r] = row16_sum(ss[r]);
        if (fr == 0) {
#pragma unroll
            for (int r = 0; r < 4; ++r) red[w * 16 + 4 * fq + r] = ss[r];
        }
        __syncthreads();
#pragma unroll
        for (int r = 0; r < 4; ++r) { const float tot = red[ct * 16 + 4 * fq + r] + red[(ct + 4) * 16 + 4 * fq + r]; const float rstd = __builtin_amdgcn_rsqf(tot * (1.0f / DV) + RMS_EPS);
#pragma unroll
            for (int vi = 0; vi < 4; ++vi) ot[(16 * ct + 4 * fq + r) * OTP + 16 * (vt0 + vi) + fr] = o[vi][r] * rstd * gng[vi]; }
        __syncthreads();
        { const int c = F.tid >> 3, sg = F.tid & 7; const LAS float* op = ot + c * OTP + 16 * sg;
          const unsigned gw[8] = {cur.g0.x, cur.g0.y, cur.g0.z, cur.g0.w, cur.g1.x, cur.g1.y, cur.g1.z, cur.g1.w};
          unsigned ow[8];
#pragma unroll
          for (int q = 0; q < 4; ++q) { const f32x4 ov = *(const LAS f32x4*)(op + 4 * q);
              const float ga = bflo(gw[2 * q]), gb = bfhi(gw[2 * q]), gc = bflo(gw[2 * q + 1]), gd = bfhi(gw[2 * q + 1]);
              ow[2 * q] = pk2(ov.x * (ga * sigmoidf_(ga)), ov.y * (gb * sigmoidf_(gb))); ow[2 * q + 1] = pk2(ov.z * (gc * sigmoidf_(gc)), ov.w * (gd * sigmoidf_(gd))); }
          unsigned char* yp = (unsigned char*)Y + tiled_off(tok0 + c, 2 * (CONVW + h * DV + 16 * sg), D / 64);
          *(u32x4*)yp = (u32x4){ow[0], ow[1], ow[2], ow[3]}; *(u32x4*)(yp + 16) = (u32x4){ow[4], ow[5], ow[6], ow[7]}; }
        __syncthreads();
        cur = nxt;
    }
    }
    for (int rep_c = 0; rep_c < 1 + ((REPMASK >> 21) & 1); ++rep_c)
    for (int it = F.bx * NTHR + F.tid; it < M * (CONVW / 8); it += F.G * NTHR) {
        const int t = it >> 6, c8 = (it & 63) * 8, s = t & (SEQ - 1);
        float acc[8];
#pragma unroll
        for (int j = 0; j < 8; ++j) acc[j] = 0.f;
#pragma unroll
        for (int i = 0; i < 3; ++i) { const int sp = s - 2 + i; if (sp < 0) continue;
            const size_t ro = (size_t)(t - 2 + i) * NPROJ;
            const u32x4 uh = *(const u32x4*)(PROJ + ro + C_UH + c8), gc = *(const u32x4*)(PROJ + ro + C_GC + c8);
            const unsigned uw[4] = {uh.x, uh.y, uh.z, uh.w}, gw[4] = {gc.x, gc.y, gc.z, gc.w};
            const f32x4 w0 = *(const f32x4*)(F.conv_w + i * CONVW + c8), w1 = *(const f32x4*)(F.conv_w + i * CONVW + c8 + 4);
            const float ww[8] = {w0.x, w0.y, w0.z, w0.w, w1.x, w1.y, w1.z, w1.w};
#pragma unroll
            for (int p = 0; p < 4; ++p) { acc[2 * p] += ww[2 * p] * (bflo(uw[p]) * bflo(gw[p])); acc[2 * p + 1] += ww[2 * p + 1] * (bfhi(uw[p]) * bfhi(gw[p])); } }
        const u32x4 gb = *(const u32x4*)(PROJ + (size_t)t * NPROJ + C_GB + c8); const unsigned bw[4] = {gb.x, gb.y, gb.z, gb.w};
        u32x4 o;
        o.x = pk2(bflo(bw[0]) * acc[0], bfhi(bw[0]) * acc[1]); o.y = pk2(bflo(bw[1]) * acc[2], bfhi(bw[1]) * acc[3]);
        o.z = pk2(bflo(bw[2]) * acc[4], bfhi(bw[2]) * acc[5]); o.w = pk2(bflo(bw[3]) * acc[6], bfhi(bw[3]) * acc[7]);
        *(u32x4*)((unsigned char*)Y + tiled_off(t, 2 * c8, D / 64)) = o;
    }
}

constexpr int WRP = 1032;
__device__ __forceinline__ void p6_router(Frame& F) {
    LAS bf16_t* wh = (LAS bf16_t*)F.lds;
    LAS bf16_t* wl = (LAS bf16_t*)(F.lds + 32 * WRP * 2);
    LAS float* lgp = (LAS float*)(F.lds + 2 * 32 * WRP * 2);
    LAS int* hist = (LAS int*)(F.lds + 2 * 32 * WRP * 2 + 2 * 64 * 33 * 4);
    const bf16_t* X1 = (const bf16_t*)(F.ws + WS_X1); bf16_t* XB = (bf16_t*)(F.ws + WS_XN); float* RSTD = (float*)(F.ws + WS_ROUTE + R_RSTD);
    int* TOPI = (int*)(F.ws + WS_ROUTE + R_TOPI); float* TOPG = (float*)(F.ws + WS_ROUTE + R_TOPG); int* HIST = (int*)(F.ws + WS_ROUTE + R_HIST);
    for (int i = F.tid; i < 1024 * 32; i += NTHR) { const int k = i >> 5, e = i & 31; const float wv = F.w_router[i]; const unsigned h = f2bf(wv); const float hf = __builtin_bit_cast(float, h << 16);
        wh[e * WRP + k] = (bf16_t)h; wl[e * WRP + k] = (bf16_t)f2bf(wv - hf); }
    const int lane = F.lane, w = F.wave, fr = lane & 15, fq = lane >> 4, rt = w & 3, kh = w >> 2;
    for (int wg = F.bx; wg < M / 64; wg += F.G) {
        if (F.tid < 32) hist[F.tid] = 0;
        __syncthreads();
        const int m = wg * 64 + rt * 16 + fr;
        const bf16_t* xrow = X1 + (size_t)m * D + kh * 512 + 8 * fq;
        bf16_t* orow = XB + (size_t)m * D + kh * 512 + 8 * fq;
        const float* grow = F.g_ffn + kh * 512 + 8 * fq;
        f32x4 c0 = (f32x4){0.f, 0.f, 0.f, 0.f}, c1 = c0; float s2 = 0.f;
#pragma unroll 4
        for (int s = 0; s < 16; ++s) {
            const u32x4 xr8 = *(const u32x4*)(xrow + 32 * s);
            const f32x4 x0 = {bflo(xr8.x), bfhi(xr8.x), bflo(xr8.y), bfhi(xr8.y)}, x1v = {bflo(xr8.z), bfhi(xr8.z), bflo(xr8.w), bfhi(xr8.w)};
            const f32x4 g0 = *(const f32x4*)(grow + 32 * s), g1 = *(const f32x4*)(grow + 32 * s + 4);
            s2 += (x0.x * x0.x + x0.y * x0.y) + (x0.z * x0.z + x0.w * x0.w) + (x1v.x * x1v.x + x1v.y * x1v.y) + (x1v.z * x1v.z + x1v.w * x1v.w);
            const float xg[8] = {x0.x * g0.x, x0.y * g0.y, x0.z * g0.z, x0.w * g0.w, x1v.x * g1.x, x1v.y * g1.y, x1v.z * g1.z, x1v.w * g1.w};
            unsigned hw[4], lw[4];
#pragma unroll
            for (int p = 0; p < 4; ++p) { const unsigned h0 = f2bf(xg[2 * p]), h1 = f2bf(xg[2 * p + 1]);
                hw[p] = h0 | (h1 << 16);
                lw[p] = pk2(xg[2 * p] - __builtin_bit_cast(float, h0 << 16), xg[2 * p + 1] - __builtin_bit_cast(float, h1 << 16)); }
            const u32x4 hv = {hw[0], hw[1], hw[2], hw[3]}, lv = {lw[0], lw[1], lw[2], lw[3]};
            if constexpr (MOE_FP8) { u32x2 f8; f8.x = pk4_fp8(xg[0], xg[1], xg[2], xg[3]); f8.y = pk4_fp8(xg[4], xg[5], xg[6], xg[7]); *(u32x2*)((unsigned char*)XB + (size_t)m * D + kh * 512 + 8 * fq + 32 * s) = f8; }
            else *(u32x4*)(orow + 32 * s) = hv;
            const bf16x8 ah = __builtin_bit_cast(bf16x8, hv), al = __builtin_bit_cast(bf16x8, lv);
            const int kk = kh * 512 + 32 * s + 8 * fq;
            const bf16x8 bh0 = *(const LAS bf16x8*)(wh + fr * WRP + kk), bh1 = *(const LAS bf16x8*)(wh + (16 + fr) * WRP + kk);
            const bf16x8 bl0 = *(const LAS bf16x8*)(wl + fr * WRP + kk), bl1 = *(const LAS bf16x8*)(wl + (16 + fr) * WRP + kk);
            c0 = __builtin_amdgcn_mfma_f32_16x16x32_bf16(ah, bh0, c0, 0, 0, 0); c1 = __builtin_amdgcn_mfma_f32_16x16x32_bf16(ah, bh1, c1, 0, 0, 0);
            c0 = __builtin_amdgcn_mfma_f32_16x16x32_bf16(al, bh0, c0, 0, 0, 0); c1 = __builtin_amdgcn_mfma_f32_16x16x32_bf16(al, bh1, c1, 0, 0, 0);
            c0 = __builtin_amdgcn_mfma_f32_16x16x32_bf16(ah, bl0, c0, 0, 0, 0); c1 = __builtin_amdgcn_mfma_f32_16x16x32_bf16(ah, bl1, c1, 0, 0, 0);
        }
        s2 += __shfl_xor(s2, 16); s2 += __shfl_xor(s2, 32);
#pragma unroll
        for (int r = 0; r < 4; ++r) { LAS float* dst = lgp + (kh * 64 + rt * 16 + 4 * fq + r) * 33; dst[fr] = c0[r]; dst[16 + fr] = c1[r]; }
        if (fq == 0) lgp[(kh * 64 + rt * 16 + fr) * 33 + 32] = s2;
        __syncthreads();
        if (F.tid < 64) {
            const int row = F.tid, mm = wg * 64 + row;
            const LAS float* p0 = lgp + row * 33; const LAS float* p1 = lgp + (64 + row) * 33;
            const float rstd = 1.0f / sqrtf((p0[32] + p1[32]) * (1.0f / D) + RMS_EPS);
            float l[32];
#pragma unroll
            for (int e = 0; e < 32; ++e) l[e] = (p0[e] + p1[e]) * rstd + F.b_router[e];
            int bi[4]; float bv[4]; unsigned used = 0u;
#pragma unroll
            for (int k = 0; k < 4; ++k) { float best = -3.0e38f; int be = 0;
#pragma unroll
                for (int e = 0; e < 32; ++e) { const bool ok = !((used >> e) & 1u) && l[e] > best; best = ok ? l[e] : best; be = ok ? e : be; }
                used |= 1u << be; bi[k] = be; bv[k] = best; }
            const float e1 = __expf(bv[1] - bv[0]), e2 = __expf(bv[2] - bv[0]), e3 = __expf(bv[3] - bv[0]); const float inv = 1.0f / (1.0f + e1 + e2 + e3);
            *(int4*)(TOPI + (size_t)mm * 4) = make_int4(bi[0], bi[1], bi[2], bi[3]);
            *(f32x4*)(TOPG + (size_t)mm * 4) = (f32x4){inv, e1 * inv, e2 * inv, e3 * inv};
            RSTD[mm] = rstd;
#pragma unroll
            for (int k = 0; k < 4; ++k) atomicAdd((int*)&hist[bi[k]], 1);
        }
        __syncthreads();
        if (F.tid < 32) HIST[wg * 32 + F.tid] = hist[F.tid];
        __syncthreads();
    }
}

__device__ __forceinline__ void p7_slots(Frame& F) {
    LAS int* part = (LAS int*)F.lds;
    LAS int* cnt = part + 1024;
    LAS int* pre = cnt + 32;
    LAS int* pst = pre + 32;
    LAS int* wcnt = pst + 64;
    const int* TOPI = (const int*)(F.ws + WS_ROUTE + R_TOPI); const float* TOPG = (const float*)(F.ws + WS_ROUTE + R_TOPG); const int* HIST = (const int*)(F.ws + WS_ROUTE + R_HIST);
    int* POS = (int*)(F.ws + WS_ROUTE + R_POS); int* ROWTOK = (int*)(F.ws + WS_ROUTE + R_ROWTOK); float* ROWGATE = (float*)(F.ws + WS_ROUTE + R_ROWGATE); int* META = (int*)(F.ws + WS_ROUTE + R_META);
    const float* RSTD = (const float*)(F.ws + WS_ROUTE + R_RSTD); float* ROWRSTD = (float*)(F.ws + WS_ROUTE + R_ROWRSTD);
    constexpr int NWG = M / 64;
    const int lane = F.lane;
    for (int wg = F.bx; wg < NWG; wg += F.G) {
        int my_e = 0, tokn = 0, kk = 0; float my_g = 0.f, my_rs = 0.f;
        if (F.tid < 256) { tokn = wg * 64 + (F.tid >> 2); kk = F.tid & 3; my_e = TOPI[(size_t)tokn * 4 + kk]; my_g = TOPG[(size_t)tokn * 4 + kk]; my_rs = RSTD[tokn]; }
        { const int e = F.tid & 31, p = F.tid >> 5; int tot = 0, bef = 0;
#pragma unroll
          for (int q = 0; q < 16; ++q) { const int hv = HIST[(p * 16 + q) * 32 + e]; tot += hv; bef += (p * 16 + q < wg) ? hv : 0; }
          part[(p * 32 + e) * 2] = tot; part[(p * 32 + e) * 2 + 1] = bef; }
        __syncthreads();
        if (F.tid < 64) { int tot = 0, bef = 0;
            if (lane < 32) {
#pragma unroll
                for (int p = 0; p < 16; ++p) { tot += part[(p * 32 + lane) * 2]; bef += part[(p * 32 + lane) * 2 + 1]; }
                cnt[lane] = tot; pre[lane] = bef; }
            const int padded = lane < 32 ? ((tot + 255) & ~255) : 0;
            const int incl = (int)wave_incl_scan((float)padded);
            if (lane < 32) pst[lane] = incl - padded;
            if (lane == 31) pst[32] = incl; }
        int rw = 0;
        if (F.tid < 256) { int mycnt = 0;
#pragma unroll 4
            for (int e = 0; e < 32; ++e) { const unsigned long long mk = __ballot(my_e == e);
                if (my_e == e) rw = __popcll(mk & ((1ull << lane) - 1ull));
                if (lane == e) mycnt = __popcll(mk); }
            if (lane < 32) wcnt[F.wave * 32 + lane] = mycnt; }
        __syncthreads();
        if (F.tid < 256) { int rank = rw;
#pragma unroll
            for (int w2 = 0; w2 < 3; ++w2) rank += (w2 < F.wave) ? wcnt[w2 * 32 + my_e] : 0;
            const int slot = pst[my_e] + pre[my_e] + rank;
            ROWTOK[slot] = tokn; ROWGATE[slot] = my_g; ROWRSTD[slot] = my_rs; POS[(size_t)tokn * 4 + kk] = slot; }
        if (wg < NE) { const int e = wg, c = cnt[e], s0 = pst[e] + c, s1 = pst[e] + ((c + 255) & ~255);
            for (int s = s0 + F.tid; s < s1; s += NTHR) { ROWTOK[s] = 0; ROWGATE[s] = 0.f; ROWRSTD[s] = 0.f; } }
        if (wg == 0) { if (F.tid == 0) META[0] = pst[32] >> 8;
            for (int t = F.tid; t < NTILES_MAX; t += NTHR) { int e = 0;
#pragma unroll
                for (int q = 0; q < 32; ++q) e += (t * 256 >= pst[q + 1]) ? 1 : 0;
                META[32 + t] = e < 32 ? e : 31; } }
        __syncthreads();
    }
}

__device__ __forceinline__ void p10_combine(Frame& F) {
    const bf16_t* X1 = (const bf16_t*)(F.ws + WS_X1); const bf16_t* CB = (const bf16_t*)(F.ws + WS_CONTRIB); const int* POS = (const int*)(F.ws + WS_ROUTE + R_POS);
    const int gw = F.bx * NWAVES + F.wave, NGW = F.G * NWAVES;
    for (int m = gw; m < M; m += NGW) {
        const GAS u32x2* xr = (const GAS u32x2*)(X1 + (size_t)m * D) + F.lane;
        f32x4 v[4];
#pragma unroll
        for (int j = 0; j < 4; ++j) { const u32x2 c = xr[64 * j]; v[j] = (f32x4){bflo(c.x), bfhi(c.x), bflo(c.y), bfhi(c.y)}; }
        const int4 ps = *(const int4*)(POS + (size_t)m * 4); const int pp[4] = {ps.x, ps.y, ps.z, ps.w};
#pragma unroll
        for (int k = 0; k < 4; ++k) { const GAS u32x2* cr = (const GAS u32x2*)(CB + (size_t)pp[k] * D) + F.lane;
#pragma unroll
            for (int j = 0; j < 4; ++j) { const u32x2 c = cr[64 * j]; v[j].x += bflo(c.x); v[j].y += bfhi(c.x); v[j].z += bflo(c.y); v[j].w += bfhi(c.y); } }
        float s2 = 0.f;
#pragma unroll
        for (int j = 0; j < 4; ++j) s2 += (v[j].x * v[j].x + v[j].y * v[j].y) + (v[j].z * v[j].z + v[j].w * v[j].w);
        const float rstd = 1.0f / sqrtf(wave_sum(s2) * (1.0f / D) + RMS_EPS);
        GAS f32x4* orow = (GAS f32x4*)(F.out + (size_t)m * D) + F.lane;
#pragma unroll
        for (int j = 0; j < 4; ++j) { const f32x4 g = *((const GAS f32x4*)F.g_fin + F.lane + 64 * j); orow[64 * j] = v[j] * rstd * g; }
    }
}

__global__ void __launch_bounds__(NTHR, 2) fwd_kernel(Args args) {
    extern __shared__ __attribute__((aligned(16))) unsigned char lds_raw[];
    Frame F;
    F.lds = (LAS unsigned char*)lds_raw;
    F.tid = threadIdx.x; F.lane = F.tid & 63; F.wave = __builtin_amdgcn_readfirstlane(F.tid >> 6); F.G = gridDim.x; F.bx = blockIdx.x;
    F.x = args.in[0]; F.g_mix = args.in[1]; F.w_in = args.in[2]; F.conv_w = args.in[3]; F.w_gk_up = args.in[4]; F.b_gk_up = args.in[5]; F.gla_g = args.in[6]; F.w_out = args.in[7];
    F.g_ffn = args.in[8]; F.w_router = args.in[9]; F.b_router = args.in[10]; F.w_gu = args.in[11]; F.b_gu = args.in[12]; F.w_dn = args.in[13]; F.b_dn = args.in[14]; F.g_fin = args.in[15];
    F.out = args.out; F.ws = args.ws;
    volatile LAS unsigned* MISC = (volatile LAS unsigned*)(F.lds + MISC_OFF);
    for (int u = F.tid; u < 256; u += NTHR) MISC[u] = 0u;
    __syncthreads();
    unsigned* ctl = (unsigned*)(F.ws + WS_CTL);
    XcdBarrier bar; bar.bar = ctl + CW_BAR; bar.x = 0; bar.st = nullptr;
    if (N_LAUNCHES == 1) bar = xcd_barrier_post(ctl + CW_BAR, MISC + 8);
    const int lo = args.ph_lo, hi = args.ph_hi;
#define IN(k) (lo <= (k) && (k) < hi)
#define SEAM(k) do { if (IN(k) && IN((k) + 1)) { xcd_barrier(bar); if (((REPMASK >> 22) & 1) != 0) xcd_barrier(bar); } } while (0)
#define REP(k) for (int rep_ = 0; rep_ < 1 + ((REPMASK >> (k)) & 1); ++rep_)
    const int* META = (const int*)(F.ws + WS_ROUTE + R_META);

    if (IN(0)) REP(0) { p0_prep(F); } SEAM(0);
    if (IN(1)) {
        pg8::StaticOrder S; S.init(M / 256, NPROJ / 256, F.G, F.bx, 1 + ((REPMASK >> 1) & 1));
        pg8::EpiBf16 E{(bf16_t*)(F.ws + WS_PROJ), NPROJ};
        pg8::gemm_phase<pg8::EpiBf16, pg8::StaticOrder, true, false, 1 + ((REPMASK >> 14) & 1)>(F.lds, F.ws + WS_XN, F.ws + WS_W1T, 0, D / 64, nullptr, S, E);
    } SEAM(1);
    if (IN(2)) REP(2) { p2_gla_kv(F); } SEAM(2);
    if (IN(3)) REP(3) { p3_scan(F); } SEAM(3);
    if (IN(4)) REP(4) { p4_gla_out(F); } SEAM(4);
    if (IN(5)) {
        pg8::StaticOrder S; S.init(M / 256, D / 256, F.G, F.bx, 1 + ((REPMASK >> 5) & 1));
        pg8::EpiResBf16 E{F.x, (bf16_t*)(F.ws + WS_X1), D};
        pg8::gemm_phase<pg8::EpiResBf16, pg8::StaticOrder, true, false, 1 + ((REPMASK >> 15) & 1)>(F.lds, F.ws + WS_Y, F.ws + WS_WOT, 0, D / 64, nullptr, S, E);
    } SEAM(5);
    if (IN(6)) REP(6) { p6_router(F); } SEAM(6);
    if (IN(7)) REP(7) { p7_slots(F); } SEAM(7);
    if (IN(8)) {
        const int ntiles = META[0];
        LAS int* te = (LAS int*)(F.lds + TE_OFF); LAS int* utab = te + NTILES_MAX;
        LAS unsigned short* ridx = (LAS unsigned short*)(F.lds + TE_OFF + 2048); LAS float* rstd = (LAS float*)(F.lds + TE_OFF + 2048 + pg8::UCAP * 512); LAS float* bias = rstd + pg8::UCAP * 256;
        for (int i = F.tid; i < NTILES_MAX; i += NTHR) te[i] = META[32 + i];
        __syncthreads();
        pg8::MoeOrder S0; S0.so.init(ntiles, 2 * FF / 256, F.G, F.bx); S0.tile_expert = te;
        int nun = 0;
        { const int* ROWTOK = (const int*)(F.ws + WS_ROUTE + R_ROWTOK); const float* ROWRSTD = (const float*)(F.ws + WS_ROUTE + R_ROWRSTD); pg8::Unit uu;
          for (; nun < pg8::UCAP && S0.next(nun, uu); ++nun) {
              if (F.tid == 0) { utab[4 * nun] = uu.pm; utab[4 * nun + 1] = uu.pn; utab[4 * nun + 2] = uu.pb; utab[4 * nun + 3] = uu.e; }
              if (F.tid < 256) { ridx[nun * 256 + F.tid] = (unsigned short)ROWTOK[uu.pm * 256 + F.tid]; rstd[nun * 256 + F.tid] = ROWRSTD[uu.pm * 256 + F.tid];
                  bias[nun * 256 + F.tid] = F.b_gu[(size_t)uu.e * 2048 + (F.tid >> 7) * 1024 + uu.pn * 128 + (F.tid & 127)]; } }
          __syncthreads(); }
        pg8::TabOrder S{utab, nun, (REPMASK >> 18) & 1};
#ifdef SKEW_TICKS
        { const unsigned long long t0 = __builtin_amdgcn_s_memrealtime(); const unsigned long long dl = (unsigned long long)((F.bx >> 3) & 31) * SKEW_TICKS;
          while (__builtin_amdgcn_s_memrealtime() - t0 < dl) __builtin_amdgcn_s_sleep(2); }
#endif
        pg8::EpiSwiglu E{(bf16_t*)(F.ws + WS_H), bias, rstd};
        constexpr int ES = MOE_FP8 ? 1 : 2;
        pg8::gemm_phase<pg8::EpiSwiglu, pg8::TabOrder, true, MOE_FP8 != 0, 1 + ((REPMASK >> 16) & 1)>(F.lds, F.ws + WS_XN, F.ws + WS_WGUT, D * ES, D * ES / 128, ridx, S, E);
    } SEAM(8);
    if (IN(9)) {
        const int ntiles = META[0];
        LAS int* te = (LAS int*)(F.lds + TE_OFF); LAS int* utab = te + NTILES_MAX;
        LAS float* gate = (LAS float*)(F.lds + TE_OFF + 2048); LAS float* bias = gate + pg8::UCAP * 256;
        for (int i = F.tid; i < NTILES_MAX; i += NTHR) te[i] = META[32 + i];
        __syncthreads();
        pg8::MoeOrder S0; S0.so.init(ntiles, D / 256, F.G, F.bx); S0.tile_expert = te;
        int nun = 0;
        { const float* ROWGATE = (const float*)(F.ws + WS_ROUTE + R_ROWGATE); pg8::Unit uu;
          for (; nun < pg8::UCAP && S0.next(nun, uu); ++nun) {
              if (F.tid == 0) { utab[4 * nun] = uu.pm; utab[4 * nun + 1] = uu.pn; utab[4 * nun + 2] = uu.pb; utab[4 * nun + 3] = uu.e; }
              if (F.tid < 256) { gate[nun * 256 + F.tid] = ROWGATE[uu.pm * 256 + F.tid]; bias[nun * 256 + F.tid] = F.b_dn[(size_t)uu.e * D + uu.pn * 256 + F.tid]; } }
          __syncthreads(); }
        pg8::TabOrder S{utab, nun, (REPMASK >> 19) & 1};
        pg8::EpiDown E{(bf16_t*)(F.ws + WS_CONTRIB), bias, gate};
        constexpr int ES = MOE_FP8 ? 1 : 2;
        pg8::gemm_phase<pg8::EpiDown, pg8::TabOrder, true, MOE_FP8 != 0, 1 + ((REPMASK >> 17) & 1)>(F.lds, F.ws + WS_H, F.ws + WS_WDT, 0, FF * ES / 128, nullptr, S, E);
    } SEAM(9);
    if (IN(10)) REP(10) { p10_combine(F); }
#undef IN
#undef SEAM
}

extern "C" void kernel_launch(void* const* d_in, const int* in_sizes, int n_in, void* d_out, int out_size, void* d_ws, size_t ws_size, hipStream_t stream) {
    static int grid = 0;
    if (grid == 0) {
        if (n_in != 16 || in_sizes[0] != M * D || out_size != M * D || ws_size < WS_END) { fprintf(stderr, "kernel_launch: unexpected shapes (n_in %d, in0 %d, out %d, ws %zu < %zu)\n", n_in, n_in > 0 ? in_sizes[0] : -1, out_size, ws_size, (size_t)WS_END); grid = -1; return; }
        int dev = 0, cus = 0, per_cu = 0;
        if (hipGetDevice(&dev) != hipSuccess || hipDeviceGetAttribute(&cus, hipDeviceAttributeMultiprocessorCount, dev) != hipSuccess) { grid = -1; return; }
        if (hipFuncSetAttribute((const void*)fwd_kernel, hipFuncAttributeMaxDynamicSharedMemorySize, LDS_BYTES) != hipSuccess) { fprintf(stderr, "kernel_launch: hipFuncSetAttribute failed\n"); grid = -1; return; }
        if (hipOccupancyMaxActiveBlocksPerMultiprocessor(&per_cu, (const void*)fwd_kernel, NTHR, LDS_BYTES) != hipSuccess || per_cu < 1) fprintf(stderr, "kernel_launch: occupancy query reports %d\n", per_cu);
        (void)hipGetLastError();
        grid = cus;
    }
    if (grid < 0) return;
    (void)hipMemsetAsync((char*)d_ws + WS_CTL, 0, CTL_ZERO_BYTES, stream);
    Args a{};
    for (int i = 0; i < 16; ++i) a.in[i] = (const float*)d_in[i];
    a.out = (float*)d_out; a.ws = (unsigned char*)d_ws;
    for (int li = 0; li < N_LAUNCHES; ++li) {
        if (N_LAUNCHES == 1) { a.ph_lo = 0; a.ph_hi = NPHASES; } else { a.ph_lo = li; a.ph_hi = li + 1; }
        a.li = li;
        hipLaunchKernelGGL(fwd_kernel, dim3(grid), dim3(NTHR), LDS_BYTES, stream, a);
    }
}
```

```cpp
#include <hip/hip_runtime.h>
#include <cstdio>
#include <cstdint>

#ifndef MK_N_LAUNCHES
#define MK_N_LAUNCHES 1
#endif

#ifndef MOE_FP8
#define MOE_FP8 1
#endif
#ifndef REPMASK
#define REPMASK 0
#endif
#define LAS __attribute__((address_space(3)))
#define GAS __attribute__((address_space(1)))
typedef unsigned short bf16_t;
typedef short bf16x8 __attribute__((ext_vector_type(8)));
typedef float f32x4 __attribute__((ext_vector_type(4)));
typedef float f32x2 __attribute__((ext_vector_type(2)));
typedef unsigned u32x4 __attribute__((ext_vector_type(4)));
typedef unsigned u32x2 __attribute__((ext_vector_type(2)));

constexpr int NWAVES = 8, NTHR = 512;
constexpr int NPHASES = 11;
constexpr int N_LAUNCHES = MK_N_LAUNCHES;
constexpr int BATCH = 4, SEQ = 4096, D = 1024, M = BATCH * SEQ;
constexpr int CONVW = 512, NH = 4, DK = 64, DV = 128, RANK = 16, CHUNK = 64, NCH = SEQ / CHUNK;
constexpr int DIN = 3088, NPROJ = 3072;
constexpr int C_UH = 0, C_GB = 512, C_GC = 1024, C_Q = 1536, C_K = 1792, C_V = 2048, C_G = 2560, C_GKL = 3072;
constexpr int NE = 32, TOPK = 4, FF = 1024;
constexpr int NUNITS_GLA = BATCH * NH * NCH;
constexpr int NROWS_MAX = M * TOPK + NE * 256;
constexpr int NTILES_MAX = NROWS_MAX / 256;
constexpr float RMS_EPS = 1e-5f;

constexpr size_t MiB = 1u << 20;
constexpr size_t WS_CTL = 0, CTL_ZERO_BYTES = 1 * MiB;
constexpr size_t WS_XN = 1 * MiB;
constexpr size_t WS_GKL = WS_XN + 32 * MiB;
constexpr size_t WS_W1T = WS_GKL + 1 * MiB;
constexpr size_t WS_WOT = WS_W1T + 6 * MiB;
constexpr size_t WS_WGUT = WS_WOT + 2 * MiB;
constexpr size_t WS_WDT = WS_WGUT + 128 * MiB;
constexpr size_t WS_PROJ = WS_WDT + 64 * MiB;
constexpr size_t WS_KVT = WS_PROJ + 96 * MiB;
constexpr size_t WS_DEC = WS_KVT + 32 * MiB;
constexpr size_t WS_ST = WS_DEC + 1 * MiB;
constexpr size_t WS_Y = WS_ST + 16 * MiB;
constexpr size_t WS_X1 = WS_Y + 32 * MiB;
constexpr size_t WS_ROUTE = WS_X1 + 64 * MiB;
constexpr size_t WS_H = WS_ROUTE + 2 * MiB;
constexpr size_t WS_CONTRIB = WS_H + 144 * MiB;
constexpr size_t WS_END = WS_CONTRIB + 144 * MiB;
constexpr size_t R_TOPI = 0;
constexpr size_t R_TOPG = 256 * 1024;
constexpr size_t R_POS = 512 * 1024;
constexpr size_t R_ROWTOK = 768 * 1024;
constexpr size_t R_ROWGATE = 1088 * 1024;
constexpr size_t R_HIST = 1408 * 1024;
constexpr size_t R_META = 1472 * 1024;
constexpr size_t R_RSTD = 1536 * 1024;
constexpr size_t R_ROWRSTD = 1664 * 1024;
constexpr size_t WS_WRIMG = WS_CTL + 512 * 1024;
constexpr int CW_BAR = 4096;

constexpr int LDS_BYTES = 160 * 1024 - 2048;
constexpr int MISC_OFF = LDS_BYTES - 1024;
constexpr int TE_OFF = 131072;

__device__ __forceinline__ unsigned f2bf(float f) { unsigned u = __builtin_bit_cast(unsigned, f); return (u + 0x7fffu + ((u >> 16) & 1u)) >> 16; }
__device__ __forceinline__ unsigned pk2(float lo, float hi) { typedef __bf16 bf2_ __attribute__((ext_vector_type(2))); const f32x2 v = {lo, hi}; return __builtin_bit_cast(unsigned, __builtin_convertvector(v, bf2_)); }
__device__ __forceinline__ float bf2f(unsigned short b) { return __builtin_bit_cast(float, (unsigned)b << 16); }
__device__ __forceinline__ float bflo(unsigned w) { return __builtin_bit_cast(float, w << 16); }
__device__ __forceinline__ float bfhi(unsigned w) { return __builtin_bit_cast(float, w & 0xffff0000u); }
__device__ __forceinline__ unsigned cvt_pk_bf16(float lo, float hi) { unsigned r; asm volatile("v_cvt_pk_bf16_f32 %0, %1, %2" : "=v"(r) : "v"(lo), "v"(hi)); return r; }
__device__ __forceinline__ unsigned pk4_fp8(float a, float b, float c, float d) { int w = 0; w = __builtin_amdgcn_cvt_pk_fp8_f32(a, b, w, false); w = __builtin_amdgcn_cvt_pk_fp8_f32(c, d, w, true); return (unsigned)w; }

__device__ __forceinline__ float sigmoidf_(float x) { return __builtin_amdgcn_rcpf(1.0f + __expf(-x)); }
__device__ __forceinline__ float log_sigmoidf_(float x) { return fminf(x, 0.f) - __logf(1.0f + __expf(-fabsf(x))); }
#define DPPF_(x, ctrl, rm) __builtin_bit_cast(float, __builtin_amdgcn_update_dpp(0, __builtin_bit_cast(int, (x)), (ctrl), (rm), 0xf, false))
__device__ __forceinline__ float row16_sum(float t) { t += DPPF_(t, 0xb1, 0xf); t += DPPF_(t, 0x4e, 0xf); t += DPPF_(t, 0x141, 0xf); t += DPPF_(t, 0x140, 0xf); return t; }
__device__ __forceinline__ float wave_incl_scan(float v) {
    v += DPPF_(v, 0x111, 0xf); v += DPPF_(v, 0x112, 0xf); v += DPPF_(v, 0x114, 0xf); v += DPPF_(v, 0x118, 0xf);
    v += DPPF_(v, 0x142, 0xa); v += DPPF_(v, 0x143, 0xc);
    return v;
}
__device__ __forceinline__ float wave_sum(float v) { const float t = wave_incl_scan(v); return __builtin_bit_cast(float, __builtin_amdgcn_readlane(__builtin_bit_cast(int, t), 63)); }
__host__ __device__ __forceinline__ size_t tiled_off(int row, int cbyte, int nt) { return ((size_t)((row >> 8) * nt + (cbyte >> 7)) << 15) + (size_t)(((row & 255) << 7) + (cbyte & 127)); }
#define LDS_WAIT() asm volatile("s_waitcnt lgkmcnt(0)" ::: "memory")
#define VM_WAIT() asm volatile("s_waitcnt vmcnt(0)" ::: "memory")

#define XB_TMO      128
#define XB_XCNT(j)  (256  + 64 * (j))
#define XB_XSUB(j)  (1280 + 64 * (j))
#define XB_XGEN(j)  (2304 + 64 * (j))
#define XB_TOP      3328
#define XB_TOPGEN   3392
#define XCD_BAR_WORDS 3456
#define XB_SPIN_CAP (1u << 18)
__device__ __forceinline__ unsigned xb_ld(unsigned* p)              { return __hip_atomic_load(p, __ATOMIC_RELAXED, __HIP_MEMORY_SCOPE_AGENT); }
__device__ __forceinline__ unsigned xb_add(unsigned* p, unsigned v) { return __hip_atomic_fetch_add(p, v, __ATOMIC_RELAXED, __HIP_MEMORY_SCOPE_AGENT); }
__device__ __forceinline__ unsigned xb_xcc_id() { return (unsigned)__builtin_amdgcn_s_getreg((3 << 11) | 20) & 0xFu; }
#define XB_SPIN(cond, bar) do { unsigned _sp = 0; while (cond) { __builtin_amdgcn_s_sleep(1); \
    if ((++_sp & 255u) == 0u) { if (xb_ld(&(bar)[XB_TMO])) break; if (_sp > XB_SPIN_CAP) { atomicAdd(&(bar)[XB_TMO], 1u); break; } } } } while (0)
struct XcdBarrier { unsigned* bar; unsigned x; volatile LAS unsigned* st; };
__device__ __forceinline__ XcdBarrier xcd_barrier_post(unsigned* bar, volatile LAS unsigned* st) {
    XcdBarrier b; b.bar = bar; b.x = xb_xcc_id(); b.st = st;
    if (threadIdx.x == 0) (void)xb_add(&bar[XB_XCNT(b.x)], 1u);
    return b;
}
__device__ __forceinline__ void xcd_barrier_complete(unsigned* bar, unsigned x, unsigned& nloc, unsigned& nx) {
    const unsigned G = gridDim.x * gridDim.y * gridDim.z;
    unsigned sum, cnt, mine, sp = 0u;
    for (;;) {
        sum = 0u; cnt = 0u; mine = 0u;
#pragma unroll
        for (unsigned j = 0; j < 16; ++j) { const unsigned c = xb_ld(&bar[XB_XCNT(j)]); sum += c; cnt += (c > 0u) ? 1u : 0u; mine = (j == x) ? c : mine; }
        if (sum == G) break;
        __builtin_amdgcn_s_sleep(1);
        if ((++sp & 255u) == 0u) { if (xb_ld(&bar[XB_TMO])) break; if (sp > XB_SPIN_CAP) { atomicAdd(&bar[XB_TMO], 1u); break; } }
    }
    nloc = mine > 0u ? mine : 1u; nx = cnt > 0u ? cnt : 1u;
}
__device__ __forceinline__ void xcd_barrier(const XcdBarrier& b) {
    asm volatile("s_waitcnt vmcnt(0)" ::: "memory");
    __syncthreads();
    if (threadIdx.x == 0) {
        unsigned* bar = b.bar;
        __builtin_amdgcn_s_waitcnt(0);
        unsigned nloc = b.st[0], nx = b.st[1];
        if (nloc == 0u) { xcd_barrier_complete(bar, b.x, nloc, nx); b.st[0] = nloc; b.st[1] = nx; }
        const unsigned old = xb_add(&bar[XB_XSUB(b.x)], 1u);
        const unsigned gen = old / nloc;
        if (old + 1u == (gen + 1u) * nloc) {
            __builtin_amdgcn_fence(__ATOMIC_RELEASE, "agent");
            asm volatile("s_waitcnt vmcnt(0)" ::: "memory");
            const unsigned og = xb_add(&bar[XB_TOP], 1u);
            const unsigned tg = og / nx;
            if (og + 1u == (tg + 1u) * nx) xb_add(&bar[XB_TOPGEN], 1u);
            else XB_SPIN(xb_ld(&bar[XB_TOPGEN]) == tg, bar);
            __builtin_amdgcn_fence(__ATOMIC_ACQUIRE, "agent");
            xb_add(&bar[XB_XGEN(b.x)], 1u);
            asm volatile("s_waitcnt vmcnt(0)" ::: "memory");
        } else {
            XB_SPIN(xb_ld(&bar[XB_XGEN(b.x)]) == gen, bar);
            __builtin_amdgcn_fence(__ATOMIC_ACQUIRE, "agent");
            asm volatile("s_waitcnt vmcnt(0)" ::: "memory");
        }
    }
    __syncthreads();
}

namespace pg8 {
constexpr int BM = 256, BK = 64, HALF = 128, HTB = HALF * BK * 2, STAGE_BYTES = 8 * HTB, NXCD = 8, WGM = 8;
constexpr int PF_DUMMY_OFF = 158720;
__host__ __device__ __forceinline__ int lds_byte(int r, int c) { const int st = (r >> 4) * 2 + (c >> 5), rr = r & 15, cc = c & 31, ob = rr * 64 + cc * 2; return st * 1024 + (ob ^ (((ob >> 9) & 1) << 5)); }
__host__ __device__ __forceinline__ void stage_rc(int b, int& R, int& C) { const int st = b / 1024, sb = b % 1024, swz = sb ^ (((sb >> 9) & 1) << 5); R = (st >> 1) * 16 + swz / 64; C = (st & 1) * 32 + (swz % 64) / 2; }
__host__ __device__ __forceinline__ int perm32(int rho) { const int n = rho >> 4, i = rho & 15; return 8 * (i >> 2) + 4 * n + (i & 3); }
struct Unit { int pm, pn, pb, e, i; };
struct StaticOrder {
    int nM, nN, nwg, G, c, reps;
    __host__ __device__ void init(int nM_, int nN_, int G_, int c_, int reps_ = 1) { nM = nM_; nN = nN_; nwg = nM * nN; G = G_; c = c_; reps = reps_; }
    __host__ __device__ bool next(int i, Unit& u) const {
        const long L = (long)i * G + c; if (L >= (long)nwg * reps) return false;
        int wgid = (int)(L % nwg); { const int q = nwg / NXCD, r = nwg % NXCD, xcd = wgid % NXCD, off = wgid / NXCD; wgid = (xcd < r ? xcd * (q + 1) : r * (q + 1) + (xcd - r) * q) + off; }
        const int nig = WGM * nN, gid = wgid / nig, fm = gid * WGM, gsz = (nM - fm) < WGM ? (nM - fm) : WGM;
        u.pm = fm + ((wgid % nig) % gsz); u.pn = (wgid % nig) / gsz; u.pb = u.pn; u.e = 0; u.i = i; return true;
    }
};
struct ListOrder {
    StaticOrder so; int L0, stride, n, Ltail;
    __device__ bool next(int i, Unit& u) const {
        int L; if (i < n) L = L0 + i * stride; else if (i == n && Ltail >= 0) L = Ltail; else return false;
        StaticOrder t = so; t.G = 0; t.c = L; const bool ok = t.next(0, u); u.i = i; return ok; }
};
struct MoeOrder {
    StaticOrder so; const LAS int* tile_expert;
    __device__ bool next(int i, Unit& u) const { if (!so.next(i, u)) return false; u.e = __builtin_amdgcn_readfirstlane(tile_expert[u.pm]); u.pb = u.e * so.nN + u.pn; return true; }
};
struct TabOrder {
    const LAS int* tab; int n; int dup;
    __device__ bool next(int i, Unit& u) const { if (i >= (n << dup)) return false; const LAS int* p = tab + 4 * (i >> dup);
        u.pm = __builtin_amdgcn_readfirstlane(p[0]); u.pn = __builtin_amdgcn_readfirstlane(p[1]); u.pb = __builtin_amdgcn_readfirstlane(p[2]); u.e = __builtin_amdgcn_readfirstlane(p[3]); u.i = i >> dup; return true; }
};
constexpr int UCAP = 10;
typedef int i32x8 __attribute__((ext_vector_type(8)));
typedef int i32x4 __attribute__((ext_vector_type(4)));
template <class Epi, class Sched, bool ALIGN_EPI, bool FP8, int NPASS = 1, bool PF = false>
__device__ __forceinline__ void gemm_phase(LAS unsigned char* lds, const void* A, const void* Bt, const int ldA, const int nt, const LAS unsigned short* rowidx, const Sched& S, const Epi& E) {
    const int tid = threadIdx.x, wid = __builtin_amdgcn_readfirstlane(tid >> 6), lane = tid & 63, wr = wid >> 2, wc = wid & 3, fr = lane & 15, fq = lane >> 4;
    unsigned voffB[2];
#pragma unroll
    for (int i = 0; i < 2; ++i) { int R, C; stage_rc(tid * 16 + i * 8192, R, C); const int Rb = Epi::PERM ? ((R & ~31) + perm32(R & 31)) : R; voffB[i] = (unsigned)(Rb * 128 + C * 2); }
    const size_t kstep = 32768, kstepA = rowidx ? (size_t)128 : (size_t)32768;
    const size_t hstep = 16384;
    const size_t tstep = (size_t)nt * 32768;
    const unsigned ldsw = (unsigned)wid * 1024u;
    const int aoff = lds_byte(wr * 64 + fr, fq * 8), boff = lds_byte(wc * 32 + fr, fq * 8);
#define PG8_SA(b, h) (((b) * 2 + (h)) * HTB)
#define PG8_SB(b, h) ((4 + (b) * 2 + (h)) * HTB)
#define PG8_STAGE(bufoff, gbase, voff) do { _Pragma("unroll") for (int _i = 0; _i < 2; ++_i) \
        __builtin_amdgcn_global_load_lds((const unsigned*)((const char*)(gbase) + (voff)[_i]), (LAS unsigned*)(lds + (bufoff) + ldsw + _i * 8192), 16, 0, 0); } while (0)
#define PG8_LDA(dst, b, h) do { _Pragma("unroll") for (int m = 0; m < 4; ++m) _Pragma("unroll") for (int k = 0; k < 2; ++k) dst[m][k] = *(const LAS bf16x8*)(lds + PG8_SA(b, h) + aoff + m * 2048 + k * 1024); } while (0)
#define PG8_LDB(dst, b, h) do { _Pragma("unroll") for (int n = 0; n < 2; ++n) _Pragma("unroll") for (int k = 0; k < 2; ++k) dst[n][k] = *(const LAS bf16x8*)(lds + PG8_SB(b, h) + boff + n * 2048 + k * 1024); } while (0)
#define PG8_F8(x) __builtin_shufflevector(__builtin_bit_cast(i32x4, (x)[0]), __builtin_bit_cast(i32x4, (x)[1]), 0, 1, 2, 3, 4, 5, 6, 7)
#define PG8_MMA(ai, bj, At, Bt_) do { __builtin_amdgcn_s_setprio(1); _Pragma("unroll") for (int m = 0; m < 4; ++m) _Pragma("unroll") for (int n = 0; n < 2; ++n) { \
        if constexpr (FP8) { const i32x8 _a = PG8_F8(Bt_[n]), _b = PG8_F8(At[m]); \
            asm volatile("v_mfma_scale_f32_16x16x128_f8f6f4 %0, %1, %2, %0, %3, %4 op_sel_hi:[0,0,0]" : "+v"(acc[ai][bj][m][n]) : "v"(_a), "v"(_b), "v"(sclW), "v"(sclX)); } \
        else { _Pragma("unroll") for (int k = 0; k < 2; ++k) acc[ai][bj][m][n] = __builtin_amdgcn_mfma_f32_16x16x32_bf16(Bt_[n][k], At[m][k], acc[ai][bj][m][n], 0, 0, 0); } } \
        __builtin_amdgcn_s_setprio(0); } while (0)
#define PG8_WAIT_V(n) asm volatile("s_waitcnt vmcnt(" #n ")" ::: "memory")
#define PG8_WAIT_L(n) asm volatile("s_waitcnt lgkmcnt(" #n ")" ::: "memory")
#define PG8_WAIT_VR(rx) do { if (rx) { if constexpr (Epi::NST == 16) PG8_WAIT_V(24); else if constexpr (Epi::NST == 8) PG8_WAIT_V(16); else PG8_WAIT_V(8); } else PG8_WAIT_V(8); } while (0)
#define PG8_BAR __builtin_amdgcn_s_barrier()
#define PG8_SCHED __builtin_amdgcn_sched_barrier(0)
#define PG8_AOFF(dst, u, uo) do { _Pragma("unroll") for (int _h = 0; _h < 2; ++_h) _Pragma("unroll") for (int _i = 0; _i < 2; ++_i) { int _R, _C; stage_rc(tid * 16 + _i * 8192, _R, _C); \
        dst[_h][_i] = rowidx ? (unsigned)((int)rowidx[(u).i * BM + _h * HALF + _R] * ldA + _C * 2) : (unsigned)(((u).pm * nt << 15) + ((_h * HALF + _R) << 7) + _C * 2); } } while (0)
    Unit cur, nxt; int ui = 0;
    if (!S.next(0, cur)) return;
    f32x4 acc[2][2][4][2];
#pragma unroll
    for (int a = 0; a < 2; ++a)
#pragma unroll
        for (int b = 0; b < 2; ++b)
#pragma unroll
            for (int m = 0; m < 4; ++m)
#pragma unroll
                for (int n = 0; n < 2; ++n) acc[a][b][m][n] = (f32x4){0.f, 0.f, 0.f, 0.f};
    bf16x8 At[4][2], B0[2][2], B1[2][2];
    int sclW = 0x7A7A7A7A, sclX = 0x7F7F7F7F;
    asm volatile("" : "+v"(sclW), "+v"(sclX));
    unsigned ca[2][2], na[2][2];
    PG8_AOFF(ca, cur, 0);
    const char* cA = (const char*)A; const char* cB = (const char*)Bt + (size_t)cur.pb * tstep;
    PG8_STAGE(PG8_SB(0, 0), cB, voffB); PG8_STAGE(PG8_SB(0, 1), cB + hstep, voffB); PG8_STAGE(PG8_SA(0, 0), cA, ca[0]); PG8_STAGE(PG8_SA(0, 1), cA, ca[1]);
    if (wr == 1) PG8_BAR;
    PG8_WAIT_V(2); PG8_BAR;
    PG8_STAGE(PG8_SB(1, 0), cB + kstep, voffB); PG8_STAGE(PG8_SA(1, 0), cA + kstepA, ca[0]); PG8_STAGE(PG8_SB(1, 1), cB + hstep + kstep, voffB);
    PG8_WAIT_V(6); PG8_BAR;
    for (;;) {
        const bool has_next = S.next(ui + 1, nxt);
        if (has_next) { PG8_AOFF(na, nxt, ui + 1); }
        else {
#pragma unroll
            for (int h = 0; h < 2; ++h)
#pragma unroll
                for (int i = 0; i < 2; ++i) na[h][i] = ca[h][i];
        }
        const char* nB = has_next ? (const char*)Bt + (size_t)nxt.pb * tstep : cB;
#pragma unroll 1
        for (int pass = 0; pass < NPASS; ++pass)
#pragma unroll 1
        for (int t = 0; t < nt; t += 2) {
            const bool lastp = (pass == NPASS - 1);
            const bool last = (t == nt - 2);
            const char* a1 = cA + (size_t)(t + 1) * kstepA;
            const char* a2 = last ? cA : cA + (size_t)(t + 2) * kstepA; const char* b2 = last ? (lastp ? nB : cB) : cB + (size_t)(t + 2) * kstep;
            const char* a3 = a2 + kstepA; const char* b3 = b2 + kstep;
            unsigned o2[2][2];
#pragma unroll
            for (int h = 0; h < 2; ++h)
#pragma unroll
                for (int i = 0; i < 2; ++i) o2[h][i] = (last && lastp) ? na[h][i] : ca[h][i];
            constexpr bool relax = false;
            PG8_LDB(B0, 0, 0); PG8_LDB(B1, 0, 1); PG8_SCHED; PG8_LDA(At, 0, 0); PG8_STAGE(PG8_SA(1, 1), a1, ca[1]);
            PG8_WAIT_VR(relax); PG8_WAIT_L(0); PG8_BAR; PG8_MMA(0, 0, At, B0); PG8_MMA(0, 1, At, B1); PG8_BAR; PG8_SCHED;
            PG8_LDA(At, 0, 1); PG8_STAGE(PG8_SB(0, 0), b2, voffB); PG8_STAGE(PG8_SB(0, 1), b2 + hstep, voffB); PG8_STAGE(PG8_SA(0, 0), a2, o2[0]);
            PG8_WAIT_VR(relax); PG8_WAIT_L(0); PG8_BAR; PG8_MMA(1, 0, At, B0); PG8_MMA(1, 1, At, B1); PG8_BAR; PG8_SCHED;
            PG8_LDB(B0, 1, 0); PG8_LDB(B1, 1, 1); PG8_SCHED; PG8_LDA(At, 1, 0); PG8_STAGE(PG8_SA(0, 1), a2, o2[1]);
            PG8_WAIT_V(8); PG8_WAIT_L(0); PG8_BAR; PG8_MMA(0, 0, At, B0); PG8_MMA(0, 1, At, B1); PG8_BAR; PG8_SCHED;
            PG8_LDA(At, 1, 1); PG8_STAGE(PG8_SB(1, 0), b3, voffB); PG8_STAGE(PG8_SB(1, 1), b3 + hstep, voffB); PG8_STAGE(PG8_SA(1, 0), a3, o2[0]);
            PG8_WAIT_V(8); PG8_WAIT_L(0); PG8_BAR; PG8_MMA(1, 0, At, B0); PG8_MMA(1, 1, At, B1); PG8_BAR; PG8_SCHED;
        }
        if constexpr (ALIGN_EPI) { if (wr == 0) PG8_BAR; }
        if constexpr (FP8) asm volatile("s_nop 15\n\ts_nop 15" ::: "memory");
        if constexpr (PF) {
            if (has_next) {
                const int npf = (nt - 2) * 256;
                LAS unsigned* dmy = (LAS unsigned*)(lds + PF_DUMMY_OFF + wid * 256);
                for (int idx = tid; idx < npf; idx += 512) { const int kt = 2 + (idx >> 8), ln = idx & 255;
                    const char* pb = nB + (size_t)kt * kstep + ln * 128;
                    __builtin_amdgcn_global_load_lds((const unsigned*)pb, dmy, 4, 0, 0);
                    const char* pa = rowidx ? (const char*)A + (size_t)((int)rowidx[nxt.i * BM + ln] * ldA) + (size_t)kt * 128
                                            : (const char*)A + ((size_t)(nxt.pm * nt + kt) << 15) + ln * 128;
                    __builtin_amdgcn_global_load_lds((const unsigned*)pa, dmy, 4, 0, 0); }
            }
        }
        if constexpr (NPASS > 1) {
#pragma unroll
            for (int a = 0; a < 2; ++a)
#pragma unroll
                for (int b = 0; b < 2; ++b)
#pragma unroll
                    for (int m = 0; m < 4; ++m)
#pragma unroll
                        for (int n = 0; n < 2; ++n) acc[a][b][m][n] *= (1.0f / NPASS);
        }
        E(acc, cur, wr, wc, fr, fq);
        if constexpr (((REPMASK >> 13) & 1) != 0) { asm volatile("" ::: "memory"); E(acc, cur, wr, wc, fr, fq); }
        if (!has_next) break;
#pragma unroll
        for (int a = 0; a < 2; ++a)
#pragma unroll
            for (int b = 0; b < 2; ++b)
#pragma unroll
                for (int m = 0; m < 4; ++m)
#pragma unroll
                    for (int n = 0; n < 2; ++n) acc[a][b][m][n] = (f32x4){0.f, 0.f, 0.f, 0.f};
        cur = nxt; cB = nB; ++ui;
#pragma unroll
        for (int h = 0; h < 2; ++h)
#pragma unroll
            for (int i = 0; i < 2; ++i) ca[h][i] = na[h][i];
        if constexpr (ALIGN_EPI) { if (wr == 1) PG8_BAR; }
    }
    PG8_WAIT_V(0);
    if constexpr (!ALIGN_EPI) { if (wr == 0) PG8_BAR; }
    PG8_BAR;
#undef PG8_SA
#undef PG8_SB
#undef PG8_STAGE
#undef PG8_LDA
#undef PG8_LDB
#undef PG8_MMA
#undef PG8_F8
#undef PG8_WAIT_V
#undef PG8_WAIT_L
#undef PG8_WAIT_VR
#undef PG8_BAR
#undef PG8_SCHED
#undef PG8_AOFF
}

struct EpiBf16 {
    static constexpr bool PERM = true; static constexpr int NST = 16;
    bf16_t* O; int ldc;
    __device__ __forceinline__ void operator()(const f32x4 (&acc)[2][2][4][2], const Unit& u, int wr, int wc, int fr, int fq) const {
        const int row0 = u.pm * BM + wr * 64 + fr, col0 = u.pn * BM + wc * 32 + 8 * fq;
#pragma unroll
        for (int ai = 0; ai < 2; ++ai)
#pragma unroll
            for (int m = 0; m < 4; ++m) { bf16_t* rowp = O + (size_t)(row0 + ai * HALF + m * 16) * ldc + col0;
#pragma unroll
                for (int bj = 0; bj < 2; ++bj) { const f32x4 v0 = acc[ai][bj][m][0], v1 = acc[ai][bj][m][1];
                    u32x4 w; w.x = cvt_pk_bf16(v0[0], v0[1]); w.y = cvt_pk_bf16(v0[2], v0[3]); w.z = cvt_pk_bf16(v1[0], v1[1]); w.w = cvt_pk_bf16(v1[2], v1[3]);
                    *(u32x4*)(rowp + bj * HALF) = w; } }
    }
};
struct EpiResBf16 {
    static constexpr bool PERM = true; static constexpr int NST = 0;
    const float* __restrict__ base; bf16_t* __restrict__ O; int ldc;
    __device__ __forceinline__ void operator()(const f32x4 (&acc)[2][2][4][2], const Unit& u, int wr, int wc, int fr, int fq) const {
        const int row0 = u.pm * BM + wr * 64 + fr, col0 = u.pn * BM + wc * 32 + 8 * fq;
#pragma unroll
        for (int ai = 0; ai < 2; ++ai)
#pragma unroll
            for (int mp = 0; mp < 2; ++mp) {
                f32x4 bs[2][2][2];
#pragma unroll
                for (int mm = 0; mm < 2; ++mm)
#pragma unroll
                    for (int bj = 0; bj < 2; ++bj)
#pragma unroll
                        for (int n = 0; n < 2; ++n) bs[mm][bj][n] = *(const f32x4*)(base + (size_t)(row0 + ai * HALF + (2 * mp + mm) * 16) * ldc + col0 + bj * HALF + 4 * n);
#pragma unroll
                for (int mm = 0; mm < 2; ++mm)
#pragma unroll
                    for (int bj = 0; bj < 2; ++bj) { const int m = 2 * mp + mm; const f32x4 v0 = acc[ai][bj][m][0] + bs[mm][bj][0], v1 = acc[ai][bj][m][1] + bs[mm][bj][1];
                        u32x4 w; w.x = cvt_pk_bf16(v0[0], v0[1]); w.y = cvt_pk_bf16(v0[2], v0[3]); w.z = cvt_pk_bf16(v1[0], v1[1]); w.w = cvt_pk_bf16(v1[2], v1[3]);
                        *(u32x4*)(O + (size_t)(row0 + ai * HALF + m * 16) * ldc + col0 + bj * HALF) = w; }
            }
    }
};
struct EpiSwiglu {
    static constexpr bool PERM = true; static constexpr int NST = 8;
    bf16_t* Hb; const LAS float* bias; const LAS float* rstd;
    __device__ __forceinline__ void operator()(const f32x4 (&acc)[2][2][4][2], const Unit& u, int wr, int wc, int fr, int fq) const {
        const int row0 = u.pm * BM + wr * 64 + fr, col0 = u.pn * HALF + wc * 32 + 8 * fq;
        const LAS float* bg = bias + u.i * 256 + wc * 32 + 8 * fq; const LAS float* bu = bg + 128;
        const f32x4 g0 = *(const LAS f32x4*)bg, g1 = *(const LAS f32x4*)(bg + 4), u0 = *(const LAS f32x4*)bu, u1 = *(const LAS f32x4*)(bu + 4);
        float rsv[2][4];
#pragma unroll
        for (int ai = 0; ai < 2; ++ai)
#pragma unroll
            for (int m = 0; m < 4; ++m) rsv[ai][m] = rstd[u.i * 256 + wr * 64 + fr + ai * HALF + m * 16];
#pragma unroll
        for (int ai = 0; ai < 2; ++ai)
#pragma unroll
            for (int m = 0; m < 4; ++m) {
                float r[8]; const float rs = rsv[ai][m];
#pragma unroll
                for (int n = 0; n < 2; ++n)
#pragma unroll
                    for (int j = 0; j < 4; ++j) {
                        float gt = acc[ai][0][m][n][j] * rs + (n ? g1[j] : g0[j]); float up = acc[ai][1][m][n][j] * rs + (n ? u1[j] : u0[j]);
                        gt = fminf(gt, 7.0f); up = fminf(fmaxf(up, -7.0f), 7.0f);
                        const float glu = gt * __builtin_amdgcn_rcpf(1.0f + __builtin_amdgcn_exp2f(gt * (-1.702f * 1.4426950408889634f)));
                        r[n * 4 + j] = (up + 1.0f) * glu; }
                if constexpr (MOE_FP8) { u32x2 w; w.x = pk4_fp8(r[0], r[1], r[2], r[3]); w.y = pk4_fp8(r[4], r[5], r[6], r[7]);
                    *(u32x2*)((unsigned char*)Hb + tiled_off(row0 + ai * HALF + m * 16, col0, FF / 128)) = w; }
                else { u32x4 w; w.x = cvt_pk_bf16(r[0], r[1]); w.y = cvt_pk_bf16(r[2], r[3]); w.z = cvt_pk_bf16(r[4], r[5]); w.w = cvt_pk_bf16(r[6], r[7]);
                    *(u32x4*)((unsigned char*)Hb + tiled_off(row0 + ai * HALF + m * 16, 2 * col0, FF / 64)) = w; } }
    }
};
struct EpiDown {
    static constexpr bool PERM = true; static constexpr int NST = 16;
    unsigned char* Cb; const LAS float* bias; const LAS float* gate;
    __device__ __forceinline__ void operator()(const f32x4 (&acc)[2][2][4][2], const Unit& u, int wr, int wc, int fr, int fq) const {
        const int row0 = u.pm * BM + wr * 64 + fr, col0 = u.pn * BM + wc * 32 + 8 * fq;
        f32x4 bv[2][2]; float gtv[2][4];
#pragma unroll
        for (int bj = 0; bj < 2; ++bj)
#pragma unroll
            for (int n = 0; n < 2; ++n) bv[bj][n] = *(const LAS f32x4*)(bias + u.i * 256 + wc * 32 + 8 * fq + bj * HALF + 4 * n);
#pragma unroll
        for (int ai = 0; ai < 2; ++ai)
#pragma unroll
            for (int m = 0; m < 4; ++m) gtv[ai][m] = gate[u.i * 256 + wr * 64 + fr + ai * HALF + m * 16] * (MOE_FP8 ? 16.0f : 1.0f);
#pragma unroll
        for (int ai = 0; ai < 2; ++ai)
#pragma unroll
            for (int m = 0; m < 4; ++m) { const int row = row0 + ai * HALF + m * 16; const float gt = gtv[ai][m];
#pragma unroll
                for (int bj = 0; bj < 2; ++bj) { const f32x4 v0 = (acc[ai][bj][m][0] + bv[bj][0]) * gt, v1 = (acc[ai][bj][m][1] + bv[bj][1]) * gt;
                    if constexpr (MOE_FP8) { u32x2 w; w.x = pk4_fp8(v0[0], v0[1], v0[2], v0[3]); w.y = pk4_fp8(v1[0], v1[1], v1[2], v1[3]);
                        *(u32x2*)(Cb + (size_t)row * D + col0 + bj * HALF) = w; }
                    else { u32x4 w; w.x = cvt_pk_bf16(v0[0], v0[1]); w.y = cvt_pk_bf16(v0[2], v0[3]); w.z = cvt_pk_bf16(v1[0], v1[1]); w.w = cvt_pk_bf16(v1[2], v1[3]);
                        *(u32x4*)((bf16_t*)Cb + (size_t)row * D + col0 + bj * HALF) = w; } } }
    }
};
}

struct Args { const float* in[16]; float* out; unsigned char* ws; int ph_lo, ph_hi, li, pad; };
struct Frame {
    LAS unsigned char* lds; int tid, lane, wave, G, bx;
    const float *x, *g_mix, *w_in, *conv_w, *w_gk_up, *b_gk_up, *gla_g, *w_out, *g_ffn, *w_router, *b_router, *w_gu, *b_gu, *w_dn, *b_dn, *g_fin;
    float* out; unsigned char* ws;
};

struct P0Item { const float* W; unsigned char* dst; int ldn, k0, seg0, seg1; bool f8; };
__device__ __forceinline__ void p0_decode(Frame& F, int it, P0Item& I) {
    constexpr int ES = MOE_FP8 ? 1 : 2, NTE = D * ES / 128;
    constexpr int I_1 = (NPROJ / 256) * 16, I_O = (D / 256) * 16, I_GU = (2 * FF / 256) * NTE, I_DN = (D / 256) * NTE;
    if (it < I_1) { const int tile = it / 16, kt = it % 16; I = P0Item{F.w_in, F.ws + WS_W1T + ((size_t)(tile * 16 + kt) << 15), DIN, 64 * kt, 256 * tile, 256 * tile + 128, false}; return; }
    it -= I_1;
    if (it < I_O) { const int tile = it / 16, kt = it % 16; I = P0Item{F.w_out, F.ws + WS_WOT + ((size_t)(tile * 16 + kt) << 15), D, 64 * kt, 256 * tile, 256 * tile + 128, false}; return; }
    it -= I_O;
    const int e = it / (I_GU + I_DN); it -= e * (I_GU + I_DN);
    if (it < I_GU) { const int pn = it / NTE, kt = it % NTE;
        I = P0Item{F.w_gu + (size_t)e * D * 2 * FF, F.ws + WS_WGUT + ((size_t)((e * 8 + pn) * NTE + kt) << 15), 2 * FF, (128 / ES) * kt, 128 * pn, FF + 128 * pn, MOE_FP8 != 0}; return; }
    it -= I_GU;
    { const int pn = it / NTE, kt = it % NTE;
      I = P0Item{F.w_dn + (size_t)e * FF * D, F.ws + WS_WDT + ((size_t)((e * 4 + pn) * NTE + kt) << 15), D, (128 / ES) * kt, 256 * pn, 256 * pn + 128, MOE_FP8 != 0}; }
}
__device__ __forceinline__ void p0_load(const P0Item& I, int lane, int wave, f32x4 (&v)[16]) {
    const int n4 = 4 * lane, col = n4 < 128 ? I.seg0 + n4 : I.seg1 + (n4 - 128);
    const int kpw = I.f8 ? 16 : 8;
    const float* src = I.W + (size_t)(I.k0 + kpw * wave) * I.ldn + col;
#pragma unroll
    for (int kk = 0; kk < 8; ++kk) v[kk] = *(const GAS f32x4*)(src + (size_t)kk * I.ldn);
    if (I.f8) {
#pragma unroll
        for (int kk = 8; kk < 16; ++kk) v[kk] = *(const GAS f32x4*)(src + (size_t)kk * I.ldn);
    }
}
constexpr int W16P = 1032;
__device__ __forceinline__ void p0_prep(Frame& F) {
    LAS bf16_t* w16 = (LAS bf16_t*)F.lds;
    LAS float* part = (LAS float*)(F.lds + 16 * W16P * 2);
    bf16_t* XN = (bf16_t*)(F.ws + WS_XN); float* GKL = (float*)(F.ws + WS_GKL);
    { const int lane = F.lane, w = F.wave, fr = lane & 15, fq = lane >> 4, rt = w & 3, kh = w >> 2;
      bool w16_ready = false;
      for (int rep_a = 0; rep_a < 1 + ((REPMASK >> 11) & 1); ++rep_a)
      for (int grp = F.bx; grp < M / 64; grp += F.G) {
        const int m = grp * 64 + rt * 16 + fr;
        const float* xrow = F.x + (size_t)m * D + kh * 512 + 8 * fq; const float* grow = F.g_mix + kh * 512 + 8 * fq;
        f32x4 xv[16][2]; float s2 = 0.f; f32x4 c = (f32x4){0.f, 0.f, 0.f, 0.f};
#pragma unroll
        for (int s = 0; s < 16; ++s) { xv[s][0] = *(const f32x4*)(xrow + 32 * s); xv[s][1] = *(const f32x4*)(xrow + 32 * s + 4); }
        if (!w16_ready) {
            for (int i = F.tid; i < 1024 * 16; i += NTHR) { const int k = i >> 4, r = i & 15; w16[r * W16P + k] = (bf16_t)f2bf(F.w_in[(size_t)k * DIN + C_GKL + r]); }
            __syncthreads(); w16_ready = true; }
#pragma unroll
        for (int s = 0; s < 16; ++s) {
            const f32x4 g0 = *(const f32x4*)(grow + 32 * s), g1 = *(const f32x4*)(grow + 32 * s + 4);
            const f32x4 x0 = xv[s][0], x1v = xv[s][1];
            s2 += (x0.x * x0.x + x0.y * x0.y) + (x0.z * x0.z + x0.w * x0.w) + (x1v.x * x1v.x + x1v.y * x1v.y) + (x1v.z * x1v.z + x1v.w * x1v.w);
            xv[s][0] = x0 * g0; xv[s][1] = x1v * g1;
            const u32x4 hv = {pk2(xv[s][0].x, xv[s][0].y), pk2(xv[s][0].z, xv[s][0].w), pk2(xv[s][1].x, xv[s][1].y), pk2(xv[s][1].z, xv[s][1].w)};
            const bf16x8 bb = *(const LAS bf16x8*)(w16 + fr * W16P + kh * 512 + 32 * s + 8 * fq);
            c = __builtin_amdgcn_mfma_f32_16x16x32_bf16(__builtin_bit_cast(bf16x8, hv), bb, c, 0, 0, 0);
        }
        s2 += __shfl_xor(s2, 16); s2 += __shfl_xor(s2, 32);
#pragma unroll
        for (int r = 0; r < 4; ++r) part[(kh * 64 + rt * 16 + 4 * fq + r) * 17 + fr] = c[r];
        if (fq == 0) part[(kh * 64 + rt * 16 + fr) * 17 + 16] = s2;
        __syncthreads();
        const int rowl = rt * 16 + fr;
        const float rstd = __builtin_amdgcn_rsqf((part[rowl * 17 + 16] + part[(64 + rowl) * 17 + 16]) * (1.0f / D) + RMS_EPS);
#pragma unroll
        for (int s = 0; s < 16; ++s) { const f32x4 a = xv[s][0] * rstd, b = xv[s][1] * rstd;
            const u32x4 o = {pk2(a.x, a.y), pk2(a.z, a.w), pk2(b.x, b.y), pk2(b.z, b.w)};
            *(GAS u32x4*)((unsigned char*)XN + tiled_off(m, 2 * (kh * 512 + 32 * s + 8 * fq), D / 64)) = o; }
        if (F.tid < 64) { const int row = F.tid; const float rs = __builtin_amdgcn_rsqf((part[row * 17 + 16] + part[(64 + row) * 17 + 16]) * (1.0f / D) + RMS_EPS);
#pragma unroll
            for (int q = 0; q < 4; ++q) { f32x4 o;
#pragma unroll
                for (int j = 0; j < 4; ++j) o[j] = (part[row * 17 + 4 * q + j] + part[(64 + row) * 17 + 4 * q + j]) * rs;
                *(f32x4*)(GKL + (size_t)(grp * 64 + row) * 16 + 4 * q) = o; } }
        __syncthreads();
      }
    }
}
__device__ __forceinline__ void p0b_weights(Frame& F, const int it_lo, const int it_hi, const int start, const int step, const bool router_img) {
    if (router_img && F.bx < NE) { bf16_t* img = (bf16_t*)(F.ws + WS_WRIMG); const int e = F.bx;
        for (int k = F.tid; k < 1024; k += NTHR) { const float wv = F.w_router[k * NE + e]; const unsigned h = f2bf(wv); const float hf = __builtin_bit_cast(float, h << 16);
            img[e * 1032 + k] = (bf16_t)h; img[32 * 1032 + e * 1032 + k] = (bf16_t)f2bf(wv - hf); }
        if (F.tid < 8) { img[e * 1032 + 1024 + F.tid] = 0; img[32 * 1032 + e * 1032 + 1024 + F.tid] = 0; } }
    __syncthreads();
    {
        constexpr int ES = MOE_FP8 ? 1 : 2, NTE = D * ES / 128;
        const int NITEMS = it_hi, G_ = step;
        LAS unsigned char* img = F.lds;
        const int lane = F.lane, w = F.wave;
        {
        P0Item ia, ib; f32x4 va[16], vb[16];
        int it = it_lo + start;
        if (it < NITEMS) { p0_decode(F, it, ia); p0_load(ia, lane, w, va); }
        if (it + G_ < NITEMS) { p0_decode(F, it + G_, ib); p0_load(ib, lane, w, vb); }
#define P0_CONVERT(I, V) do { _Pragma("unroll") for (int j = 0; j < 4; ++j) { u32x4 o; \
            if ((I).f8) { o.x = pk4_fp8(V[0][j] * 32.f, V[1][j] * 32.f, V[2][j] * 32.f, V[3][j] * 32.f); o.y = pk4_fp8(V[4][j] * 32.f, V[5][j] * 32.f, V[6][j] * 32.f, V[7][j] * 32.f); \
                          o.z = pk4_fp8(V[8][j] * 32.f, V[9][j] * 32.f, V[10][j] * 32.f, V[11][j] * 32.f); o.w = pk4_fp8(V[12][j] * 32.f, V[13][j] * 32.f, V[14][j] * 32.f, V[15][j] * 32.f); } \
            else { o.x = pk2(V[0][j], V[1][j]); o.y = pk2(V[2][j], V[3][j]); o.z = pk2(V[4][j], V[5][j]); o.w = pk2(V[6][j], V[7][j]); } \
            *(LAS u32x4*)(img + (4 * lane + j) * 128 + ((w ^ (lane & 7)) << 4)) = o; } } while (0)
#define P0_STORE(DST) do { __syncthreads(); _Pragma("unroll") for (int q = 0; q < 4; ++q) { const int idx = F.tid + NTHR * q, n = idx >> 3, c = idx & 7; \
            const u32x4 o = *(const LAS u32x4*)(img + n * 128 + ((c ^ ((n >> 2) & 7)) << 4)); *(GAS u32x4*)((DST) + (size_t)idx * 16) = o; } __syncthreads(); } while (0)
        for (; it < NITEMS; it += 2 * G_) {
            { unsigned char* dst = ia.dst; P0_CONVERT(ia, va);
              if (it + 2 * G_ < NITEMS) { p0_decode(F, it + 2 * G_, ia); p0_load(ia, lane, w, va); }
              P0_STORE(dst); }
            if (it + G_ < NITEMS) { unsigned char* dst = ib.dst; P0_CONVERT(ib, vb);
              if (it + 3 * G_ < NITEMS) { p0_decode(F, it + 3 * G_, ib); p0_load(ib, lane, w, vb); }
              P0_STORE(dst); }
        }
#undef P0_CONVERT
#undef P0_STORE
        }
    }
}

struct GlaIn { f32x4 gl[4]; u32x4 q, k, v0, v1, g0, g1; };
template <bool OUT>
__device__ __forceinline__ void gla_load(Frame& F, int u, GlaIn& L) {
    const bf16_t* PROJ = (const bf16_t*)(F.ws + WS_PROJ); const float* GKL = (const float*)(F.ws + WS_GKL);
    const int b = u / (NH * NCH), h = (u / NCH) % NH, n = u % NCH, tok0 = b * SEQ + n * CHUNK, tok = tok0 + F.lane, w = F.wave;
#pragma unroll
    for (int q = 0; q < 4; ++q) L.gl[q] = *(const f32x4*)(GKL + (size_t)tok * 16 + 4 * q);
    L.k = *(const u32x4*)(PROJ + (size_t)tok * NPROJ + C_K + h * DK + 8 * w);
    L.v0 = *(const u32x4*)(PROJ + (size_t)tok * NPROJ + C_V + h * DV + 16 * w); L.v1 = *(const u32x4*)(PROJ + (size_t)tok * NPROJ + C_V + h * DV + 16 * w + 8);
    if constexpr (OUT) {
        L.q = *(const u32x4*)(PROJ + (size_t)tok * NPROJ + C_Q + h * DK + 8 * w);
        const bf16_t* gp = PROJ + (size_t)(tok0 + (F.tid >> 3)) * NPROJ + C_G + h * DV + 16 * (F.tid & 7);
        L.g0 = *(const u32x4*)gp; L.g1 = *(const u32x4*)(gp + 8);
    }
}
constexpr int WGK_OFF = 81920;
__device__ __forceinline__ void gla_stage_wgk(Frame& F) {
    LAS float* wgk = (LAS float*)(F.lds + WGK_OFF);
    for (int i = F.tid; i < 17 * 256; i += NTHR) wgk[i] = i < 16 * 256 ? F.w_gk_up[i] : F.b_gk_up[i - 16 * 256];
    __syncthreads();
}
__device__ __forceinline__ void gla_decay(Frame& F, const GlaIn& L, int h, float (&bc)[8], float (&blast)[8]) {
    const LAS float* wgk = (const LAS float*)(F.lds + WGK_OFF);
    const float gl[16] = {L.gl[0].x, L.gl[0].y, L.gl[0].z, L.gl[0].w, L.gl[1].x, L.gl[1].y, L.gl[1].z, L.gl[1].w, L.gl[2].x, L.gl[2].y, L.gl[2].z, L.gl[2].w, L.gl[3].x, L.gl[3].y, L.gl[3].z, L.gl[3].w};
    const int dbase = h * DK + 8 * F.wave;
#pragma unroll
    for (int i = 0; i < 8; ++i) {
        float gk = wgk[16 * 256 + dbase + i];
#pragma unroll
        for (int r = 0; r < 16; ++r) gk += gl[r] * wgk[r * (NH * DK) + dbase + i];
        float la = log_sigmoidf_(gk) * (1.0f / 16.0f);
        la = wave_incl_scan(la);
        bc[i] = la; blast[i] = __builtin_bit_cast(float, __builtin_amdgcn_readlane(__builtin_bit_cast(int, la), 63));
        asm volatile("" ::: "memory");
    }
}

constexpr int LP = 72;
__device__ __forceinline__ void p2_gla_kv(Frame& F) {
    float* KVT = (float*)(F.ws + WS_KVT); float* DEC = (float*)(F.ws + WS_DEC);
    LAS bf16_t* kremT = (LAS bf16_t*)F.lds;
    LAS bf16_t* vT = (LAS bf16_t*)(F.lds + 64 * LP * 2);
    const int lane = F.lane, w = F.wave;
    gla_stage_wgk(F);
    GlaIn cur, nxt;
    if (F.bx < NUNITS_GLA) gla_load<false>(F, F.bx, cur);
    for (int u = F.bx; u < NUNITS_GLA; u += F.G) {
        if (u + F.G < NUNITS_GLA) gla_load<false>(F, u + F.G, nxt);
        const int h = (u / NCH) % NH;
        float bc[8], blast[8];
        gla_decay(F, cur, h, bc, blast);
        const unsigned kw[4] = {cur.k.x, cur.k.y, cur.k.z, cur.k.w};
#pragma unroll
        for (int i = 0; i < 8; ++i) { const float kv = (i & 1) ? bfhi(kw[i >> 1]) : bflo(kw[i >> 1]);
            kremT[(8 * w + i) * LP + lane] = (bf16_t)f2bf(kv * __expf(blast[i] - bc[i])); }
        if (lane == 0) {
#pragma unroll
            for (int i = 0; i < 8; ++i) DEC[(size_t)u * DK + 8 * w + i] = __expf(blast[i]);
        }
        { const unsigned vw[8] = {cur.v0.x, cur.v0.y, cur.v0.z, cur.v0.w, cur.v1.x, cur.v1.y, cur.v1.z, cur.v1.w};
#pragma unroll
          for (int i = 0; i < 16; ++i) vT[(16 * w + i) * LP + lane] = (bf16_t)((i & 1) ? (vw[i >> 1] >> 16) : (vw[i >> 1] & 0xffffu)); }
        __syncthreads();
        const int fr = lane & 15, fq = lane >> 4;
        bf16x8 a[2];
#pragma unroll
        for (int s = 0; s < 2; ++s) a[s] = *(const LAS bf16x8*)(vT + (16 * w + fr) * LP + 8 * fq + 32 * s);
#pragma unroll
        for (int dt = 0; dt < 4; ++dt) {
            f32x4 c = (f32x4){0.f, 0.f, 0.f, 0.f};
#pragma unroll
            for (int s = 0; s < 2; ++s) { const bf16x8 bb = *(const LAS bf16x8*)(kremT + (16 * dt + fr) * LP + 8 * fq + 32 * s); c = __builtin_amdgcn_mfma_f32_16x16x32_bf16(a[s], bb, c, 0, 0, 0); }
#pragma unroll
            for (int r = 0; r < 4; ++r) KVT[((size_t)u * DV + 16 * w + 4 * fq + r) * DK + 16 * dt + fr] = c[r];
        }
        __syncthreads();
        cur.gl[0] = nxt.gl[0]; cur.gl[1] = nxt.gl[1]; cur.gl[2] = nxt.gl[2]; cur.gl[3] = nxt.gl[3]; cur.k = nxt.k; cur.v0 = nxt.v0; cur.v1 = nxt.v1;
    }
}

__device__ __forceinline__ void p3_scan(Frame& F) {
    const float* KVT = (const float*)(F.ws + WS_KVT); const float* DEC = (const float*)(F.ws + WS_DEC); bf16_t* ST = (bf16_t*)(F.ws + WS_ST);
    for (int gid = F.bx * NTHR + F.tid; gid < BATCH * NH * DV * DK; gid += F.G * NTHR) {
        const int bh = gid >> 13, vd = gid & 8191, d = gid & 63;
        float S = 0.f;
#pragma unroll 8
        for (int n = 0; n < NCH; ++n) { const size_t u = (size_t)bh * NCH + n;
            ST[u * (DV * DK) + vd] = (bf16_t)f2bf(S);
            S = DEC[u * DK + d] * S + KVT[u * (DV * DK) + vd]; }
    }
}

constexpr int OTP = 132;
__device__ __forceinline__ void p4_gla_out(Frame& F) {
    const bf16_t* PROJ = (const bf16_t*)(F.ws + WS_PROJ); bf16_t* Y = (bf16_t*)(F.ws + WS_Y);
    LAS bf16_t* qd = (LAS bf16_t*)F.lds;
    LAS bf16_t* kd = (LAS bf16_t*)(F.lds + 64 * LP * 2);
    LAS bf16_t* vT = (LAS bf16_t*)(F.lds + 2 * 64 * LP * 2);
    LAS bf16_t* pm = (LAS bf16_t*)(F.lds + 4 * 64 * LP * 2);
    LAS float* red = (LAS float*)(F.lds + 5 * 64 * LP * 2);
    LAS float* ot = (LAS float*)(F.lds + 5 * 64 * LP * 2 + 512);
    const int lane = F.lane, w = F.wave, fr = lane & 15, fq = lane >> 4;
    const int ct = w & 3, vt0 = 4 * (w >> 2);
    float gng[4];
#pragma unroll
    for (int vi = 0; vi < 4; ++vi) gng[vi] = F.gla_g[16 * (vt0 + vi) + fr];
    gla_stage_wgk(F);
    GlaIn cur, nxt;
    for (int rep_g = 0; rep_g < 1 + ((REPMASK >> 20) & 1); ++rep_g) {
    if (F.bx < NUNITS_GLA) gla_load<true>(F, F.bx, cur);
    for (int u = F.bx; u < NUNITS_GLA; u += F.G) {
        if (u + F.G < NUNITS_GLA) gla_load<true>(F, u + F.G, nxt);
        const int b = u / (NH * NCH), h = (u / NCH) % NH, n = u % NCH;
        const int tok0 = b * SEQ + n * CHUNK;
        bf16x8 stf[4][2];
        { const bf16_t* ST = (const bf16_t*)(F.ws + WS_ST);
#pragma unroll
          for (int vi = 0; vi < 4; ++vi)
#pragma unroll
              for (int s = 0; s < 2; ++s) stf[vi][s] = *(const bf16x8*)(ST + ((size_t)u * DV + 16 * (vt0 + vi) + fr) * DK + 8 * fq + 32 * s); }
        float bc[8], blast[8];
        gla_decay(F, cur, h, bc, blast);
        { const unsigned qw[4] = {cur.q.x, cur.q.y, cur.q.z, cur.q.w}, kw[4] = {cur.k.x, cur.k.y, cur.k.z, cur.k.w};
          u32x4 qo, ko; unsigned qq[4], kk[4];
#pragma unroll
          for (int p = 0; p < 4; ++p) { const float e0 = __expf(bc[2 * p]), e1 = __expf(bc[2 * p + 1]);
              qq[p] = pk2(bflo(qw[p]) * 0.125f * e0, bfhi(qw[p]) * 0.125f * e1);
              kk[p] = pk2(bflo(kw[p]) * __expf(-bc[2 * p]), bfhi(kw[p]) * __expf(-bc[2 * p + 1])); }
          qo.x = qq[0]; qo.y = qq[1]; qo.z = qq[2]; qo.w = qq[3]; ko.x = kk[0]; ko.y = kk[1]; ko.z = kk[2]; ko.w = kk[3];
          *(LAS u32x4*)(qd + lane * LP + 8 * w) = qo; *(LAS u32x4*)(kd + lane * LP + 8 * w) = ko; }
        { const unsigned vw[8] = {cur.v0.x, cur.v0.y, cur.v0.z, cur.v0.w, cur.v1.x, cur.v1.y, cur.v1.z, cur.v1.w};
#pragma unroll
          for (int i = 0; i < 16; ++i) vT[(16 * w + i) * LP + lane] = (bf16_t)((i & 1) ? (vw[i >> 1] >> 16) : (vw[i >> 1] & 0xffffu)); }
        __syncthreads();
        { const int cts = w >> 1;
          bf16x8 a[2];
#pragma unroll
          for (int s = 0; s < 2; ++s) a[s] = *(const LAS bf16x8*)(qd + (16 * cts + fr) * LP + 8 * fq + 32 * s);
#pragma unroll
          for (int jj = 0; jj < 2; ++jj) { const int jt = 2 * (w & 1) + jj;
              f32x4 c = (f32x4){0.f, 0.f, 0.f, 0.f};
#pragma unroll
              for (int s = 0; s < 2; ++s) { const bf16x8 bb = *(const LAS bf16x8*)(kd + (16 * jt + fr) * LP + 8 * fq + 32 * s); c = __builtin_amdgcn_mfma_f32_16x16x32_bf16(a[s], bb, c, 0, 0, 0); }
#pragma unroll
              for (int r = 0; r < 4; ++r) { const int cc = 16 * cts + 4 * fq + r, jcol = 16 * jt + fr; pm[cc * LP + jcol] = (bf16_t)f2bf(jcol <= cc ? c[r] : 0.f); } } }
        __syncthreads();
        bf16x8 ap[2], aq[2];
#pragma unroll
        for (int s = 0; s < 2; ++s) { ap[s] = *(const LAS bf16x8*)(pm + (16 * ct + fr) * LP + 8 * fq + 32 * s); aq[s] = *(const LAS bf16x8*)(qd + (16 * ct + fr) * LP + 8 * fq + 32 * s); }
        f32x4 o[4]; float ss[4] = {0.f, 0.f, 0.f, 0.f};
#pragma unroll
        for (int vi = 0; vi < 4; ++vi) { const int vt = vt0 + vi;
            f32x4 c = (f32x4){0.f, 0.f, 0.f, 0.f};
#pragma unroll
            for (int s = 0; s < 2; ++s) { const bf16x8 bb = *(const LAS bf16x8*)(vT + (16 * vt + fr) * LP + 8 * fq + 32 * s); c = __builtin_amdgcn_mfma_f32_16x16x32_bf16(ap[s], bb, c, 0, 0, 0); }
#pragma unroll
            for (int s = 0; s < 2; ++s) c = __builtin_amdgcn_mfma_f32_16x16x32_bf16(aq[s], stf[vi][s], c, 0, 0, 0);
            o[vi] = c;
#pragma unroll
            for (int r = 0; r < 4; ++r) ss[r] += c[r] * c[r]; }
#pragma unroll
        for (int r = 0; r < 4; ++r) ss[r] = row16_sum(ss[r]);
        if (fr == 0) {
#pragma unroll
            for (int r = 0; r < 4; ++r) red[w * 16 + 4 * fq + r] = ss[r];
        }
        __syncthreads();
#pragma unroll
        for (int r = 0; r < 4; ++r) { const float tot = red[ct * 16 + 4 * fq + r] + red[(ct + 4) * 16 + 4 * fq + r]; const float rstd = __builtin_amdgcn_rsqf(tot * (1.0f / DV) + RMS_EPS);
#pragma unroll
            for (int vi = 0; vi < 4; ++vi) ot[(16 * ct + 4 * fq + r) * OTP + 16 * (vt0 + vi) + fr] = o[vi][r] * rstd * gng[vi]; }
        __syncthreads();
        { const int c = F.tid >> 3, sg = F.tid & 7; const LAS float* op = ot + c * OTP + 16 * sg;
          const unsigned gw[8] = {cur.g0.x, cur.g0.y, cur.g0.z, cur.g0.w, cur.g1.x, cur.g1.y, cur.g1.z, cur.g1.w};
          unsigned ow[8];
#pragma unroll
          for (int q = 0; q < 4; ++q) { const f32x4 ov = *(const LAS f32x4*)(op + 4 * q);
              const float ga = bflo(gw[2 * q]), gb = bfhi(gw[2 * q]), gc = bflo(gw[2 * q + 1]), gd = bfhi(gw[2 * q + 1]);
              ow[2 * q] = pk2(ov.x * (ga * sigmoidf_(ga)), ov.y * (gb * sigmoidf_(gb))); ow[2 * q + 1] = pk2(ov.z * (gc * sigmoidf_(gc)), ov.w * (gd * sigmoidf_(gd))); }
          unsigned char* yp = (unsigned char*)Y + tiled_off(tok0 + c, 2 * (CONVW + h * DV + 16 * sg), D / 64);
          *(u32x4*)yp = (u32x4){ow[0], ow[1], ow[2], ow[3]}; *(u32x4*)(yp + 16) = (u32x4){ow[4], ow[5], ow[6], ow[7]}; }
        __syncthreads();
        cur = nxt;
    }
    }
    for (int rep_c = 0; rep_c < 1 + ((REPMASK >> 21) & 1); ++rep_c)
    for (int it = F.bx * NTHR + F.tid; it < M * (CONVW / 8); it += F.G * NTHR) {
        const int t = it >> 6, c8 = (it & 63) * 8, s = t & (SEQ - 1);
        float acc[8];
#pragma unroll
        for (int j = 0; j < 8; ++j) acc[j] = 0.f;
#pragma unroll
        for (int i = 0; i < 3; ++i) { const int sp = s - 2 + i; if (sp < 0) continue;
            const size_t ro = (size_t)(t - 2 + i) * NPROJ;
            const u32x4 uh = *(const u32x4*)(PROJ + ro + C_UH + c8), gc = *(const u32x4*)(PROJ + ro + C_GC + c8);
            const unsigned uw[4] = {uh.x, uh.y, uh.z, uh.w}, gw[4] = {gc.x, gc.y, gc.z, gc.w};
            const f32x4 w0 = *(const f32x4*)(F.conv_w + i * CONVW + c8), w1 = *(const f32x4*)(F.conv_w + i * CONVW + c8 + 4);
            const float ww[8] = {w0.x, w0.y, w0.z, w0.w, w1.x, w1.y, w1.z, w1.w};
#pragma unroll
            for (int p = 0; p < 4; ++p) { acc[2 * p] += ww[2 * p] * (bflo(uw[p]) * bflo(gw[p])); acc[2 * p + 1] += ww[2 * p + 1] * (bfhi(uw[p]) * bfhi(gw[p])); } }
        const u32x4 gb = *(const u32x4*)(PROJ + (size_t)t * NPROJ + C_GB + c8); const unsigned bw[4] = {gb.x, gb.y, gb.z, gb.w};
        u32x4 o;
        o.x = pk2(bflo(bw[0]) * acc[0], bfhi(bw[0]) * acc[1]); o.y = pk2(bflo(bw[1]) * acc[2], bfhi(bw[1]) * acc[3]);
        o.z = pk2(bflo(bw[2]) * acc[4], bfhi(bw[2]) * acc[5]); o.w = pk2(bflo(bw[3]) * acc[6], bfhi(bw[3]) * acc[7]);
        *(u32x4*)((unsigned char*)Y + tiled_off(t, 2 * c8, D / 64)) = o;
    }
}

constexpr int WRP = 1032;
__device__ __forceinline__ void p6_router(Frame& F) {
    LAS bf16_t* wh = (LAS bf16_t*)F.lds;
    LAS bf16_t* wl = (LAS bf16_t*)(F.lds + 32 * WRP * 2);
    LAS float* lgp = (LAS float*)(F.lds + 2 * 32 * WRP * 2);
    LAS int* hist = (LAS int*)(F.lds + 2 * 32 * WRP * 2 + 2 * 64 * 33 * 4);
    const bf16_t* X1 = (const bf16_t*)(F.ws + WS_X1); bf16_t* XB = (bf16_t*)(F.ws + WS_XN); float* RSTD = (float*)(F.ws + WS_ROUTE + R_RSTD);
    int* TOPI = (int*)(F.ws + WS_ROUTE + R_TOPI); float* TOPG = (float*)(F.ws + WS_ROUTE + R_TOPG); int* HIST = (int*)(F.ws + WS_ROUTE + R_HIST);
    { const u32x4* img = (const u32x4*)(F.ws + WS_WRIMG); LAS u32x4* dst = (LAS u32x4*)F.lds;
      for (int i = F.tid; i < 2 * 32 * WRP * 2 / 16; i += NTHR) dst[i] = img[i]; }
    const int lane = F.lane, w = F.wave, fr = lane & 15, fq = lane >> 4, rt = w & 3, kh = w >> 2;
    for (int wg = F.bx; wg < M / 64; wg += F.G) {
        if (F.tid < 32) hist[F.tid] = 0;
        __syncthreads();
        const int m = wg * 64 + rt * 16 + fr;
        const bf16_t* xrow = X1 + (size_t)m * D + kh * 512 + 8 * fq;
        bf16_t* orow = XB + (size_t)m * D + kh * 512 + 8 * fq;
        const float* grow = F.g_ffn + kh * 512 + 8 * fq;
        f32x4 c0 = (f32x4){0.f, 0.f, 0.f, 0.f}, c1 = c0; float s2 = 0.f;
#pragma unroll 4
        for (int s = 0; s < 16; ++s) {
            const u32x4 xr8 = *(const u32x4*)(xrow + 32 * s);
            const f32x4 x0 = {bflo(xr8.x), bfhi(xr8.x), bflo(xr8.y), bfhi(xr8.y)}, x1v = {bflo(xr8.z), bfhi(xr8.z), bflo(xr8.w), bfhi(xr8.w)};
            const f32x4 g0 = *(const f32x4*)(grow + 32 * s), g1 = *(const f32x4*)(grow + 32 * s + 4);
            s2 += (x0.x * x0.x + x0.y * x0.y) + (x0.z * x0.z + x0.w * x0.w) + (x1v.x * x1v.x + x1v.y * x1v.y) + (x1v.z * x1v.z + x1v.w * x1v.w);
            const float xg[8] = {x0.x * g0.x, x0.y * g0.y, x0.z * g0.z, x0.w * g0.w, x1v.x * g1.x, x1v.y * g1.y, x1v.z * g1.z, x1v.w * g1.w};
            unsigned hw[4], lw[4];
#pragma unroll
            for (int p = 0; p < 4; ++p) { const unsigned h0 = f2bf(xg[2 * p]), h1 = f2bf(xg[2 * p + 1]);
                hw[p] = h0 | (h1 << 16);
                lw[p] = pk2(xg[2 * p] - __builtin_bit_cast(float, h0 << 16), xg[2 * p + 1] - __builtin_bit_cast(float, h1 << 16)); }
            const u32x4 hv = {hw[0], hw[1], hw[2], hw[3]}, lv = {lw[0], lw[1], lw[2], lw[3]};
            if constexpr (MOE_FP8) { u32x2 f8; f8.x = pk4_fp8(xg[0], xg[1], xg[2], xg[3]); f8.y = pk4_fp8(xg[4], xg[5], xg[6], xg[7]); *(u32x2*)((unsigned char*)XB + (size_t)m * D + kh * 512 + 8 * fq + 32 * s) = f8; }
            else *(u32x4*)(orow + 32 * s) = hv;
            const bf16x8 ah = __builtin_bit_cast(bf16x8, hv), al = __builtin_bit_cast(bf16x8, lv);
            const int kk = kh * 512 + 32 * s + 8 * fq;
            const bf16x8 bh0 = *(const LAS bf16x8*)(wh + fr * WRP + kk), bh1 = *(const LAS bf16x8*)(wh + (16 + fr) * WRP + kk);
            const bf16x8 bl0 = *(const LAS bf16x8*)(wl + fr * WRP + kk), bl1 = *(const LAS bf16x8*)(wl + (16 + fr) * WRP + kk);
            c0 = __builtin_amdgcn_mfma_f32_16x16x32_bf16(ah, bh0, c0, 0, 0, 0); c1 = __builtin_amdgcn_mfma_f32_16x16x32_bf16(ah, bh1, c1, 0, 0, 0);
            c0 = __builtin_amdgcn_mfma_f32_16x16x32_bf16(al, bh0, c0, 0, 0, 0); c1 = __builtin_amdgcn_mfma_f32_16x16x32_bf16(al, bh1, c1, 0, 0, 0);
            c0 = __builtin_amdgcn_mfma_f32_16x16x32_bf16(ah, bl0, c0, 0, 0, 0); c1 = __builtin_amdgcn_mfma_f32_16x16x32_bf16(ah, bl1, c1, 0, 0, 0);
        }
        s2 += __shfl_xor(s2, 16); s2 += __shfl_xor(s2, 32);
#pragma unroll
        for (int r = 0; r < 4; ++r) { LAS float* dst = lgp + (kh * 64 + rt * 16 + 4 * fq + r) * 33; dst[fr] = c0[r]; dst[16 + fr] = c1[r]; }
        if (fq == 0) lgp[(kh * 64 + rt * 16 + fr) * 33 + 32] = s2;
        __syncthreads();
        if (F.tid < 64) {
            const int row = F.tid, mm = wg * 64 + row;
            const LAS float* p0 = lgp + row * 33; const LAS float* p1 = lgp + (64 + row) * 33;
            const float rstd = 1.0f / sqrtf((p0[32] + p1[32]) * (1.0f / D) + RMS_EPS);
            float l[32];
#pragma unroll
            for (int e = 0; e < 32; ++e) l[e] = (p0[e] + p1[e]) * rstd + F.b_router[e];
            int bi[4]; float bv[4]; unsigned used = 0u;
#pragma unroll
            for (int k = 0; k < 4; ++k) { float best = -3.0e38f; int be = 0;
#pragma unroll
                for (int e = 0; e < 32; ++e) { const bool ok = !((used >> e) & 1u) && l[e] > best; best = ok ? l[e] : best; be = ok ? e : be; }
                used |= 1u << be; bi[k] = be; bv[k] = best; }
            const float e1 = __expf(bv[1] - bv[0]), e2 = __expf(bv[2] - bv[0]), e3 = __expf(bv[3] - bv[0]); const float inv = 1.0f / (1.0f + e1 + e2 + e3);
            *(int4*)(TOPI + (size_t)mm * 4) = make_int4(bi[0], bi[1], bi[2], bi[3]);
            *(f32x4*)(TOPG + (size_t)mm * 4) = (f32x4){inv, e1 * inv, e2 * inv, e3 * inv};
            RSTD[mm] = rstd;
#pragma unroll
            for (int k = 0; k < 4; ++k) atomicAdd((int*)&hist[bi[k]], 1);
        }
        __syncthreads();
        if (F.tid < 32) HIST[wg * 32 + F.tid] = hist[F.tid];
        __syncthreads();
    }
}

__device__ __forceinline__ void p7_slots(Frame& F) {
    LAS int* part = (LAS int*)F.lds;
    LAS int* cnt = part + 1024;
    LAS int* pre = cnt + 32;
    LAS int* pst = pre + 32;
    LAS int* wcnt = pst + 64;
    const int* TOPI = (const int*)(F.ws + WS_ROUTE + R_TOPI); const float* TOPG = (const float*)(F.ws + WS_ROUTE + R_TOPG); const int* HIST = (const int*)(F.ws + WS_ROUTE + R_HIST);
    int* POS = (int*)(F.ws + WS_ROUTE + R_POS); int* ROWTOK = (int*)(F.ws + WS_ROUTE + R_ROWTOK); float* ROWGATE = (float*)(F.ws + WS_ROUTE + R_ROWGATE); int* META = (int*)(F.ws + WS_ROUTE + R_META);
    const float* RSTD = (const float*)(F.ws + WS_ROUTE + R_RSTD); float* ROWRSTD = (float*)(F.ws + WS_ROUTE + R_ROWRSTD);
    constexpr int NWG = M / 64;
    const int lane = F.lane;
    for (int wg = F.bx; wg < NWG; wg += F.G) {
        int my_e = 0, tokn = 0, kk = 0; float my_g = 0.f, my_rs = 0.f;
        if (F.tid < 256) { tokn = wg * 64 + (F.tid >> 2); kk = F.tid & 3; my_e = TOPI[(size_t)tokn * 4 + kk]; my_g = TOPG[(size_t)tokn * 4 + kk]; my_rs = RSTD[tokn]; }
        { const int e = F.tid & 31, p = F.tid >> 5; int tot = 0, bef = 0;
#pragma unroll
          for (int q = 0; q < 16; ++q) { const int hv = HIST[(p * 16 + q) * 32 + e]; tot += hv; bef += (p * 16 + q < wg) ? hv : 0; }
          part[(p * 32 + e) * 2] = tot; part[(p * 32 + e) * 2 + 1] = bef; }
        __syncthreads();
        if (F.tid < 64) { int tot = 0, bef = 0;
            if (lane < 32) {
#pragma unroll
                for (int p = 0; p < 16; ++p) { tot += part[(p * 32 + lane) * 2]; bef += part[(p * 32 + lane) * 2 + 1]; }
                cnt[lane] = tot; pre[lane] = bef; }
            const int padded = lane < 32 ? ((tot + 255) & ~255) : 0;
            const int incl = (int)wave_incl_scan((float)padded);
            if (lane < 32) pst[lane] = incl - padded;
            if (lane == 31) pst[32] = incl; }
        int rw = 0;
        if (F.tid < 256) { int mycnt = 0;
#pragma unroll 4
            for (int e = 0; e < 32; ++e) { const unsigned long long mk = __ballot(my_e == e);
                if (my_e == e) rw = __popcll(mk & ((1ull << lane) - 1ull));
                if (lane == e) mycnt = __popcll(mk); }
            if (lane < 32) wcnt[F.wave * 32 + lane] = mycnt; }
        __syncthreads();
        if (F.tid < 256) { int rank = rw;
#pragma unroll
            for (int w2 = 0; w2 < 3; ++w2) rank += (w2 < F.wave) ? wcnt[w2 * 32 + my_e] : 0;
            const int slot = pst[my_e] + pre[my_e] + rank;
            ROWTOK[slot] = tokn; ROWGATE[slot] = my_g; ROWRSTD[slot] = my_rs; POS[(size_t)tokn * 4 + kk] = slot; }
        if (wg < NE) { const int e = wg, c = cnt[e], s0 = pst[e] + c, s1 = pst[e] + ((c + 255) & ~255);
            for (int s = s0 + F.tid; s < s1; s += NTHR) { ROWTOK[s] = 0; ROWGATE[s] = 0.f; ROWRSTD[s] = 0.f; } }
        if (wg == 0) { if (F.tid == 0) META[0] = pst[32] >> 8;
            for (int t = F.tid; t < NTILES_MAX; t += NTHR) { int e = 0;
#pragma unroll
                for (int q = 0; q < 32; ++q) e += (t * 256 >= pst[q + 1]) ? 1 : 0;
                META[32 + t] = e < 32 ? e : 31; } }
        __syncthreads();
    }
}

__device__ __forceinline__ void p10_combine(Frame& F) {
    const bf16_t* X1 = (const bf16_t*)(F.ws + WS_X1); const unsigned char* CB = F.ws + WS_CONTRIB; const int* POS = (const int*)(F.ws + WS_ROUTE + R_POS);
    const int gw = F.bx * NWAVES + F.wave, NGW = F.G * NWAVES, lane = F.lane;
    f32x4 gf[4];
#pragma unroll
    for (int q = 0; q < 4; ++q) gf[q] = *(const f32x4*)(F.g_fin + 16 * lane + 4 * q);
    for (int m = gw; m < M; m += NGW) {
        const int4 ps = *(const int4*)(POS + (size_t)m * 4); const int pp[4] = {ps.x, ps.y, ps.z, ps.w};
        const u32x4 xa = *(const GAS u32x4*)(X1 + (size_t)m * D + 16 * lane), xb = *(const GAS u32x4*)(X1 + (size_t)m * D + 16 * lane + 8);
        u32x4 cr[4];
#pragma unroll
        for (int k = 0; k < 4; ++k) {
            if constexpr (MOE_FP8) cr[k] = *(const GAS u32x4*)(CB + (size_t)pp[k] * D + 16 * lane);
        }
        float v[16];
        { const unsigned xw[8] = {xa.x, xa.y, xa.z, xa.w, xb.x, xb.y, xb.z, xb.w};
#pragma unroll
          for (int p = 0; p < 8; ++p) { v[2 * p] = bflo(xw[p]); v[2 * p + 1] = bfhi(xw[p]); } }
        if constexpr (MOE_FP8) {
#pragma unroll
            for (int k = 0; k < 4; ++k) { const unsigned cw[4] = {cr[k].x, cr[k].y, cr[k].z, cr[k].w};
#pragma unroll
                for (int p = 0; p < 4; ++p) { const f32x2 lo = __builtin_amdgcn_cvt_pk_f32_fp8((int)cw[p], false), hi = __builtin_amdgcn_cvt_pk_f32_fp8((int)cw[p], true);
                    v[4 * p] += lo.x * 0.0625f; v[4 * p + 1] += lo.y * 0.0625f; v[4 * p + 2] += hi.x * 0.0625f; v[4 * p + 3] += hi.y * 0.0625f; } }
        } else {
#pragma unroll
            for (int k = 0; k < 4; ++k) { const u32x4 ca = *(const GAS u32x4*)((const bf16_t*)CB + (size_t)pp[k] * D + 16 * lane), cb = *(const GAS u32x4*)((const bf16_t*)CB + (size_t)pp[k] * D + 16 * lane + 8);
                const unsigned cw[8] = {ca.x, ca.y, ca.z, ca.w, cb.x, cb.y, cb.z, cb.w};
#pragma unroll
                for (int p = 0; p < 8; ++p) { v[2 * p] += bflo(cw[p]); v[2 * p + 1] += bfhi(cw[p]); } }
        }
        float s2 = 0.f;
#pragma unroll
        for (int j = 0; j < 16; ++j) s2 += v[j] * v[j];
        const float rstd = __builtin_amdgcn_rsqf(wave_sum(s2) * (1.0f / D) + RMS_EPS);
        GAS f32x4* orow = (GAS f32x4*)(F.out + (size_t)m * D + 16 * lane);
#pragma unroll
        for (int q = 0; q < 4; ++q) orow[q] = (f32x4){v[4 * q] * rstd * gf[q].x, v[4 * q + 1] * rstd * gf[q].y, v[4 * q + 2] * rstd * gf[q].z, v[4 * q + 3] * rstd * gf[q].w};
    }
}

__global__ void __launch_bounds__(NTHR, 2) fwd_kernel(Args args) {
    extern __shared__ __attribute__((aligned(16))) unsigned char lds_raw[];
    Frame F;
    F.lds = (LAS unsigned char*)lds_raw;
    F.tid = threadIdx.x; F.lane = F.tid & 63; F.wave = __builtin_amdgcn_readfirstlane(F.tid >> 6); F.G = gridDim.x; F.bx = blockIdx.x;
    F.x = args.in[0]; F.g_mix = args.in[1]; F.w_in = args.in[2]; F.conv_w = args.in[3]; F.w_gk_up = args.in[4]; F.b_gk_up = args.in[5]; F.gla_g = args.in[6]; F.w_out = args.in[7];
    F.g_ffn = args.in[8]; F.w_router = args.in[9]; F.b_router = args.in[10]; F.w_gu = args.in[11]; F.b_gu = args.in[12]; F.w_dn = args.in[13]; F.b_dn = args.in[14]; F.g_fin = args.in[15];
    F.out = args.out; F.ws = args.ws;
    volatile LAS unsigned* MISC = (volatile LAS unsigned*)(F.lds + MISC_OFF);
    for (int u = F.tid; u < 256; u += NTHR) MISC[u] = 0u;
    __syncthreads();
    unsigned* ctl = (unsigned*)(F.ws + WS_CTL);
    XcdBarrier bar; bar.bar = ctl + CW_BAR; bar.x = 0; bar.st = nullptr;
    if (N_LAUNCHES == 1) bar = xcd_barrier_post(ctl + CW_BAR, MISC + 8);
    const int lo = args.ph_lo, hi = args.ph_hi;
#define IN(k) (lo <= (k) && (k) < hi)
#ifndef TPROBE
#define TPROBE -1
#endif
    unsigned long long tp_a = 0, tp_b = 0;
    if (TPROBE == 0 || TPROBE == 100) tp_a = __builtin_amdgcn_s_memrealtime();
#define SEAM(k) do { if (IN(k) && IN((k) + 1)) { xcd_barrier(bar); if (((REPMASK >> 22) & 1) != 0) xcd_barrier(bar); } \
        if ((k) + 1 == TPROBE) tp_a = __builtin_amdgcn_s_memrealtime(); if ((k) == TPROBE) tp_b = __builtin_amdgcn_s_memrealtime(); } while (0)
#define REP(k) for (int rep_ = 0; rep_ < 1 + ((REPMASK >> (k)) & 1); ++rep_)
    const int* META = (const int*)(F.ws + WS_ROUTE + R_META);

    constexpr int ES_ = MOE_FP8 ? 1 : 2, NTE_ = D * ES_ / 128;
    constexpr int IT_DENSE = (NPROJ / 256) * 16 + (D / 256) * 16;
    constexpr int IT_ALL = IT_DENSE + NE * ((2 * FF / 256) * NTE_ + (D / 256) * NTE_);
    const int NCONV = (F.G == 256) ? 128 : 0;
    if (IN(0)) { p0_prep(F);
        if (TPROBE == 100 || TPROBE == 101) { xcd_barrier(bar); if (TPROBE == 100) tp_b = __builtin_amdgcn_s_memrealtime(); else tp_a = __builtin_amdgcn_s_memrealtime(); }
        p0b_weights(F, 0, NCONV ? IT_DENSE : IT_ALL, F.bx, F.G, true); } SEAM(0);
    if (TPROBE == 101) tp_b = __builtin_amdgcn_s_memrealtime();
    if (IN(1)) {
        pg8::EpiBf16 E{(bf16_t*)(F.ws + WS_PROJ), NPROJ};
        pg8::ListOrder S; S.so.init(M / 256, NPROJ / 256, F.G, F.bx);
        constexpr int NU = (M / 256) * (NPROJ / 256);
        if (NCONV == 0) { S.L0 = F.bx; S.stride = F.G; S.n = (NU - F.bx + F.G - 1) / F.G; S.Ltail = -1; }
        else {
            const int NG = F.G - NCONV, nfull = NU / NG, tail0 = nfull * NG, ntail = NU - tail0;
            if (F.bx < NCONV) { __syncthreads(); p0b_weights(F, IT_DENSE, IT_ALL, F.bx, NCONV, false); __syncthreads();
                S.L0 = 0; S.stride = 0; S.n = 0; S.Ltail = (F.bx < ntail) ? tail0 + F.bx : -1; }
            else { const int c = F.bx - NCONV; S.L0 = c; S.stride = NG; S.n = nfull; S.Ltail = (NCONV + c < ntail) ? tail0 + NCONV + c : -1; }
        }
        pg8::gemm_phase<pg8::EpiBf16, pg8::ListOrder, true, false, 1 + ((REPMASK >> 14) & 1)>(F.lds, F.ws + WS_XN, F.ws + WS_W1T, 0, D / 64, nullptr, S, E);
    } SEAM(1);
    if (IN(2)) REP(2) { p2_gla_kv(F); } SEAM(2);
    if (IN(3)) REP(3) { p3_scan(F); } SEAM(3);
    if (IN(4)) REP(4) { p4_gla_out(F); } SEAM(4);
    if (IN(5)) {
        pg8::StaticOrder S; S.init(M / 256, D / 256, F.G, F.bx, 1 + ((REPMASK >> 5) & 1));
        pg8::EpiResBf16 E{F.x, (bf16_t*)(F.ws + WS_X1), D};
        pg8::gemm_phase<pg8::EpiResBf16, pg8::StaticOrder, true, false, 1 + ((REPMASK >> 15) & 1)>(F.lds, F.ws + WS_Y, F.ws + WS_WOT, 0, D / 64, nullptr, S, E);
    } SEAM(5);
    if (IN(6)) REP(6) { p6_router(F); } SEAM(6);
    if (IN(7)) REP(7) { p7_slots(F); } SEAM(7);
    if (IN(8)) {
        const int ntiles = META[0];
        LAS int* te = (LAS int*)(F.lds + TE_OFF); LAS int* utab = te + NTILES_MAX;
        LAS unsigned short* ridx = (LAS unsigned short*)(F.lds + TE_OFF + 2048); LAS float* rstd = (LAS float*)(F.lds + TE_OFF + 2048 + pg8::UCAP * 512); LAS float* bias = rstd + pg8::UCAP * 256;
        for (int i = F.tid; i < NTILES_MAX; i += NTHR) te[i] = META[32 + i];
        __syncthreads();
        pg8::MoeOrder S0; S0.so.init(ntiles, 2 * FF / 256, F.G, F.bx); S0.tile_expert = te;
        int nun = 0;
        { const int* ROWTOK = (const int*)(F.ws + WS_ROUTE + R_ROWTOK); const float* ROWRSTD = (const float*)(F.ws + WS_ROUTE + R_ROWRSTD); pg8::Unit uu;
          for (; nun < pg8::UCAP && S0.next(nun, uu); ++nun) {
              if (F.tid == 0) { utab[4 * nun] = uu.pm; utab[4 * nun + 1] = uu.pn; utab[4 * nun + 2] = uu.pb; utab[4 * nun + 3] = uu.e; }
              if (F.tid < 256) { ridx[nun * 256 + F.tid] = (unsigned short)ROWTOK[uu.pm * 256 + F.tid]; rstd[nun * 256 + F.tid] = ROWRSTD[uu.pm * 256 + F.tid];
                  bias[nun * 256 + F.tid] = F.b_gu[(size_t)uu.e * 2048 + (F.tid >> 7) * 1024 + uu.pn * 128 + (F.tid & 127)]; } }
          __syncthreads(); }
        pg8::TabOrder S{utab, nun, (REPMASK >> 18) & 1};
#ifdef SKEW_TICKS
        { const unsigned long long t0 = __builtin_amdgcn_s_memrealtime(); const unsigned long long dl = (unsigned long long)((F.bx >> 3) & 31) * SKEW_TICKS;
          while (__builtin_amdgcn_s_memrealtime() - t0 < dl) __builtin_amdgcn_s_sleep(2); }
#endif
        pg8::EpiSwiglu E{(bf16_t*)(F.ws + WS_H), bias, rstd};
        constexpr int ES = MOE_FP8 ? 1 : 2;
        pg8::gemm_phase<pg8::EpiSwiglu, pg8::TabOrder, true, MOE_FP8 != 0, 1 + ((REPMASK >> 16) & 1), false>(F.lds, F.ws + WS_XN, F.ws + WS_WGUT, D * ES, D * ES / 128, ridx, S, E);
    } SEAM(8);
    if (IN(9)) {
        const int ntiles = META[0];
        LAS int* te = (LAS int*)(F.lds + TE_OFF); LAS int* utab = te + NTILES_MAX;
        LAS float* gate = (LAS float*)(F.lds + TE_OFF + 2048); LAS float* bias = gate + pg8::UCAP * 256;
        for (int i = F.tid; i < NTILES_MAX; i += NTHR) te[i] = META[32 + i];
        __syncthreads();
        pg8::MoeOrder S0; S0.so.init(ntiles, D / 256, F.G, F.bx); S0.tile_expert = te;
        int nun = 0;
        { const float* ROWGATE = (const float*)(F.ws + WS_ROUTE + R_ROWGATE); pg8::Unit uu;
          for (; nun < pg8::UCAP && S0.next(nun, uu); ++nun) {
              if (F.tid == 0) { utab[4 * nun] = uu.pm; utab[4 * nun + 1] = uu.pn; utab[4 * nun + 2] = uu.pb; utab[4 * nun + 3] = uu.e; }
              if (F.tid < 256) { gate[nun * 256 + F.tid] = ROWGATE[uu.pm * 256 + F.tid]; bias[nun * 256 + F.tid] = F.b_dn[(size_t)uu.e * D + uu.pn * 256 + F.tid]; } }
          __syncthreads(); }
        pg8::TabOrder S{utab, nun, (REPMASK >> 19) & 1};
        pg8::EpiDown E{F.ws + WS_CONTRIB, bias, gate};
        constexpr int ES = MOE_FP8 ? 1 : 2;
        pg8::gemm_phase<pg8::EpiDown, pg8::TabOrder, true, MOE_FP8 != 0, 1 + ((REPMASK >> 17) & 1), false>(F.lds, F.ws + WS_H, F.ws + WS_WDT, 0, FF * ES / 128, nullptr, S, E);
    } SEAM(9);
    if (IN(10)) REP(10) { p10_combine(F); }
    if (TPROBE >= 0) { if (TPROBE == 10) tp_b = __builtin_amdgcn_s_memrealtime();
        if (F.bx == 0) { const unsigned long long t0 = __builtin_amdgcn_s_memrealtime(), dl = (tp_b - tp_a) * 10ull;
            while (__builtin_amdgcn_s_memrealtime() - t0 < dl) __builtin_amdgcn_s_sleep(8); } }
#undef IN
#undef SEAM
}

extern "C" void kernel_launch(void* const* d_in, const int* in_sizes, int n_in, void* d_out, int out_size, void* d_ws, size_t ws_size, hipStream_t stream) {
    static int grid = 0;
    if (grid == 0) {
        if (n_in != 16 || in_sizes[0] != M * D || out_size != M * D || ws_size < WS_END) { fprintf(stderr, "kernel_launch: unexpected shapes (n_in %d, in0 %d, out %d, ws %zu < %zu)\n", n_in, n_in > 0 ? in_sizes[0] : -1, out_size, ws_size, (size_t)WS_END); grid = -1; return; }
        int dev = 0, cus = 0, per_cu = 0;
        if (hipGetDevice(&dev) != hipSuccess || hipDeviceGetAttribute(&cus, hipDeviceAttributeMultiprocessorCount, dev) != hipSuccess) { grid = -1; return; }
        if (hipFuncSetAttribute((const void*)fwd_kernel, hipFuncAttributeMaxDynamicSharedMemorySize, LDS_BYTES) != hipSuccess) { fprintf(stderr, "kernel_launch: hipFuncSetAttribute failed\n"); grid = -1; return; }
        if (hipOccupancyMaxActiveBlocksPerMultiprocessor(&per_cu, (const void*)fwd_kernel, NTHR, LDS_BYTES) != hipSuccess || per_cu < 1) fprintf(stderr, "kernel_launch: occupancy query reports %d\n", per_cu);
        (void)hipGetLastError();
        grid = cus;
    }
    if (grid < 0) return;
    (void)hipMemsetAsync((char*)d_ws + WS_CTL, 0, CTL_ZERO_BYTES, stream);
    Args a{};
    for (int i = 0; i < 16; ++i) a.in[i] = (const float*)d_in[i];
    a.out = (float*)d_out; a.ws = (unsigned char*)d_ws;
    for (int li = 0; li < N_LAUNCHES; ++li) {
        if (N_LAUNCHES == 1) { a.ph_lo = 0; a.ph_hi = NPHASES; } else { a.ph_lo = li; a.ph_hi = li + 1; }
        a.li = li;
        hipLaunchKernelGGL(fwd_kernel, dim3(grid), dim3(NTHR), LDS_BYTES, stream, a);
    }
}
```
